# Optimizing an MI355X kernel written in HIP

```python
import math
import jax
import jax.numpy as jnp
from jax import lax
import numpy as np

D_MODEL = 1024
BATCH = 32
SEQ = 2048
DEPTH = 1
DEC_BATCH = 8
DEC_SEQ = 16
PAST_LEN = 4096

CHUNK = 64
Q_BLOCK = 128
DIFF_HEADS = 8
DIFF_HEAD_DIM = 64
DIFF_V_DIM = 2 * DIFF_HEAD_DIM
MLA_HEADS = 16
MLA_NOPE_DIM = 64
MLA_ROPE_DIM = 32
MLA_V_DIM = 64
MLA_Q_LORA = 256
MLA_KV_LORA = 256
D_FF = 4 * D_MODEL
NUM_BUCKETS = 32
MAX_DISTANCE = 128
ROPE_THETA = 10000.0
EPS = 1e-6
NEG_INF = -1e30

DIFF_QK_W = DIFF_HEADS * 2 * DIFF_HEAD_DIM
DIFF_V_W = DIFF_HEADS * DIFF_V_DIM
IN_COLS = 2 * DIFF_QK_W + DIFF_V_W + MLA_Q_LORA + MLA_KV_LORA + MLA_ROPE_DIM + 2 * D_MODEL

kernel_name = 'hybrid_diffattn_mla_stream_step'


def _in_splits():
    sizes = (DIFF_QK_W, DIFF_QK_W, DIFF_V_W, MLA_Q_LORA, MLA_KV_LORA, MLA_ROPE_DIM, D_MODEL, D_MODEL)
    out, acc = [], 0
    for s in sizes[:-1]:
        acc += s
        out.append(acc)
    return tuple(out)


def _rmsnorm(x, g):
    xf = x.astype(jnp.float32)
    y = xf * lax.rsqrt(jnp.mean(xf * xf, axis=-1, keepdims=True) + EPS) * g.astype(jnp.float32)
    return y.astype(x.dtype)


def _rope(x, pos):
    r = x.shape[-1]
    half = r // 2
    inv = jnp.power(ROPE_THETA, -jnp.arange(half, dtype=jnp.float32) * 2.0 / r)
    ang = pos.astype(jnp.float32)[:, None] * inv[None, :]
    ang = ang.reshape((ang.shape[0],) + (1,) * (x.ndim - 3) + (half,))
    cos, sin = jnp.cos(ang), jnp.sin(ang)
    xf = x.astype(jnp.float32)
    x1, x2 = xf[..., :half], xf[..., half:]
    return jnp.concatenate([x1 * cos - x2 * sin, x2 * cos + x1 * sin], axis=-1).astype(x.dtype)


def _t5_bias(q_pos, k_pos, table):
    rel = k_pos[None, :] - q_pos[:, None]
    half = NUM_BUCKETS // 2
    max_exact = half // 2
    n = jnp.abs(rel)
    nf = jnp.maximum(n, max_exact).astype(jnp.float32)
    large = max_exact + (jnp.log(nf / max_exact) / math.log(MAX_DISTANCE / max_exact)
                         * (half - max_exact)).astype(jnp.int32)
    large = jnp.minimum(large, half - 1)
    bucket = jnp.where(rel > 0, half, 0) + jnp.where(n < max_exact, n, large)
    return jnp.transpose(table[bucket].astype(jnp.float32), (2, 0, 1))


def _chunk_mask(q_pos, k_pos):
    return (k_pos // CHUNK)[None, :] <= (q_pos // CHUNK)[:, None]


def _sweep_queries(fn, qs, q_pos):
    t = q_pos.shape[0]
    if t <= Q_BLOCK:
        return fn(*qs, q_pos)
    nb = t // Q_BLOCK

    def to_blocks(a):
        return jnp.moveaxis(a.reshape((a.shape[0], nb, Q_BLOCK) + a.shape[2:]), 1, 0)

    out = lax.map(lambda args: fn(*args[0], args[1]),
                  (tuple(to_blocks(a) for a in qs), q_pos.reshape(nb, Q_BLOCK)))
    out = jnp.moveaxis(out, 0, 1)
    return out.reshape((out.shape[0], t) + out.shape[3:])


def _diff_attention(q, k_all, v_all, q_pos, k_pos, rel_bias, lam, subln, lambda_init):
    b, kl = k_all.shape[0], k_all.shape[1]
    k = k_all.reshape(b, kl, DIFF_HEADS, 2, DIFF_HEAD_DIM)
    scale = DIFF_HEAD_DIM ** -0.5

    def block(qb, qp):
        s = jnp.einsum('bqhnd,bkhnd->bnhqk', qb, k).astype(jnp.float32) * scale
        s = s + _t5_bias(qp, k_pos, rel_bias)[None, None]
        s = jnp.where(_chunk_mask(qp, k_pos)[None, None, None], s, NEG_INF)
        p = jax.nn.softmax(s, axis=-1)
        a = (p[:, 0] - lam * p[:, 1]).astype(v_all.dtype)
        return jnp.einsum('bhqk,bkhe->bqhe', a, v_all)

    o = _sweep_queries(block, (q,), q_pos)
    return _rmsnorm(o, subln) * (1.0 - lambda_init)


def _mla_attention(q_lat, q_rope, ckv_all, kr_all, q_pos, k_pos):
    scale = (MLA_NOPE_DIM + MLA_ROPE_DIM) ** -0.5

    def block(ql, qr, qp):
        s = (jnp.einsum('bqhc,bkc->bhqk', ql, ckv_all)
             + jnp.einsum('bqhr,bkr->bhqk', qr, kr_all)).astype(jnp.float32) * scale
        s = jnp.where(_chunk_mask(qp, k_pos)[None, None], s, NEG_INF)
        p = jax.nn.softmax(s, axis=-1).astype(ckv_all.dtype)
        return jnp.einsum('bhqk,bkc->bqhc', p, ckv_all)

    return _sweep_queries(block, (q_lat, q_rope), q_pos)


def _layer(x, q_pos, k_pos, past, layer_idx, rel_bias, norm_mix, w_in, lam_q1, lam_k1, lam_q2, lam_k2,
           diff_subln, mla_q_norm, mla_w_uq, mla_kv_norm, mla_w_uk, mla_w_uv, w_o_diff, w_o_mla, w_out,
           norm_mlp, w_up, w_down):
    b, t, _ = x.shape
    h = _rmsnorm(x, norm_mix)
    z = jnp.einsum('btd,dc->btc', h, w_in)
    q_d, k_d, v_d, c_q, c_kv, k_r, g_d, g_m = jnp.split(z, _in_splits(), axis=-1)

    k_new = k_d.reshape(b, t, DIFF_HEADS, 2 * DIFF_HEAD_DIM)
    v_new = v_d.reshape(b, t, DIFF_HEADS, DIFF_V_DIM)
    ckv_new = _rmsnorm(c_kv, mla_kv_norm)
    kr_new = _rope(k_r, q_pos)
    if past is None:
        k_all, v_all, ckv_all, kr_all = k_new, v_new, ckv_new, kr_new
    else:
        k_all = jnp.concatenate([past[0], k_new], axis=1)
        v_all = jnp.concatenate([past[1], v_new], axis=1)
        ckv_all = jnp.concatenate([past[2], ckv_new], axis=1)
        kr_all = jnp.concatenate([past[3], kr_new], axis=1)

    lambda_init = 0.8 - 0.6 * math.exp(-0.3 * layer_idx)
    lam = (jnp.exp(jnp.sum(lam_q1.astype(jnp.float32) * lam_k1.astype(jnp.float32)))
           - jnp.exp(jnp.sum(lam_q2.astype(jnp.float32) * lam_k2.astype(jnp.float32))) + lambda_init)
    q = q_d.reshape(b, t, DIFF_HEADS, 2, DIFF_HEAD_DIM)
    diff_out = _diff_attention(q, k_all, v_all, q_pos, k_pos, rel_bias, lam, diff_subln, lambda_init)

    cq = _rmsnorm(c_q, mla_q_norm)
    qm = jnp.einsum('btc,chd->bthd', cq, mla_w_uq)
    q_nope, q_rope = qm[..., :MLA_NOPE_DIM], _rope(qm[..., MLA_NOPE_DIM:], q_pos)
    q_lat = jnp.einsum('bthd,chd->bthc', q_nope, mla_w_uk)
    o_lat = _mla_attention(q_lat, q_rope, ckv_all, kr_all, q_pos, k_pos)
    mla_out = jnp.einsum('bthc,chd->bthd', o_lat, mla_w_uv)

    o_d = jnp.einsum('bthe,hed->btd', diff_out, w_o_diff)
    o_m = jnp.einsum('bthe,hed->btd', mla_out, w_o_mla)
    merged = jax.nn.sigmoid(g_d) * o_d + jax.nn.sigmoid(g_m) * o_m
    x = x + jnp.einsum('btd,de->bte', merged, w_out)

    u = jax.nn.relu(jnp.einsum('btd,df->btf', _rmsnorm(x, norm_mlp), w_up))
    x = x + jnp.einsum('btf,fd->btd', u * u, w_down)
    return x, (k_new, v_new, ckv_new, kr_new)


def setup_inputs(seed: int = 0) -> dict:
    key = jax.random.key(seed)
    ks = jax.random.split(key, 32)

    def nrm(k, shape, scale):
        return jax.random.normal(k, shape, dtype=jnp.float32) * scale

    def gain(k, shape):
        return 1.0 + nrm(k, shape, 0.05)

    L = DEPTH
    return {
        'x_prompt': nrm(ks[0], (BATCH, SEQ, D_MODEL), 1.0),
        'x_sample': nrm(ks[1], (DEC_BATCH, DEC_SEQ, D_MODEL), 1.0),
        'cache_diff_k': nrm(ks[2], (L, DEC_BATCH, PAST_LEN, DIFF_HEADS, 2 * DIFF_HEAD_DIM), 1.0),
        'cache_diff_v': nrm(ks[3], (L, DEC_BATCH, PAST_LEN, DIFF_HEADS, DIFF_V_DIM), 1.0),
        'cache_mla_ckv': nrm(ks[4], (L, DEC_BATCH, PAST_LEN, MLA_KV_LORA), 1.0),
        'cache_mla_krope': nrm(ks[5], (L, DEC_BATCH, PAST_LEN, MLA_ROPE_DIM), 1.0),
        'rel_bias': nrm(ks[6], (NUM_BUCKETS, DIFF_HEADS), 0.5),
        'norm_mix': gain(ks[7], (L, D_MODEL)),
        'w_in': nrm(ks[8], (L, D_MODEL, IN_COLS), D_MODEL ** -0.5),
        'lam_q1': nrm(ks[9], (L, DIFF_HEAD_DIM), 0.1),
        'lam_k1': nrm(ks[10], (L, DIFF_HEAD_DIM), 0.1),
        'lam_q2': nrm(ks[11], (L, DIFF_HEAD_DIM), 0.1),
        'lam_k2': nrm(ks[12], (L, DIFF_HEAD_DIM), 0.1),
        'diff_subln': gain(ks[13], (L, DIFF_V_DIM)),
        'mla_q_norm': gain(ks[14], (L, MLA_Q_LORA)),
        'mla_w_uq': nrm(ks[15], (L, MLA_Q_LORA, MLA_HEADS, MLA_NOPE_DIM + MLA_ROPE_DIM), MLA_Q_LORA ** -0.5),
        'mla_kv_norm': gain(ks[16], (L, MLA_KV_LORA)),
        'mla_w_uk': nrm(ks[17], (L, MLA_KV_LORA, MLA_HEADS, MLA_NOPE_DIM), MLA_KV_LORA ** -0.5),
        'mla_w_uv': nrm(ks[18], (L, MLA_KV_LORA, MLA_HEADS, MLA_V_DIM), MLA_KV_LORA ** -0.5),
        'w_o_diff': nrm(ks[19], (L, DIFF_HEADS, DIFF_V_DIM, D_MODEL), DIFF_V_W ** -0.5),
        'w_o_mla': nrm(ks[20], (L, MLA_HEADS, MLA_V_DIM, D_MODEL), (MLA_HEADS * MLA_V_DIM) ** -0.5),
        'w_out': nrm(ks[21], (L, D_MODEL, D_MODEL), D_MODEL ** -0.5),
        'norm_mlp': gain(ks[22], (L, D_MODEL)),
        'w_up': nrm(ks[23], (L, D_MODEL, D_FF), D_MODEL ** -0.5),
        'w_down': nrm(ks[24], (L, D_FF, D_MODEL), D_FF ** -0.5),
        'norm_final': gain(ks[25], (D_MODEL,)),
    }


def reference(x_prompt, x_sample, cache_diff_k, cache_diff_v, cache_mla_ckv, cache_mla_krope, rel_bias,
              norm_mix, w_in, lam_q1, lam_k1, lam_q2, lam_k2, diff_subln, mla_q_norm, mla_w_uq, mla_kv_norm,
              mla_w_uk, mla_w_uv, w_o_diff, w_o_mla, w_out, norm_mlp, w_up, w_down, norm_final):
    past_len = cache_diff_k.shape[2]
    pos_p = jnp.arange(x_prompt.shape[1], dtype=jnp.int32)
    pos_s = past_len + jnp.arange(x_sample.shape[1], dtype=jnp.int32)
    kpos_s = jnp.arange(past_len + x_sample.shape[1], dtype=jnp.int32)

    xp, xs = x_prompt, x_sample
    rows_p, rows_s = [], []
    for l in range(DEPTH):
        lw = (norm_mix[l], w_in[l], lam_q1[l], lam_k1[l], lam_q2[l], lam_k2[l], diff_subln[l], mla_q_norm[l],
              mla_w_uq[l], mla_kv_norm[l], mla_w_uk[l], mla_w_uv[l], w_o_diff[l], w_o_mla[l], w_out[l],
              norm_mlp[l], w_up[l], w_down[l])
        xp, rp = _layer(xp, pos_p, pos_p, None, l, rel_bias, *lw)
        past = (cache_diff_k[l], cache_diff_v[l], cache_mla_ckv[l], cache_mla_krope[l])
        xs, rs = _layer(xs, pos_s, kpos_s, past, l, rel_bias, *lw)
        rows_p.append(rp)
        rows_s.append(rs)

    y_prompt = _rmsnorm(xp, norm_final)
    y_sample = _rmsnorm(xs, norm_final)
    new_diff_k_prompt = jnp.stack([r[0] for r in rows_p])
    new_diff_v_prompt = jnp.stack([r[1] for r in rows_p])
    new_mla_ckv_prompt = jnp.stack([r[2] for r in rows_p])
    new_mla_krope_prompt = jnp.stack([r[3] for r in rows_p])
    new_diff_k_sample = jnp.stack([r[0] for r in rows_s])
    new_diff_v_sample = jnp.stack([r[1] for r in rows_s])
    new_mla_ckv_sample = jnp.stack([r[2] for r in rows_s])
    new_mla_krope_sample = jnp.stack([r[3] for r in rows_s])
    return (y_prompt, y_sample, new_diff_k_prompt, new_diff_v_prompt, new_mla_ckv_prompt, new_mla_krope_prompt,
            new_diff_k_sample, new_diff_v_sample, new_mla_ckv_sample, new_mla_krope_sample)
```

```cpp
#include <hip/hip_runtime.h>
#include <hip/hip_cooperative_groups.h>
#include <cstdio>
#include <cstdint>
namespace cg = cooperative_groups;
namespace pg8 {
#define PG8_LAS __attribute__((address_space(3)))
typedef unsigned short bf16_t;
typedef short bf16x8 __attribute__((ext_vector_type(8)));
typedef float f32x4 __attribute__((ext_vector_type(4)));
typedef unsigned u32x4 __attribute__((ext_vector_type(4)));
constexpr int BM = 256, BK = 64, HALF = 128, HTB = HALF * BK * 2  , STAGE_BYTES = 8 * HTB, NXCD = 8, WGM = 8;

__host__ __device__ __forceinline__ int lds_byte(int r, int c) { const int st = (r >> 4) * 2 + (c >> 5), rr = r & 15, cc = c & 31, ob = rr * 64 + cc * 2; return st * 1024 + (ob ^ (((ob >> 9) & 1) << 5)); }
__host__ __device__ __forceinline__ void stage_rc(int b, int& R, int& C) { const int st = b / 1024, sb = b % 1024, swz = sb ^ (((sb >> 9) & 1) << 5); R = (st >> 1) * 16 + swz / 64; C = (st & 1) * 32 + (swz % 64) / 2; }
__host__ __device__ __forceinline__ int perm32(int rho) { const int n = rho >> 4, i = rho & 15; return 8 * (i >> 2) + 4 * n + (i & 3); }

struct Unit { int pm, pn; };
struct Gemm { const bf16_t* A; const bf16_t* Bt; int M, N, K; };

struct StaticOrder {
    int nM, nN, nwg, G, c;
    __host__ __device__ void init(int M, int N, int G_, int c_) { nM = M / BM; nN = N / BM; nwg = nM * nN; G = G_; c = c_; }
    __host__ __device__ bool next(int i, Unit& u) const {
        const long L = (long)i * G + c; if (L >= nwg) return false;
        int wgid = (int)L; { const int q = nwg / NXCD, r = nwg % NXCD, xcd = wgid % NXCD, off = wgid / NXCD; wgid = (xcd < r ? xcd * (q + 1) : r * (q + 1) + (xcd - r) * q) + off; }
        const int nig = WGM * nN, gid = wgid / nig, fm = gid * WGM, gsz = (nM - fm) < WGM ? (nM - fm) : WGM;
        u.pm = fm + ((wgid % nig) % gsz); u.pn = (wgid % nig) / gsz; return true;
    }
    __device__ __forceinline__ void a_ready(const Unit&) const {}
    __device__ __forceinline__ void done(const Unit&) const {}
};

__device__ __forceinline__ unsigned cvt_pk_bf16(float lo, float hi) { unsigned r; asm volatile("v_cvt_pk_bf16_f32 %0, %1, %2" : "=v"(r) : "v"(lo), "v"(hi)); return r; }
typedef float f32x2 __attribute__((ext_vector_type(2)));
template <class Epi, class Sched, bool ALIGN_EPI = false, bool SP2 = false>
__device__ __forceinline__ void gemm_phase(PG8_LAS unsigned char* lds, const Gemm g, const Sched& S, const Epi& E) {
    int tid_ = threadIdx.x; asm volatile("" : "+v"(tid_));
    const int tid = tid_, wid = __builtin_amdgcn_readfirstlane(tid >> 6), lane = tid & 63, wr = wid >> 2, wc = wid & 3, fr = lane & 15, fq = lane >> 4;
    const int K = g.K, nt = K / BK;
    unsigned voffA[2], voffB[2];
#pragma unroll
    for (int i = 0; i < 2; ++i) { int R, C; stage_rc(tid * 16 + i * 8192, R, C); const int Rb = Epi::PERM ? ((R & ~31) + perm32(R & 31)) : R;
        voffA[i] = (unsigned)(R * K + C) * 2u; voffB[i] = (unsigned)(Rb * K + C) * 2u; }
    const size_t kstep = (size_t)(BK * 2);
    const size_t hstep = (size_t)HALF * K * 2;
    const size_t tstep = 2 * hstep;
    const unsigned ldsw = (unsigned)wid * 1024u;
    const int aoff = lds_byte(wr * 64 + fr, fq * 8), boff = lds_byte(wc * 32 + fr, fq * 8);
#define PG8_SA(b, h) (((b) * 2 + (h)) * HTB)
#define PG8_SB(b, h) ((4 + (b) * 2 + (h)) * HTB)
#define PG8_STAGE(bufoff, gbase, voff) do { _Pragma("unroll") for (int _i = 0; _i < 2; ++_i) \
        __builtin_amdgcn_global_load_lds((const unsigned*)((const char*)(gbase) + (voff)[_i]), (PG8_LAS unsigned*)(lds + (bufoff) + ldsw + _i * 8192), 16, 0, 0); } while (0)
#define PG8_LDA(dst, b, h) do { _Pragma("unroll") for (int m = 0; m < 4; ++m) _Pragma("unroll") for (int k = 0; k < 2; ++k) dst[m][k] = *(const PG8_LAS bf16x8*)(lds + PG8_SA(b, h) + aoff + m * 2048 + k * 1024); } while (0)
#define PG8_LDB(dst, b, h) do { _Pragma("unroll") for (int n = 0; n < 2; ++n) _Pragma("unroll") for (int k = 0; k < 2; ++k) dst[n][k] = *(const PG8_LAS bf16x8*)(lds + PG8_SB(b, h) + boff + n * 2048 + k * 1024); } while (0)
#define PG8_MMA(ai, bj, At, Bt) do { __builtin_amdgcn_s_setprio(1); _Pragma("unroll") for (int m = 0; m < 4; ++m) _Pragma("unroll") for (int n = 0; n < 2; ++n) _Pragma("unroll") for (int k = 0; k < 2; ++k) \
        acc[ai][bj][m][n] = __builtin_amdgcn_mfma_f32_16x16x32_bf16(Bt[n][k], At[m][k], acc[ai][bj][m][n], 0, 0, 0); __builtin_amdgcn_s_setprio(0); } while (0)
#define PG8_WAIT_V(n) asm volatile("s_waitcnt vmcnt(" #n ")" ::: "memory")
#define PG8_WAIT_L(n) asm volatile("s_waitcnt lgkmcnt(" #n ")" ::: "memory")
#define PG8_BAR __builtin_amdgcn_s_barrier()
#define PG8_SCHED __builtin_amdgcn_sched_barrier(0)
    Unit cur, nxt; int ui = 0;
    if (!S.next(0, cur)) return;
    f32x4 acc[2][2][4][2];
#pragma unroll
    for (int a = 0; a < 2; ++a)
#pragma unroll
        for (int b = 0; b < 2; ++b)
#pragma unroll
            for (int m = 0; m < 4; ++m)
#pragma unroll
                for (int n = 0; n < 2; ++n) acc[a][b][m][n] = (f32x4){0.f, 0.f, 0.f, 0.f};
    bf16x8 At[4][2], B0[2][2], B1[2][2];
    const char* cA = (const char*)g.A + (size_t)cur.pm * tstep; const char* cB = (const char*)g.Bt + (size_t)cur.pn * tstep;
    S.a_ready(cur);
    if constexpr (SP2) {
        PG8_STAGE(PG8_SB(0, 0), cB, voffB); PG8_STAGE(PG8_SB(0, 1), cB + hstep, voffB); PG8_STAGE(PG8_SA(0, 0), cA, voffA); PG8_STAGE(PG8_SA(0, 1), cA + hstep, voffA);
        if (wr == 1) PG8_BAR;
        PG8_WAIT_V(2); PG8_BAR;
        PG8_STAGE(PG8_SB(1, 0), cB + kstep, voffB); PG8_STAGE(PG8_SA(1, 0), cA + kstep, voffA); PG8_STAGE(PG8_SB(1, 1), cB + hstep + kstep, voffB);
        PG8_WAIT_V(6); PG8_BAR;
    } else {
        PG8_STAGE(PG8_SB(0, 0), cB, voffB); PG8_STAGE(PG8_SA(0, 0), cA, voffA); PG8_STAGE(PG8_SB(0, 1), cB + hstep, voffB); PG8_STAGE(PG8_SA(0, 1), cA + hstep, voffA);
        if (wr == 1) PG8_BAR;
        PG8_WAIT_V(4); PG8_BAR;
        PG8_STAGE(PG8_SB(1, 0), cB + kstep, voffB); PG8_STAGE(PG8_SA(1, 0), cA + kstep, voffA); PG8_STAGE(PG8_SB(1, 1), cB + hstep + kstep, voffB);
        PG8_WAIT_V(6); PG8_BAR;
    }
    for (;;) {
        const bool has_next = S.next(ui + 1, nxt);
        const char* nA = has_next ? (const char*)g.A + (size_t)nxt.pm * tstep : cA; const char* nB = has_next ? (const char*)g.Bt + (size_t)nxt.pn * tstep : cB;
        for (int t = 0; t < nt; t += 2) {
            const bool last = (t == nt - 2);
            const char* a1 = cA + (size_t)(t + 1) * kstep;
            const char* a2 = last ? nA : cA + (size_t)(t + 2) * kstep; const char* b2 = last ? nB : cB + (size_t)(t + 2) * kstep;
            const char* a3 = a2 + kstep; const char* b3 = b2 + kstep;
            if (last && has_next) S.a_ready(nxt);
            if constexpr (SP2) {
            PG8_LDB(B0, 0, 0); PG8_LDB(B1, 0, 1); PG8_SCHED; PG8_LDA(At, 0, 0); PG8_STAGE(PG8_SA(1, 1), a1 + hstep, voffA);
            PG8_WAIT_V(8); PG8_WAIT_L(0); PG8_BAR; PG8_MMA(0, 0, At, B0); PG8_MMA(0, 1, At, B1); PG8_BAR; PG8_SCHED;
            PG8_LDA(At, 0, 1); PG8_STAGE(PG8_SB(0, 0), b2, voffB); PG8_STAGE(PG8_SB(0, 1), b2 + hstep, voffB); PG8_STAGE(PG8_SA(0, 0), a2, voffA);
            PG8_WAIT_V(8); PG8_WAIT_L(0); PG8_BAR; PG8_MMA(1, 0, At, B0); PG8_MMA(1, 1, At, B1); PG8_BAR; PG8_SCHED;
            PG8_LDB(B0, 1, 0); PG8_LDB(B1, 1, 1); PG8_SCHED; PG8_LDA(At, 1, 0); PG8_STAGE(PG8_SA(0, 1), a2 + hstep, voffA);
            PG8_WAIT_V(8); PG8_WAIT_L(0); PG8_BAR; PG8_MMA(0, 0, At, B0); PG8_MMA(0, 1, At, B1); PG8_BAR; PG8_SCHED;
            PG8_LDA(At, 1, 1); PG8_STAGE(PG8_SB(1, 0), b3, voffB); PG8_STAGE(PG8_SB(1, 1), b3 + hstep, voffB); PG8_STAGE(PG8_SA(1, 0), a3, voffA);
            PG8_WAIT_V(8); PG8_WAIT_L(0); PG8_BAR; PG8_MMA(1, 0, At, B0); PG8_MMA(1, 1, At, B1); PG8_BAR; PG8_SCHED;
            } else {
            PG8_LDB(B0, 0, 0); PG8_SCHED; PG8_LDA(At, 0, 0); PG8_STAGE(PG8_SA(1, 1), a1 + hstep, voffA);
            PG8_WAIT_L(8); PG8_BAR; PG8_WAIT_L(0); PG8_MMA(0, 0, At, B0); PG8_BAR; PG8_SCHED;
            PG8_LDB(B1, 0, 1); PG8_STAGE(PG8_SB(0, 0), b2, voffB);
            PG8_BAR; PG8_WAIT_L(0); PG8_MMA(0, 1, At, B1); PG8_BAR;
            PG8_LDA(At, 0, 1); PG8_STAGE(PG8_SA(0, 0), a2, voffA);
            PG8_BAR; PG8_WAIT_L(0); PG8_MMA(1, 0, At, B0); PG8_BAR; PG8_SCHED;
            PG8_STAGE(PG8_SB(0, 1), b2 + hstep, voffB);
            PG8_WAIT_V(6); PG8_BAR; PG8_MMA(1, 1, At, B1); PG8_BAR;
            PG8_LDB(B0, 1, 0); PG8_SCHED; PG8_LDA(At, 1, 0); PG8_STAGE(PG8_SA(0, 1), a2 + hstep, voffA);
            PG8_WAIT_L(8); PG8_BAR; PG8_WAIT_L(0); PG8_MMA(0, 0, At, B0); PG8_BAR; PG8_SCHED;
            PG8_LDB(B1, 1, 1); PG8_STAGE(PG8_SB(1, 0), b3, voffB);
            PG8_BAR; PG8_WAIT_L(0); PG8_MMA(0, 1, At, B1); PG8_BAR;
            PG8_LDA(At, 1, 1); PG8_STAGE(PG8_SA(1, 0), a3, voffA);
            PG8_BAR; PG8_WAIT_L(0); PG8_MMA(1, 0, At, B0); PG8_BAR; PG8_SCHED;
            PG8_STAGE(PG8_SB(1, 1), b3 + hstep, voffB);
            PG8_WAIT_V(6); PG8_BAR; PG8_MMA(1, 1, At, B1); PG8_BAR;
            }
        }
        if constexpr (ALIGN_EPI) { if (wr == 0) PG8_BAR; }
        if constexpr (!Epi::AFTER_DRAIN) { E(acc, cur, wr, wc, fr, fq); S.done(cur); }
        if (!has_next) break;
#pragma unroll
        for (int a = 0; a < 2; ++a)
#pragma unroll
            for (int b = 0; b < 2; ++b)
#pragma unroll
                for (int m = 0; m < 4; ++m)
#pragma unroll
                    for (int n = 0; n < 2; ++n) acc[a][b][m][n] = (f32x4){0.f, 0.f, 0.f, 0.f};
        cur = nxt; cA = nA; cB = nB; ++ui;
        if constexpr (ALIGN_EPI) { if (wr == 1) PG8_BAR; }
    }
    PG8_WAIT_V(0);
    if constexpr (!ALIGN_EPI) { if (wr == 0) PG8_BAR; }
    PG8_BAR;
    if constexpr (Epi::AFTER_DRAIN) { E.fused(acc, cur, wr, wc, fr, fq, lds, wid, lane); S.done(cur); }
#undef PG8_SA
#undef PG8_SB
#undef PG8_STAGE
#undef PG8_LDA
#undef PG8_LDB
#undef PG8_MMA
#undef PG8_WAIT_V
#undef PG8_WAIT_L
#undef PG8_BAR
#undef PG8_SCHED
}
}

#define LAS __attribute__((address_space(3)))
typedef unsigned short bf16;
typedef float f32x4 __attribute__((ext_vector_type(4)));
typedef float f32x2 __attribute__((ext_vector_type(2)));
typedef float f32x16 __attribute__((ext_vector_type(16)));
typedef short bf16x8 __attribute__((ext_vector_type(8)));
typedef short s16x4 __attribute__((ext_vector_type(4)));
typedef unsigned u32x4 __attribute__((ext_vector_type(4)));
typedef unsigned u32x2 __attribute__((ext_vector_type(2)));

constexpr int DM = 1024, NB = 32, TS = 2048, SB = 8, ST = 16, PAST = 4096;
constexpr int NPG = 2;
constexpr int RG = NB * TS / NPG;
constexpr int GBATCH = NB / NPG;
constexpr int NGRP = NPG + 1;
constexpr int NIN = 5888;
constexpr float LOG2E = 1.4426950408889634f;
constexpr float EPSN = 1e-6f;
constexpr int NSPLIT = 4;
constexpr int CACHE_ROWS = SB * PAST;

constexpr size_t O_YP = 0, O_YS = 67108864, O_KDP = 67239936, O_VDP = 134348800, O_CKVP = 201457664, O_KRP = 218234880,
                 O_KDS = 220332032, O_VDS = 220463104, O_CKVS = 220594176, O_KRS = 220626944;
constexpr size_t MiB = 1u << 20;
constexpr size_t WS_TAB = 0;
constexpr size_t WS_ROPE = 8192;
constexpr size_t WS_WIN = 1 * MiB;
constexpr size_t WS_WUQ = WS_WIN + (size_t)NIN * 1024 * 2;
constexpr size_t WS_WUKV = WS_WUQ + 1536 * 256 * 2;
constexpr size_t WS_WOD = WS_WUKV + 2048 * 256 * 2;
constexpr size_t WS_WOM = WS_WOD + 2 * MiB;
constexpr size_t WS_WOUT = WS_WOM + 2 * MiB;
constexpr size_t WS_WUP = WS_WOUT + 2 * MiB;
constexpr size_t WS_WDN = WS_WUP + 8 * MiB;
constexpr size_t WS_WEND = WS_WDN + 8 * MiB;
constexpr size_t WS_SAMP = 37 * MiB;
constexpr size_t WS_PART = 44 * MiB;
constexpr size_t WS_PO_D = WS_PART, WS_PO_M = WS_PART + 8 * MiB, WS_PM = WS_PART + 12 * MiB, WS_PL = WS_PM + 131072;
constexpr size_t WS_PROMPT = 58 * MiB;
constexpr size_t GRP_BYTES_PER_ROW = 27712;
constexpr size_t WS_NEED = WS_PROMPT + (size_t)RG * GRP_BYTES_PER_ROW;
static_assert(WS_WEND <= WS_SAMP && WS_SAMP + 256 * GRP_BYTES_PER_ROW <= WS_PART && WS_PL + 131072 <= WS_PROMPT, "ws map");
constexpr size_t C_KDC = 0, C_VDC = 64 * MiB, C_KNC = 128 * MiB, C_VMC = 192 * MiB, C_CKVC = 256 * MiB, C_KRC = 272 * MiB;

struct Args { const float* in[26]; float* out; unsigned char* ws; int pad0, pad1; };

struct Grp {
    const float* x; float* y; float* okd; float* ovd; float* ockv; float* okr;
    int nvalid, ntiles, sample;
    bf16 *QD, *KD, *VD, *QN, *U, *XN, *QR, *KN, *VM, *GD, *GM, *DO, *MO, *CQ, *CKV, *KR; float* ZS;
};
__device__ __forceinline__ Grp make_grp(const Args& a, int g) {
    Grp G; unsigned char* base; size_t RC;
    if (g == 0) {
        G.x = a.in[1]; G.y = a.out + O_YS; G.okd = a.out + O_KDS; G.ovd = a.out + O_VDS; G.ockv = a.out + O_CKVS; G.okr = a.out + O_KRS;
        G.nvalid = SB * ST; G.ntiles = 1; G.sample = 1; base = a.ws + WS_SAMP; RC = 256;
    } else {
        const size_t r0 = (size_t)(g - 1) * RG;
        G.x = a.in[0] + r0 * 1024; G.y = a.out + O_YP + r0 * 1024; G.okd = a.out + O_KDP + r0 * 1024; G.ovd = a.out + O_VDP + r0 * 1024;
        G.ockv = a.out + O_CKVP + r0 * 256; G.okr = a.out + O_KRP + r0 * 32;
        G.nvalid = RG; G.ntiles = RG / 256; G.sample = 0; base = a.ws + WS_PROMPT; RC = RG;
    }
    G.QD = (bf16*)(base); G.KD = (bf16*)(base + RC * 2048); G.VD = (bf16*)(base + RC * 4096); G.QN = (bf16*)(base + RC * 6144); G.U = (bf16*)base;
    G.XN = (bf16*)(base + RC * 8192); G.QR = (bf16*)(base + RC * 10240); G.KN = (bf16*)(base + RC * 11264); G.VM = (bf16*)(base + RC * 13312);
    G.GD = (bf16*)(base + RC * 15360); G.GM = (bf16*)(base + RC * 17408); G.DO = (bf16*)(base + RC * 19456); G.MO = (bf16*)(base + RC * 21504);
    G.ZS = (float*)(base + RC * 23552); G.CQ = (bf16*)(base + RC * 26624); G.CKV = (bf16*)(base + RC * 27136); G.KR = (bf16*)(base + RC * 27648);
    return G;
}

template <int M> __device__ __forceinline__ float swz_xor(float v) { return __int_as_float(__builtin_amdgcn_ds_swizzle(__float_as_int(v), 0x1F | (M << 10))); }
__device__ __forceinline__ float half_sum32(float v) { v += swz_xor<1>(v); v += swz_xor<2>(v); v += swz_xor<4>(v); v += swz_xor<8>(v); v += swz_xor<16>(v); return v; }
__device__ __forceinline__ float wave_sum(float v) {
    v = half_sum32(v);
    auto rr = __builtin_amdgcn_permlane32_swap(__float_as_uint(v), __float_as_uint(v), false, false);
    return __uint_as_float(rr[0]) + __uint_as_float(rr[1]);
}
__device__ __forceinline__ unsigned f2bf(float f) { unsigned u = __builtin_bit_cast(unsigned, f); return (u + 0x7fffu + ((u >> 16) & 1u)) >> 16; }
__device__ __forceinline__ unsigned pk2(float lo, float hi) { return f2bf(lo) | (f2bf(hi) << 16); }
__device__ __forceinline__ float bflo(unsigned w) { return __builtin_bit_cast(float, w << 16); }
__device__ __forceinline__ float bfhi(unsigned w) { return __builtin_bit_cast(float, w & 0xffff0000u); }
__device__ __forceinline__ void st_bf4(bf16* p, f32x4 v) { u32x2 w; w.x = pk2(v[0], v[1]); w.y = pk2(v[2], v[3]); *(u32x2*)p = w; }
__device__ __forceinline__ f32x4 ld_bf4(const bf16* p) { const u32x2 w = *(const u32x2*)p; return (f32x4){bflo(w.x), bfhi(w.x), bflo(w.y), bfhi(w.y)}; }
__device__ __forceinline__ float sigm(float x) { return 1.f / (1.f + __expf(-x)); }

#define EPI_LOOP(BODY) \
    _Pragma("unroll") for (int ai = 0; ai < 2; ++ai) _Pragma("unroll") for (int m = 0; m < 4; ++m) { const int row = u.pm * 256 + ai * 128 + wr * 64 + m * 16 + fr; const size_t rw = (size_t)row; (void)rw; \
    _Pragma("unroll") for (int bj = 0; bj < 2; ++bj) _Pragma("unroll") for (int n = 0; n < 2; ++n) { const int cl = bj * 128 + wc * 32 + n * 16 + 4 * fq; const f32x4 v = acc[ai][bj][m][n]; BODY } }

typedef const f32x4 (&AccRef)[2][2][4][2];

struct EpiIn {
    static constexpr bool PERM = false, AFTER_DRAIN = false;
    bf16 *QD, *KD, *VD, *GD, *GM; float *ZS, *okd, *ovd; int nvalid; float qs;
    __device__ __forceinline__ void operator()(AccRef acc, const pg8::Unit& u, int wr, int wc, int fr, int fq) const {
        const int t = u.pn;
        if (t < 4) { const int c0 = t * 256; EPI_LOOP( st_bf4(QD + rw * 1024 + c0 + cl, v * qs); ) }
        else if (t < 8) { const int c0 = (t - 4) * 256; EPI_LOOP( st_bf4(KD + rw * 1024 + c0 + cl, v); if (row < nvalid) *(f32x4*)(okd + rw * 1024 + c0 + cl) = v; ) }
        else if (t < 12) { const int c0 = (t - 8) * 256; EPI_LOOP( st_bf4(VD + rw * 1024 + c0 + cl, v); if (row < nvalid) *(f32x4*)(ovd + rw * 1024 + c0 + cl) = v; ) }
        else if (t < 15) { const int c0 = (t - 12) * 256; EPI_LOOP( *(f32x4*)(ZS + rw * 768 + c0 + cl) = v; ) }
        else if (t < 19) { const int c0 = (t - 15) * 256; EPI_LOOP( st_bf4(GD + rw * 1024 + c0 + cl, ((f32x4){sigm(v[0]), sigm(v[1]), sigm(v[2]), sigm(v[3])})); ) }
        else { const int c0 = (t - 19) * 256; EPI_LOOP( st_bf4(GM + rw * 1024 + c0 + cl, ((f32x4){sigm(v[0]), sigm(v[1]), sigm(v[2]), sigm(v[3])})); ) }
    }
};
struct EpiQ {
    static constexpr bool PERM = false, AFTER_DRAIN = false;
    bf16 *QN, *QR; const float* rope; int sample; float qs;
    __device__ __forceinline__ void operator()(AccRef acc, const pg8::Unit& u, int wr, int wc, int fr, int fq) const {
        const int t = u.pn;
        if (t < 4) { const int c0 = t * 256; EPI_LOOP( st_bf4(QN + rw * 1024 + c0 + cl, v * qs); ) }
        else {
            const int c0 = (t - 4) * 256;
#pragma unroll
            for (int ai = 0; ai < 2; ++ai)
#pragma unroll
                for (int m = 0; m < 4; ++m) {
                    const int row = u.pm * 256 + ai * 128 + wr * 64 + m * 16 + fr;
                    const int pos = sample ? (PAST + (row & (ST - 1))) : (row & (TS - 1));
                    const f32x4 cs0 = *(const f32x4*)(rope + (size_t)pos * 32 + 8 * fq), cs1 = *(const f32x4*)(rope + (size_t)pos * 32 + 8 * fq + 4);
#pragma unroll
                    for (int bj = 0; bj < 2; ++bj) {
                        const f32x4 x1 = acc[ai][bj][m][0], x2 = acc[ai][bj][m][1];
                        f32x4 o1, o2;
                        o1[0] = x1[0] * cs0[0] - x2[0] * cs0[1]; o2[0] = x2[0] * cs0[0] + x1[0] * cs0[1];
                        o1[1] = x1[1] * cs0[2] - x2[1] * cs0[3]; o2[1] = x2[1] * cs0[2] + x1[1] * cs0[3];
                        o1[2] = x1[2] * cs1[0] - x2[2] * cs1[1]; o2[2] = x2[2] * cs1[0] + x1[2] * cs1[1];
                        o1[3] = x1[3] * cs1[2] - x2[3] * cs1[3]; o2[3] = x2[3] * cs1[2] + x1[3] * cs1[3];
                        bf16* p = QR + (size_t)row * 512 + c0 + bj * 128 + wc * 32 + 4 * fq;
                        st_bf4(p, o1 * qs); st_bf4(p + 16, o2 * qs);
                    }
                }
        }
    }
};
struct EpiKV {
    static constexpr bool PERM = false, AFTER_DRAIN = false;
    bf16 *KN, *VM;
    __device__ __forceinline__ void operator()(AccRef acc, const pg8::Unit& u, int wr, int wc, int fr, int fq) const {
        const int t = u.pn; bf16* O = t < 4 ? KN : VM; const int c0 = (t & 3) * 256;
        EPI_LOOP( st_bf4(O + rw * 1024 + c0 + cl, v); )
    }
};
struct EpiM1 {
    static constexpr bool PERM = false, AFTER_DRAIN = false;
    const bf16* Gt; bf16* MG;
    __device__ __forceinline__ void operator()(AccRef acc, const pg8::Unit& u, int wr, int wc, int fr, int fq) const {
        const int c0 = u.pn * 256;
        EPI_LOOP( const f32x4 g = ld_bf4(Gt + rw * 1024 + c0 + cl); st_bf4(MG + rw * 1024 + c0 + cl, g * v); )
    }
};
struct EpiM2 {
    static constexpr bool PERM = false, AFTER_DRAIN = false;
    const bf16* Gt; bf16* MG;
    __device__ __forceinline__ void operator()(AccRef acc, const pg8::Unit& u, int wr, int wc, int fr, int fq) const {
        const int c0 = u.pn * 256;
        EPI_LOOP( const f32x4 g = ld_bf4(Gt + rw * 1024 + c0 + cl); const f32x4 o = ld_bf4(MG + rw * 1024 + c0 + cl); st_bf4(MG + rw * 1024 + c0 + cl, o + g * v); )
    }
};
struct EpiOut {
    static constexpr bool PERM = false, AFTER_DRAIN = false;
    const float* x; float* y; int nvalid;
    __device__ __forceinline__ void operator()(AccRef acc, const pg8::Unit& u, int wr, int wc, int fr, int fq) const {
        const int c0 = u.pn * 256;
        EPI_LOOP( if (row < nvalid) { const f32x4 b = *(const f32x4*)(x + rw * 1024 + c0 + cl); *(f32x4*)(y + rw * 1024 + c0 + cl) = b + v; } )
    }
};
struct EpiUp {
    static constexpr bool PERM = false, AFTER_DRAIN = false;
    bf16* U;
    __device__ __forceinline__ void operator()(AccRef acc, const pg8::Unit& u, int wr, int wc, int fr, int fq) const {
        const int c0 = u.pn * 256;
        EPI_LOOP( f32x4 r; r[0] = fmaxf(v[0], 0.f); r[1] = fmaxf(v[1], 0.f); r[2] = fmaxf(v[2], 0.f); r[3] = fmaxf(v[3], 0.f); st_bf4(U + rw * 4096 + c0 + cl, r * r); )
    }
};
struct EpiDown {
    static constexpr bool PERM = false, AFTER_DRAIN = false;
    float* y; int nvalid;
    __device__ __forceinline__ void operator()(AccRef acc, const pg8::Unit& u, int wr, int wc, int fr, int fq) const {
        const int c0 = u.pn * 256;
        EPI_LOOP( if (row < nvalid) { float* p = y + rw * 1024 + c0 + cl; *(f32x4*)p = *(const f32x4*)p + v; } )
    }
};

template <class Epi>
__device__ __forceinline__ void run_gemm(LAS unsigned char* lds, const bf16* A, const bf16* Bt, int M, int N, int K, const Epi& E) {
    pg8::Gemm g{A, Bt, M, N, K}; pg8::StaticOrder S; S.init(M, N, (int)gridDim.x, (int)blockIdx.x);
    pg8::gemm_phase<Epi, pg8::StaticOrder, true, true>(lds, g, S, E);
}

__device__ __forceinline__ void rms_rows_bf16(const float* src, bf16* dst, const float* gain, int nvalid, int ntotal, int gw, int ngw, int lane) {
    for (int r = gw; r < ntotal; r += ngw) {
        u32x2* o8 = (u32x2*)(dst + (size_t)r * 1024) + lane;
        if (r >= nvalid) {
#pragma unroll
            for (int j = 0; j < 4; ++j) o8[64 * j] = (u32x2){0u, 0u};
            continue;
        }
        const f32x4* xr = (const f32x4*)(src + (size_t)r * 1024) + lane;
        f32x4 v[4]; float s = 0.f;
#pragma unroll
        for (int j = 0; j < 4; ++j) { v[j] = xr[64 * j]; s += (v[j][0] * v[j][0] + v[j][1] * v[j][1]) + (v[j][2] * v[j][2] + v[j][3] * v[j][3]); }
        const float rs = 1.0f / sqrtf(wave_sum(s) * (1.f / 1024.f) + EPSN);
#pragma unroll
        for (int j = 0; j < 4; ++j) { const f32x4 g = ((const f32x4*)gain)[lane + 64 * j]; const f32x4 o = v[j] * rs * g; o8[64 * j] = (u32x2){pk2(o[0], o[1]), pk2(o[2], o[3])}; }
    }
}
__device__ __forceinline__ void rms_rows_f32_inplace(float* y, const float* gain, int nvalid, int gw, int ngw, int lane) {
    for (int r = gw; r < nvalid; r += ngw) {
        f32x4* xr = (f32x4*)(y + (size_t)r * 1024) + lane;
        f32x4 v[4]; float s = 0.f;
#pragma unroll
        for (int j = 0; j < 4; ++j) { v[j] = xr[64 * j]; s += (v[j][0] * v[j][0] + v[j][1] * v[j][1]) + (v[j][2] * v[j][2] + v[j][3] * v[j][3]); }
        const float rs = 1.0f / sqrtf(wave_sum(s) * (1.f / 1024.f) + EPSN);
#pragma unroll
        for (int j = 0; j < 4; ++j) { const f32x4 g = ((const f32x4*)gain)[lane + 64 * j]; xr[64 * j] = v[j] * rs * g; }
    }
}
__device__ __forceinline__ void phase_small(const Grp& G, const float* gq, const float* gkv, const float* rope, int gw, int ngw, int lane) {
    const int ntotal = G.ntiles * 256;
    for (int r = gw; r < ntotal; r += ngw) {
        const float* z = G.ZS + (size_t)r * 768;
        const f32x4 cq = ((const f32x4*)z)[lane], ck = ((const f32x4*)(z + 256))[lane];
        const float s1 = wave_sum((cq[0] * cq[0] + cq[1] * cq[1]) + (cq[2] * cq[2] + cq[3] * cq[3]));
        const float s2 = wave_sum((ck[0] * ck[0] + ck[1] * ck[1]) + (ck[2] * ck[2] + ck[3] * ck[3]));
        const float r1 = 1.0f / sqrtf(s1 * (1.f / 256.f) + EPSN), r2 = 1.0f / sqrtf(s2 * (1.f / 256.f) + EPSN);
        const f32x4 o1 = cq * r1 * ((const f32x4*)gq)[lane], o2 = ck * r2 * ((const f32x4*)gkv)[lane];
        ((u32x2*)(G.CQ + (size_t)r * 256))[lane] = (u32x2){pk2(o1[0], o1[1]), pk2(o1[2], o1[3])};
        ((u32x2*)(G.CKV + (size_t)r * 256))[lane] = (u32x2){pk2(o2[0], o2[1]), pk2(o2[2], o2[3])};
        if (r < G.nvalid) ((f32x4*)(G.ockv + (size_t)r * 256))[lane] = o2;
        if (lane < 16) {
            const int pos = G.sample ? (PAST + (r & (ST - 1))) : (r & (TS - 1));
            const float x1 = z[512 + lane], x2 = z[512 + 16 + lane];
            const f32x2 cs = *(const f32x2*)(rope + (size_t)pos * 32 + 2 * lane);
            const float a = x1 * cs[0] - x2 * cs[1], b = x2 * cs[0] + x1 * cs[1];
            G.KR[(size_t)r * 32 + lane] = (bf16)f2bf(a); G.KR[(size_t)r * 32 + 16 + lane] = (bf16)f2bf(b);
            if (r < G.nvalid) { G.okr[(size_t)r * 32 + lane] = a; G.okr[(size_t)r * 32 + 16 + lane] = b; }
        }
    }
}

__device__ __forceinline__ void tr_item(const float* W, int K, int N, bf16* WT, int k0, int n0, int drow0, LAS float* scr, int lane) {
#pragma unroll 8
    for (int i = 0; i < 32; ++i) { const int kk = 2 * i + (lane >> 5); scr[kk * 33 + (lane & 31)] = W[(size_t)(k0 + kk) * N + n0 + (lane & 31)]; }
    asm volatile("s_waitcnt lgkmcnt(0)" ::: "memory");
    const int c = lane & 7;
#pragma unroll
    for (int j = 0; j < 4; ++j) { const int n = (lane >> 3) + 8 * j; const LAS float* s = scr + (8 * c) * 33 + n;
        u32x4 o; o.x = pk2(s[0 * 33], s[1 * 33]); o.y = pk2(s[2 * 33], s[3 * 33]); o.z = pk2(s[4 * 33], s[5 * 33]); o.w = pk2(s[6 * 33], s[7 * 33]);
        *(u32x4*)(WT + (size_t)(drow0 + n) * K + k0 + 8 * c) = o; }
    asm volatile("s_waitcnt lgkmcnt(0)" ::: "memory");
}
__device__ __forceinline__ int map_in(int n0) {
    if (n0 < 3616) return n0;
    if (n0 < 4640) return n0 - 3616 + 3840;
    return n0 - 4640 + 4864;
}
__device__ __forceinline__ int map_uq(int n0) { const int hh = n0 / 96, d0 = n0 % 96; return d0 < 64 ? hh * 64 + d0 : 1024 + hh * 32 + (d0 - 64); }
__device__ __forceinline__ void cvt8(const float* src, bf16* dst, size_t n8, size_t gt, size_t ngt) {
    for (size_t i = gt; i < n8; i += ngt) { const f32x4 a = ((const f32x4*)src)[2 * i], b = ((const f32x4*)src)[2 * i + 1];
        ((u32x4*)dst)[i] = (u32x4){pk2(a[0], a[1]), pk2(a[2], a[3]), pk2(b[0], b[1]), pk2(b[2], b[3])}; }
}
__device__ __forceinline__ void phase_prologue(const Args& a, LAS unsigned char* lds, int gw, int ngw, int lane, int wave) {
    unsigned char* ws = a.ws;
    LAS float* scr = (LAS float*)(lds + wave * 16384);
    constexpr int I_IN = 16 * 177, I_UQ = 4 * 48, I_UK = 4 * 32, I_UV = 4 * 32, I_O = 16 * 32, I_UP = 16 * 128, I_DN = 64 * 32;
    constexpr int NITEMS = I_IN + I_UQ + I_UK + I_UV + 3 * I_O + I_UP + I_DN;
    for (int it = gw; it < NITEMS; it += ngw) {
        int r = it;
        if (r < I_IN) { const int kb = r / 177, nb = r % 177; tr_item(a.in[8], 1024, 5664, (bf16*)(ws + WS_WIN), 64 * kb, 32 * nb, map_in(32 * nb), scr, lane); continue; } r -= I_IN;
        if (r < I_UQ) { const int kb = r / 48, nb = r % 48; tr_item(a.in[15], 256, 1536, (bf16*)(ws + WS_WUQ), 64 * kb, 32 * nb, map_uq(32 * nb), scr, lane); continue; } r -= I_UQ;
        if (r < I_UK) { const int kb = r / 32, nb = r % 32; tr_item(a.in[17], 256, 1024, (bf16*)(ws + WS_WUKV), 64 * kb, 32 * nb, 32 * nb, scr, lane); continue; } r -= I_UK;
        if (r < I_UV) { const int kb = r / 32, nb = r % 32; tr_item(a.in[18], 256, 1024, (bf16*)(ws + WS_WUKV), 64 * kb, 32 * nb, 1024 + 32 * nb, scr, lane); continue; } r -= I_UV;
        if (r < I_O) { const int kb = r / 32, nb = r % 32; tr_item(a.in[19], 1024, 1024, (bf16*)(ws + WS_WOD), 64 * kb, 32 * nb, 32 * nb, scr, lane); continue; } r -= I_O;
        if (r < I_O) { const int kb = r / 32, nb = r % 32; tr_item(a.in[20], 1024, 1024, (bf16*)(ws + WS_WOM), 64 * kb, 32 * nb, 32 * nb, scr, lane); continue; } r -= I_O;
        if (r < I_O) { const int kb = r / 32, nb = r % 32; tr_item(a.in[21], 1024, 1024, (bf16*)(ws + WS_WOUT), 64 * kb, 32 * nb, 32 * nb, scr, lane); continue; } r -= I_O;
        if (r < I_UP) { const int kb = r / 128, nb = r % 128; tr_item(a.in[23], 1024, 4096, (bf16*)(ws + WS_WUP), 64 * kb, 32 * nb, 32 * nb, scr, lane); continue; } r -= I_UP;
        { const int kb = r / 32, nb = r % 32; tr_item(a.in[24], 4096, 1024, (bf16*)(ws + WS_WDN), 64 * kb, 32 * nb, 32 * nb, scr, lane); }
    }
    const size_t gt = (size_t)gw * 64 + lane, ngt = (size_t)ngw * 64;
    { u32x4* z = (u32x4*)(ws + WS_WIN + (size_t)3616 * 2048); for (size_t i = gt; i < (size_t)224 * 128; i += ngt) z[i] = (u32x4){0u, 0u, 0u, 0u}; }
    unsigned char* cb = ws + WS_PROMPT;
    cvt8(a.in[2], (bf16*)(cb + C_KDC), (size_t)CACHE_ROWS * 128, gt, ngt);
    cvt8(a.in[3], (bf16*)(cb + C_VDC), (size_t)CACHE_ROWS * 128, gt, ngt);
    cvt8(a.in[4], (bf16*)(cb + C_CKVC), (size_t)CACHE_ROWS * 32, gt, ngt);
    cvt8(a.in[5], (bf16*)(cb + C_KRC), (size_t)CACHE_ROWS * 4, gt, ngt);
    float* tab = (float*)(ws + WS_TAB);
    for (size_t i = gt; i < 8 * 192; i += ngt) {
        const int h = (int)i / 192, idx = (int)i % 192, rel = idx - 128, n = rel < 0 ? -rel : rel;
        int bucket = n;
        if (n >= 8) { int j = (31 - __clz(n * n)) - 6; bucket = 8 + j; if (bucket > 15) bucket = 15; }
        if (rel > 0) bucket += 16;
        tab[i] = a.in[6][bucket * 8 + h] * LOG2E;
    }
    if (gt == 0) {
        float d1 = 0.f, d2 = 0.f;
        for (int i = 0; i < 64; ++i) { d1 += a.in[9][i] * a.in[10][i]; d2 += a.in[11][i] * a.in[12][i]; }
        tab[1536] = expf(d1) - expf(d2) + 0.2f;
    }
    float* rope = (float*)(ws + WS_ROPE);
    for (size_t i = gt; i < (size_t)(PAST + ST) * 16; i += ngt) {
        const int pos = (int)(i >> 4), k = (int)(i & 15);
        const float inv = __builtin_amdgcn_exp2f(-(float)k * 0.8304820237218406f);
        const float ang = (float)pos * inv;
        const double rev = (double)ang * 0.15915494309189535;
        const float fr = (float)(rev - __builtin_rint(rev));
        rope[2 * i] = __builtin_amdgcn_cosf(fr); rope[2 * i + 1] = __builtin_amdgcn_sinf(fr);
    }
}

#ifndef ATTMASK
#define ATTMASK 15
#endif
constexpr int AL_TAB = 0, AL_WSF = 6144, AL_TILE = 8192;

__device__ __forceinline__ int crow(int r, int hi) { return (r & 3) + 8 * (r >> 2) + 4 * hi; }
__device__ __forceinline__ float xmax32(float v) { auto rr = __builtin_amdgcn_permlane32_swap(__float_as_uint(v), __float_as_uint(v), false, false); return fmaxf(__uint_as_float(rr[0]), __uint_as_float(rr[1])); }
__device__ __forceinline__ float xsum32(float v) { auto rr = __builtin_amdgcn_permlane32_swap(__float_as_uint(v), __float_as_uint(v), false, false); return __uint_as_float(rr[0]) + __uint_as_float(rr[1]); }
typedef __bf16 bf16x2_t __attribute__((ext_vector_type(2)));
__device__ __forceinline__ unsigned cvtpk(float lo, float hi) { f32x2 v = {lo, hi}; bf16x2_t b = __builtin_convertvector(v, bf16x2_t); return __builtin_bit_cast(unsigned, b); }
__device__ __forceinline__ bf16x8 pack8(float a0, float a1, float a2, float a3, float a4, float a5, float a6, float a7) {
    u32x4 w = {cvtpk(a0, a1), cvtpk(a2, a3), cvtpk(a4, a5), cvtpk(a6, a7)}; return __builtin_bit_cast(bf16x8, w);
}
typedef short v4i16_t __attribute__((ext_vector_type(4)));
__device__ __forceinline__ s16x4 vtr(const LAS unsigned char* p) { return __builtin_bit_cast(s16x4, __builtin_amdgcn_ds_read_tr16_b64_v4i16((LAS v4i16_t*)p)); }

template <int DQK, int DV> struct AttnState { bf16x8 qf[DQK / 16]; f32x16 o[DV / 32]; float m, l; };

template <int DQK, int DV, bool HAS_BIAS>
__device__ __forceinline__ void attn_tile(AttnState<DQK, DV>& st, const LAS unsigned char* Kt, const LAS unsigned char* Vt, int bias_mode, float cbias, const LAS float* tab, int rel0, int nkeys, LAS float* wsf, int lane) {
    constexpr int PK = DQK * 2 + 16, PV = DV * 2 + 64, KS = DQK / 16, NDB = DV / 32;
    const int q = lane & 31, hi = lane >> 5;
    f32x16 p0, p1;
    if (HAS_BIAS && bias_mode == 2) {
#pragma unroll
        for (int r = 0; r < 16; ++r) {
            const int k = crow(r, hi);
            const int i0 = min(max(rel0 + k + 128, 0), 191), i1 = min(max(rel0 + k + 160, 0), 191);
            p0[r] = tab[i0]; p1[r] = tab[i1];
        }
    } else {
        const float ini = (HAS_BIAS && bias_mode == 1) ? cbias : 0.f;
#pragma unroll
        for (int r = 0; r < 16; ++r) { p0[r] = ini; p1[r] = ini; }
    }
    const LAS unsigned char* kp = Kt + q * PK + hi * 16;
#pragma unroll
    for (int ks = 0; ks < KS; ++ks) {
        const bf16x8 a0 = *(const LAS bf16x8*)(kp + ks * 32);
        const bf16x8 a1 = *(const LAS bf16x8*)(kp + 32 * PK + ks * 32);
        p0 = __builtin_amdgcn_mfma_f32_32x32x16_bf16(a0, st.qf[ks], p0, 0, 0, 0);
        p1 = __builtin_amdgcn_mfma_f32_32x32x16_bf16(a1, st.qf[ks], p1, 0, 0, 0);
    }
    __builtin_amdgcn_sched_barrier(0);
    if (nkeys < 64) {
#pragma unroll
        for (int r = 0; r < 16; ++r) { const int k = crow(r, hi); if (k >= nkeys) p0[r] = -1e30f; if (k + 32 >= nkeys) p1[r] = -1e30f; }
    }
    float mx = fmaxf(p0[0], p1[0]);
#pragma unroll
    for (int r = 1; r < 16; ++r) mx = fmaxf(mx, fmaxf(p0[r], p1[r]));
    mx = xmax32(mx);
    const float mnew = fmaxf(st.m, mx);
    if (__any(mnew > st.m)) {
        const float f = __builtin_amdgcn_exp2f(st.m - mnew);
        st.l *= f; st.m = mnew;
        if (hi == 0) wsf[q] = f;
#pragma unroll
        for (int r = 0; r < 16; ++r) { const float fr = wsf[crow(r, hi)];
#pragma unroll
            for (int db = 0; db < NDB; ++db) st.o[db][r] *= fr; }
    }
    float sum = 0.f;
#pragma unroll
    for (int r = 0; r < 16; ++r) { p0[r] = __builtin_amdgcn_exp2f(p0[r] - st.m); p1[r] = __builtin_amdgcn_exp2f(p1[r] - st.m); sum += p0[r] + p1[r]; }
    st.l += sum;
    bf16x8 pf[4];
    pf[0] = pack8(p0[0], p0[1], p0[2], p0[3], p0[4], p0[5], p0[6], p0[7]);
    pf[1] = pack8(p0[8], p0[9], p0[10], p0[11], p0[12], p0[13], p0[14], p0[15]);
    pf[2] = pack8(p1[0], p1[1], p1[2], p1[3], p1[4], p1[5], p1[6], p1[7]);
    pf[3] = pack8(p1[8], p1[9], p1[10], p1[11], p1[12], p1[13], p1[14], p1[15]);
    __builtin_amdgcn_sched_barrier(0);
    const int q4 = (lane & 15) >> 2, blk = (lane >> 4) & 1, pp = lane & 3;
    const LAS unsigned char* vp = Vt + (4 * hi + q4) * PV + (16 * blk + 4 * pp) * 2;
#pragma unroll
    for (int db = 0; db < NDB; ++db) {
#pragma unroll
        for (int s4 = 0; s4 < 4; ++s4) {
            const s16x4 lo = vtr(vp + (16 * s4) * PV + db * 64), h4 = vtr(vp + (16 * s4 + 8) * PV + db * 64);
            const bf16x8 vb = {lo[0], lo[1], lo[2], lo[3], h4[0], h4[1], h4[2], h4[3]};
            st.o[db] = __builtin_amdgcn_mfma_f32_32x32x16_bf16(pf[s4], vb, st.o[db], 0, 0, 0);
        }
        if (NDB > 2 && (db & 1)) __builtin_amdgcn_sched_barrier(0);
    }
}

template <int DQK, int DV>
__device__ __forceinline__ void attn_init(AttnState<DQK, DV>& st) {
    st.m = -1e30f; st.l = 0.f;
#pragma unroll
    for (int db = 0; db < DV / 32; ++db)
#pragma unroll
        for (int r = 0; r < 16; ++r) st.o[db][r] = 0.f;
}

template <bool DIFF>
__device__ __forceinline__ void attn_unit_coop(const Grp& G, int b, int h, int qb, LAS unsigned char* lds, float lam, const float* subln) {
    constexpr int DQK = DIFF ? 64 : 96, DV = DIFF ? 128 : 64, PK = DQK * 2 + 16, PV = DV * 2 + 64, KB = 64 * PK, VB = 64 * PV, TB = KB + VB, NDB = DV / 32;
    int tid_ = threadIdx.x; asm volatile("" : "+v"(tid_));
    const int tid = tid_, lane = tid & 63, wid = __builtin_amdgcn_readfirstlane(tid >> 6), q = lane & 31, hi = lane >> 5;
    const size_t seq0 = (size_t)b * TS;
    const int qrow0 = qb * 256 + wid * 32;
    const int NT = 4 * qb + 4, my_nt = 4 * qb + (wid >> 1) + 1;
    const LAS float* tab = (const LAS float*)(lds + AL_TAB) + h * 192;
    LAS float* wsf = (LAS float*)(lds + AL_WSF) + wid * 64;
    LAS unsigned char* tiles = lds + AL_TILE;
    const float cbias = DIFF ? tab[0] : 0.f;
#pragma unroll 1
    for (int n = 0; n < (DIFF ? 2 : 1); ++n) {
        AttnState<DQK, DV> st; attn_init(st);
        if (DIFF) { const bf16* qp = G.QD + (seq0 + qrow0 + q) * 1024 + h * 128 + n * 64 + hi * 8;
#pragma unroll
            for (int ks = 0; ks < 4; ++ks) st.qf[ks] = *(const bf16x8*)(qp + ks * 16);
        } else { const bf16* qn = G.QN + (seq0 + qrow0 + q) * 1024 + h * 64 + hi * 8; const bf16* qr = G.QR + (seq0 + qrow0 + q) * 512 + h * 32 + hi * 8;
#pragma unroll
            for (int ks = 0; ks < 4; ++ks) st.qf[ks] = *(const bf16x8*)(qn + ks * 16);
#pragma unroll
            for (int ks = 0; ks < 2; ++ks) st.qf[4 + ks] = *(const bf16x8*)(qr + ks * 16);
        }
        const bf16* ksrc = (DIFF ? G.KD + h * 128 + n * 64 : G.KN + h * 64) + (seq0 + (tid >> 3)) * 1024 + (tid & 7) * 8;
        const int kdst = (tid >> 3) * PK + (tid & 7) * 16;
        const bf16* k2src = G.KR + (seq0 + ((tid & 255) >> 2)) * 32 + (tid & 3) * 8;
        const int k2dst = ((tid & 255) >> 2) * PK + 128 + (tid & 3) * 16;
        const bf16* vsrc = DIFF ? G.VD + (seq0 + (tid >> 4)) * 1024 + h * 128 + (tid & 15) * 8 : G.VM + (seq0 + (tid >> 3)) * 1024 + h * 64 + (tid & 7) * 8;
        const int vdst = DIFF ? KB + (tid >> 4) * PV + (tid & 15) * 16 : KB + (tid >> 3) * PV + (tid & 7) * 16;
        u32x4 rk, rk2 = {0u, 0u, 0u, 0u}, rv0, rv1 = {0u, 0u, 0u, 0u};
#define ATT_LOAD(j) do { rk = *(const u32x4*)(ksrc + (size_t)(j) * 64 * 1024); if (!DIFF && tid < 256) rk2 = *(const u32x4*)(k2src + (size_t)(j) * 64 * 32); \
        rv0 = *(const u32x4*)(vsrc + (size_t)(j) * 64 * 1024); if (DIFF) rv1 = *(const u32x4*)(vsrc + (size_t)(j) * 64 * 1024 + 32 * 1024); } while (0)
#define ATT_STORE(bufp) do { *(LAS u32x4*)((bufp) + kdst) = rk; if (!DIFF && tid < 256) *(LAS u32x4*)((bufp) + k2dst) = rk2; \
        *(LAS u32x4*)((bufp) + vdst) = rv0; if (DIFF) *(LAS u32x4*)((bufp) + vdst + 32 * PV) = rv1; } while (0)
        ATT_LOAD(0); ATT_STORE(tiles);
        __syncthreads();
        for (int j = 0; j < NT; ++j) {
            LAS unsigned char* cur = tiles + (j & 1) * TB; LAS unsigned char* nxt = tiles + ((j + 1) & 1) * TB;
            if (j + 1 < NT) ATT_LOAD(j + 1);
            if (j < my_nt) {
                const int kb = 64 * j;
                const int mode = DIFF ? ((kb + 63 - qrow0 <= -128) ? 1 : 2) : 0;
                attn_tile<DQK, DV, DIFF>(st, cur, cur + KB, mode, cbias, tab, kb - (qrow0 + q), 64, wsf, lane);
            }
            if (j + 1 < NT) ATT_STORE(nxt);
            __syncthreads();
        }
#undef ATT_LOAD
#undef ATT_STORE
        const float lt = xsum32(st.l);
        if (hi == 0) wsf[32 + q] = lt;
        float inv[16];
#pragma unroll
        for (int r = 0; r < 16; ++r) inv[r] = 1.0f / wsf[32 + crow(r, hi)];
        bf16* obase = (DIFF ? (n == 0 ? G.DO : G.XN) + h * 128 : G.MO + h * 64) + (seq0 + qrow0) * 1024 + q;
#pragma unroll
        for (int db = 0; db < NDB; ++db)
#pragma unroll
            for (int r = 0; r < 16; ++r) obase[(size_t)crow(r, hi) * 1024 + db * 32] = (bf16)f2bf(st.o[db][r] * inv[r]);
    }
}

__device__ __forceinline__ void phase_diffmix(const Grp& G, float lam, const float* subln, int gw, int ngw, int lane) {
    const int c = (lane & 7) * 16;
    float g[16];
#pragma unroll
    for (int i = 0; i < 16; ++i) g[i] = subln[c + i] * 0.8f;
    for (int r = gw; r < G.nvalid; r += ngw) {
        bf16* p1 = G.DO + (size_t)r * 1024 + lane * 16; const bf16* p2 = G.XN + (size_t)r * 1024 + lane * 16;
        const u32x4 a0 = ((const u32x4*)p1)[0], a1 = ((const u32x4*)p1)[1], b0 = ((const u32x4*)p2)[0], b1 = ((const u32x4*)p2)[1];
        float v[16];
#pragma unroll
        for (int i = 0; i < 4; ++i) { v[2 * i] = bflo(a0[i]) - lam * bflo(b0[i]); v[2 * i + 1] = bfhi(a0[i]) - lam * bfhi(b0[i]);
                                      v[8 + 2 * i] = bflo(a1[i]) - lam * bflo(b1[i]); v[8 + 2 * i + 1] = bfhi(a1[i]) - lam * bfhi(b1[i]); }
        float s = 0.f;
#pragma unroll
        for (int i = 0; i < 16; ++i) s += v[i] * v[i];
        s += swz_xor<1>(s); s += swz_xor<2>(s); s += swz_xor<4>(s);
        const float rs = 1.0f / sqrtf(s * (1.f / 128.f) + EPSN);
        u32x4 o0, o1;
#pragma unroll
        for (int i = 0; i < 4; ++i) { o0[i] = pk2(v[2 * i] * rs * g[2 * i], v[2 * i + 1] * rs * g[2 * i + 1]); o1[i] = pk2(v[8 + 2 * i] * rs * g[8 + 2 * i], v[8 + 2 * i + 1] * rs * g[8 + 2 * i + 1]); }
        ((u32x4*)p1)[0] = o0; ((u32x4*)p1)[1] = o1;
    }
}

template <bool DIFF>
__device__ __forceinline__ void attn_unit_wave(const Grp& G, const unsigned char* cb, int b, int h, int n, int j0, int j1, int wu, float* PO, float* PM, float* PL,
                                               LAS unsigned char* wt, LAS float* wsf, const LAS float* tab0, int lane_in) {
    int lane = lane_in; asm volatile("" : "+v"(lane));
    constexpr int DQK = DIFF ? 64 : 96, DV = DIFF ? 128 : 64, PK = DQK * 2 + 16, PV = DV * 2 + 64, KB = 64 * PK, NDB = DV / 32;
    const int q = lane & 31, hi = lane >> 5;
    const LAS float* tab = tab0 + h * 192;
    const float cbias = DIFF ? tab[0] : 0.f;
    AttnState<DQK, DV> st; attn_init(st);
    const size_t qrow = (size_t)b * ST + q;
    if (DIFF) { const bf16* qp = G.QD + qrow * 1024 + h * 128 + n * 64 + hi * 8;
#pragma unroll
        for (int ks = 0; ks < 4; ++ks) st.qf[ks] = *(const bf16x8*)(qp + ks * 16);
    } else { const bf16* qn = G.QN + qrow * 1024 + h * 64 + hi * 8; const bf16* qr = G.QR + qrow * 512 + h * 32 + hi * 8;
#pragma unroll
        for (int ks = 0; ks < 4; ++ks) st.qf[ks] = *(const bf16x8*)(qn + ks * 16);
#pragma unroll
        for (int ks = 0; ks < 2; ++ks) st.qf[4 + ks] = *(const bf16x8*)(qr + ks * 16);
    }
    for (int j = j0; j < j1; ++j) {
        const bf16 *kA, *kB2, *vA; int nkeys;
        if (j < 64) { const size_t r0 = (size_t)b * PAST + 64 * j; nkeys = 64;
            kA = DIFF ? (const bf16*)(cb + C_KDC) + r0 * 1024 + h * 128 + n * 64 : (const bf16*)(cb + C_KNC) + r0 * 1024 + h * 64;
            kB2 = (const bf16*)(cb + C_KRC) + r0 * 32;
            vA = DIFF ? (const bf16*)(cb + C_VDC) + r0 * 1024 + h * 128 : (const bf16*)(cb + C_VMC) + r0 * 1024 + h * 64;
        } else { const size_t r0 = (size_t)b * ST; nkeys = ST;
            kA = DIFF ? G.KD + r0 * 1024 + h * 128 + n * 64 : G.KN + r0 * 1024 + h * 64;
            kB2 = G.KR + r0 * 32;
            vA = DIFF ? G.VD + r0 * 1024 + h * 128 : G.VM + r0 * 1024 + h * 64;
        }
        { u32x4 t[8];
#pragma unroll
            for (int i = 0; i < 8; ++i) { const int idx = lane + 64 * i; t[i] = *(const u32x4*)(kA + (size_t)(idx >> 3) * 1024 + (idx & 7) * 8); }
#pragma unroll
            for (int i = 0; i < 8; ++i) { const int idx = lane + 64 * i; *(LAS u32x4*)(wt + (idx >> 3) * PK + (idx & 7) * 16) = t[i]; } }
        if (!DIFF) { u32x4 t[4];
#pragma unroll
            for (int i = 0; i < 4; ++i) { const int idx = lane + 64 * i; t[i] = *(const u32x4*)(kB2 + (size_t)(idx >> 2) * 32 + (idx & 3) * 8); }
#pragma unroll
            for (int i = 0; i < 4; ++i) { const int idx = lane + 64 * i; *(LAS u32x4*)(wt + (idx >> 2) * PK + 128 + (idx & 3) * 16) = t[i]; } }
        if (DIFF) {
#pragma unroll
            for (int hf = 0; hf < 2; ++hf) { u32x4 t[8];
#pragma unroll
                for (int i = 0; i < 8; ++i) { const int idx = lane + 64 * i + 512 * hf; t[i] = *(const u32x4*)(vA + (size_t)(idx >> 4) * 1024 + (idx & 15) * 8); }
#pragma unroll
                for (int i = 0; i < 8; ++i) { const int idx = lane + 64 * i + 512 * hf; *(LAS u32x4*)(wt + KB + (idx >> 4) * PV + (idx & 15) * 16) = t[i]; } }
        } else { u32x4 t[8];
#pragma unroll
            for (int i = 0; i < 8; ++i) { const int idx = lane + 64 * i; t[i] = *(const u32x4*)(vA + (size_t)(idx >> 3) * 1024 + (idx & 7) * 8); }
#pragma unroll
            for (int i = 0; i < 8; ++i) { const int idx = lane + 64 * i; *(LAS u32x4*)(wt + KB + (idx >> 3) * PV + (idx & 7) * 16) = t[i]; } }
        const int kb = 64 * j;
        const int mode = DIFF ? ((j <= 61) ? 1 : 2) : 0;
        attn_tile<DQK, DV, DIFF>(st, wt, wt + KB, mode, cbias, tab, kb - (PAST + q), nkeys, wsf, lane);
    }
    const float lt = xsum32(st.l);
    if (hi == 0) { PM[wu * 32 + q] = st.m; PL[wu * 32 + q] = lt; }
#pragma unroll
    for (int db = 0; db < NDB; ++db)
#pragma unroll
        for (int r = 0; r < 16; ++r) PO[((size_t)wu * 32 + crow(r, hi)) * DV + db * 32 + q] = st.o[db][r];
}

__device__ __forceinline__ void phase_combine(const Grp& G, const float* POd, const float* POm, const float* PM, const float* PL, float lam, const float* subln, int gw, int ngw, int lane) {
    for (int it = gw; it < SB * 8 * ST + SB * 16 * ST; it += ngw) {
        if (it < SB * 8 * ST) {
            const int qq = it & 15, h = (it >> 4) & 7, b = it >> 7;
            float val[2] = {0.f, 0.f};
#pragma unroll
            for (int n = 0; n < 2; ++n) {
                const int wu0 = ((b * 8 + h) * 2 + n) * NSPLIT;
                float M = -1e30f;
#pragma unroll
                for (int s = 0; s < NSPLIT; ++s) M = fmaxf(M, PM[(wu0 + s) * 32 + qq]);
                float L = 0.f, a0 = 0.f, a1 = 0.f;
#pragma unroll
                for (int s = 0; s < NSPLIT; ++s) { const float w = __builtin_amdgcn_exp2f(PM[(wu0 + s) * 32 + qq] - M); L += PL[(wu0 + s) * 32 + qq] * w;
                    const float* po = POd + ((size_t)(wu0 + s) * 32 + qq) * 128; a0 += po[lane] * w; a1 += po[lane + 64] * w; }
                const float sc = (n == 0 ? 1.f : -lam) / L;
                val[0] += a0 * sc; val[1] += a1 * sc;
            }
            const float ss = wave_sum(val[0] * val[0] + val[1] * val[1]);
            const float rs = 0.8f / sqrtf(ss * (1.f / 128.f) + EPSN);
            bf16* o = G.DO + (size_t)(b * ST + qq) * 1024 + h * 128;
            o[lane] = (bf16)f2bf(val[0] * rs * subln[lane]); o[lane + 64] = (bf16)f2bf(val[1] * rs * subln[lane + 64]);
        } else {
            const int i2 = it - SB * 8 * ST; const int qq = i2 & 15, h = (i2 >> 4) & 15, b = i2 >> 8;
            const int wu0 = 512 + (b * 16 + h) * NSPLIT;
            float M = -1e30f;
#pragma unroll
            for (int s = 0; s < NSPLIT; ++s) M = fmaxf(M, PM[(wu0 + s) * 32 + qq]);
            float L = 0.f, a0 = 0.f;
#pragma unroll
            for (int s = 0; s < NSPLIT; ++s) { const float w = __builtin_amdgcn_exp2f(PM[(wu0 + s) * 32 + qq] - M); L += PL[(wu0 + s) * 32 + qq] * w;
                a0 += POm[((size_t)(wu0 - 512 + s) * 32 + qq) * 64 + lane] * w; }
            G.MO[(size_t)(b * ST + qq) * 1024 + h * 64 + lane] = (bf16)f2bf(a0 / L);
        }
    }
}

__device__ __forceinline__ void phase_attention(const Args& a, const Grp& G, LAS unsigned char* lds) {
    int tid_ = threadIdx.x; asm volatile("" : "+v"(tid_));
    const int tid = tid_, lane = tid & 63, wid = __builtin_amdgcn_readfirstlane(tid >> 6);
    const float* tabg = (const float*)(a.ws + WS_TAB);
    for (int i = tid; i < 8 * 192; i += 512) ((LAS float*)(lds + AL_TAB))[i] = tabg[i];
    const float lam = tabg[1536];
    const float* subln = a.in[13];
    __syncthreads();
    if (G.sample) {
        if (wid < 4) {
            constexpr int TBD = 64 * (64 * 2 + 16) + 64 * (128 * 2 + 64);
            LAS unsigned char* wt = lds + AL_TILE + wid * TBD;
            LAS float* wsf = (LAS float*)(lds + AL_WSF) + wid * 64;
            const LAS float* tab0 = (const LAS float*)(lds + AL_TAB);
            const unsigned char* cb = a.ws + WS_PROMPT;
            for (int wu = (int)blockIdx.x * 4 + wid; wu < 1024; wu += (int)gridDim.x * 4) {
                const int s = wu & 3; const int j0 = s == 0 ? 0 : 17 + 16 * (s - 1), j1 = 17 + 16 * s;
                if (wu < 512) {
#if ATTMASK & 1
 const int n = (wu >> 2) & 1, h = (wu >> 3) & 7, b = wu >> 6;
                    attn_unit_wave<true>(G, cb, b, h, n, j0, j1, wu, (float*)(a.ws + WS_PO_D), (float*)(a.ws + WS_PM), (float*)(a.ws + WS_PL), wt, wsf, tab0, lane);
#endif
                } else {
#if ATTMASK & 2
 const int i2 = wu - 512; const int h = (i2 >> 2) & 15, b = i2 >> 6;
                    attn_unit_wave<false>(G, cb, b, h, 0, j0, j1, wu, (float*)(a.ws + WS_PO_M) - (size_t)512 * 32 * 64, (float*)(a.ws + WS_PM), (float*)(a.ws + WS_PL), wt, wsf, tab0, lane);
#endif
                }
            }
        }
    } else {
        for (int v = (int)blockIdx.x; v < 256; v += (int)gridDim.x) {
            { const int bh = v >> 1, b = bh >> 3, h = bh & 7, par = v & 1;
                for (int i = 0; i < 4; ++i) { const int qb = par ? ((i == 0) ? 6 : (i == 1) ? 1 : (i == 2) ? 4 : 3) : ((i == 0) ? 7 : (i == 1) ? 0 : (i == 2) ? 5 : 2);

#if ATTMASK & 4
                    attn_unit_coop<true>(G, b, h, qb, lds, lam, subln);
#endif
 } }
            { const int b = v >> 4, h = v & 15;

#if ATTMASK & 8
                for (int qb = 7; qb >= 0; --qb) attn_unit_coop<false>(G, b, h, qb, lds, lam, subln);
#endif
 }
        }
    }
}

constexpr int LDS_BYTES = 147456;
#ifndef PHMASK
#define PHMASK 0xffff
#endif

constexpr int LDS_PTAB = 131072;
__device__ __forceinline__ const void* lds_ptr(LAS const unsigned long long* pt, int i) {
    const unsigned long long v = pt[i];
    const unsigned lo = __builtin_amdgcn_readfirstlane((unsigned)v), hi = __builtin_amdgcn_readfirstlane((unsigned)(v >> 32));
    return (const void*)(const __attribute__((address_space(1))) void*)(((unsigned long long)hi << 32) | lo);
}
__device__ __forceinline__ Args load_args(LAS unsigned char* lds) {
    int z = 0; asm volatile("" : "+s"(z));
    LAS const unsigned long long* pt = (LAS const unsigned long long*)(lds + LDS_PTAB + z);
    Args a;
#pragma unroll
    for (int i = 0; i < 26; ++i) a.in[i] = (const float*)lds_ptr(pt, i);
    a.out = (float*)lds_ptr(pt, 26); a.ws = (unsigned char*)lds_ptr(pt, 27); a.pad0 = 0; a.pad1 = 0;
    return a;
}
__global__ void __launch_bounds__(512, 2) fwd_megakernel(Args ka) {
    extern __shared__ __attribute__((aligned(16))) unsigned char lds_raw[];
    LAS unsigned char* lds = (LAS unsigned char*)lds_raw;
    cg::grid_group grid = cg::this_grid();
    if (threadIdx.x == 0) {
        LAS unsigned long long* pt = (LAS unsigned long long*)(lds + LDS_PTAB);
#pragma unroll
        for (int i = 0; i < 26; ++i) pt[i] = (unsigned long long)ka.in[i];
        pt[26] = (unsigned long long)ka.out; pt[27] = (unsigned long long)ka.ws;
    }
    __syncthreads();

#if PHMASK & 1
    { const int tid = threadIdx.x, lane = tid & 63, wave = __builtin_amdgcn_readfirstlane(tid >> 6); const Args a = load_args(lds);
      phase_prologue(a, lds, (int)blockIdx.x * 8 + wave, (int)gridDim.x * 8, lane, wave); }
#endif
    grid.sync();

#define PH_BEGIN int tid_ = threadIdx.x, g_ = g; asm volatile("" : "+v"(tid_), "+s"(g_)); const int lane = tid_ & 63, wave = __builtin_amdgcn_readfirstlane(tid_ >> 6); \
    const int gw = (int)blockIdx.x * 8 + wave, ngw = (int)gridDim.x * 8; const Args a = load_args(lds); unsigned char* ws = a.ws; const float* rope = (const float*)(ws + WS_ROPE); (void)rope; const Grp G = make_grp(a, g_); const int M = G.ntiles * 256; (void)lane; (void)gw; (void)ngw; (void)M;
#pragma unroll 1
    for (int g = 0; g < NGRP; ++g) {
        { PH_BEGIN rms_rows_bf16(G.x, G.XN, a.in[7], G.nvalid, M, gw, ngw, lane); }
        grid.sync();
#if PHMASK & 2
        { PH_BEGIN EpiIn E{G.QD, G.KD, G.VD, G.GD, G.GM, G.ZS, G.okd, G.ovd, G.nvalid, 0.125f * LOG2E};
          run_gemm(lds, G.XN, (const bf16*)(ws + WS_WIN), M, NIN, 1024, E); }
#endif
        grid.sync();
        { PH_BEGIN phase_small(G, a.in[14], a.in[16], rope, gw, ngw, lane); }
        grid.sync();
#if PHMASK & 4
        { PH_BEGIN EpiQ E{G.QN, G.QR, rope, G.sample, 0.10206207261596575f * LOG2E};
          run_gemm(lds, G.CQ, (const bf16*)(ws + WS_WUQ), M, 1536, 256, E); }
#endif
#if PHMASK & 8
        { PH_BEGIN EpiKV E{G.KN, G.VM};
          run_gemm(lds, G.CKV, (const bf16*)(ws + WS_WUKV), M, 2048, 256, E); }
        if (g == 0) { PH_BEGIN EpiKV E{(bf16*)(ws + WS_PROMPT + C_KNC), (bf16*)(ws + WS_PROMPT + C_VMC)};
          run_gemm(lds, (const bf16*)(ws + WS_PROMPT + C_CKVC), (const bf16*)(ws + WS_WUKV), CACHE_ROWS, 2048, 256, E); }
#endif
        grid.sync();
#if PHMASK & 16
        { PH_BEGIN phase_attention(a, G, lds); }
#endif
        grid.sync();
        if (g != 0) {
            { PH_BEGIN phase_diffmix(G, ((const float*)(ws + WS_TAB))[1536], a.in[13], gw, ngw, lane); }
            grid.sync();
        }
        if (g == 0) {
            { PH_BEGIN phase_combine(G, (const float*)(ws + WS_PO_D), (const float*)(ws + WS_PO_M), (const float*)(ws + WS_PM), (const float*)(ws + WS_PL), ((const float*)(ws + WS_TAB))[1536], a.in[13], gw, ngw, lane); }
            grid.sync();
        }
#if PHMASK & 32
        { PH_BEGIN EpiM1 E{G.GD, G.XN}; run_gemm(lds, G.DO, (const bf16*)(ws + WS_WOD), M, 1024, 1024, E); }
        { PH_BEGIN EpiM2 E{G.GM, G.XN}; run_gemm(lds, G.MO, (const bf16*)(ws + WS_WOM), M, 1024, 1024, E); }
#endif
        grid.sync();
#if PHMASK & 64
        { PH_BEGIN EpiOut E{G.x, G.y, G.nvalid}; run_gemm(lds, G.XN, (const bf16*)(ws + WS_WOUT), M, 1024, 1024, E); }
#endif
        grid.sync();
        { PH_BEGIN rms_rows_bf16(G.y, G.XN, a.in[22], G.nvalid, M, gw, ngw, lane); }
        grid.sync();
#if PHMASK & 128
        { PH_BEGIN EpiUp E{G.U}; run_gemm(lds, G.XN, (const bf16*)(ws + WS_WUP), M, 4096, 1024, E); }
#endif
        grid.sync();
#if PHMASK & 256
        { PH_BEGIN EpiDown E{G.y, G.nvalid}; run_gemm(lds, G.U, (const bf16*)(ws + WS_WDN), M, 1024, 4096, E); }
#endif
        grid.sync();
        { PH_BEGIN rms_rows_f32_inplace(G.y, a.in[25], G.nvalid, gw, ngw, lane); }
    }
}

extern "C" void kernel_launch(void* const* d_in, const int* in_sizes, int n_in, void* d_out, int out_size, void* d_ws, size_t ws_size, hipStream_t stream) {
    static int grid = 0;
    if (grid == 0) {
        if (n_in != 26 || ws_size < WS_NEED) { fprintf(stderr, "kernel_launch: need 26 inputs and %zu bytes of workspace; got %d, %zu\n", (size_t)WS_NEED, n_in, ws_size); grid = -1; return; }
        int dev = 0, cus = 0, per_cu = 0;
        if (hipGetDevice(&dev) != hipSuccess || hipDeviceGetAttribute(&cus, hipDeviceAttributeMultiprocessorCount, dev) != hipSuccess) { grid = -1; return; }
        if (hipFuncSetAttribute((const void*)fwd_megakernel, hipFuncAttributeMaxDynamicSharedMemorySize, LDS_BYTES) != hipSuccess) { fprintf(stderr, "kernel_launch: hipFuncSetAttribute failed\n"); grid = -1; return; }
        if (hipOccupancyMaxActiveBlocksPerMultiprocessor(&per_cu, (const void*)fwd_megakernel, 512, LDS_BYTES) != hipSuccess || per_cu < 1) { fprintf(stderr, "kernel_launch: occupancy query says %d\n", per_cu); per_cu = 1; }
        (void)hipGetLastError();
        grid = cus;
    }
    if (grid < 0) return;
    Args a{};
    for (int i = 0; i < 26; ++i) a.in[i] = (const float*)d_in[i];
    a.out = (float*)d_out; a.ws = (unsigned char*)d_ws;
    void* args[] = {&a};
    hipError_t e = hipLaunchCooperativeKernel((const void*)fwd_megakernel, dim3(grid), dim3(512), args, LDS_BYTES, stream);
    if (e != hipSuccess) fprintf(stderr, "kernel_launch: cooperative launch failed: %s (grid %d)\n", hipGetErrorString(e), grid);
}
```

```cpp
#include <hip/hip_runtime.h>
#include <hip/hip_cooperative_groups.h>
#include <cstdio>
#include <cstdint>
namespace cg = cooperative_groups;
namespace pg8 {
#define PG8_LAS __attribute__((address_space(3)))
typedef unsigned short bf16_t;
typedef short bf16x8 __attribute__((ext_vector_type(8)));
typedef float f32x4 __attribute__((ext_vector_type(4)));
typedef unsigned u32x4 __attribute__((ext_vector_type(4)));
constexpr int BM = 256, BK = 64, HALF = 128, HTB = HALF * BK * 2  , STAGE_BYTES = 8 * HTB, NXCD = 8, WGM = 8;

__host__ __device__ __forceinline__ int lds_byte(int r, int c) { const int st = (r >> 4) * 2 + (c >> 5), rr = r & 15, cc = c & 31, ob = rr * 64 + cc * 2; return st * 1024 + (ob ^ (((ob >> 9) & 1) << 5)); }
__host__ __device__ __forceinline__ void stage_rc(int b, int& R, int& C) { const int st = b / 1024, sb = b % 1024, swz = sb ^ (((sb >> 9) & 1) << 5); R = (st >> 1) * 16 + swz / 64; C = (st & 1) * 32 + (swz % 64) / 2; }
__host__ __device__ __forceinline__ int perm32(int rho) { const int n = rho >> 4, i = rho & 15; return 8 * (i >> 2) + 4 * n + (i & 3); }

struct Unit { int pm, pn; };
struct Gemm { const bf16_t* A; const bf16_t* Bt; int M, N, K; };

struct StaticOrder {
    int nM, nN, nwg, G, c;
    __host__ __device__ void init(int M, int N, int G_, int c_) { nM = M / BM; nN = N / BM; nwg = nM * nN; G = G_; c = c_; }
    __host__ __device__ bool next(int i, Unit& u) const {
        const long L = (long)i * G + c; if (L >= nwg) return false;
        int wgid = (int)L; { const int q = nwg / NXCD, r = nwg % NXCD, xcd = wgid % NXCD, off = wgid / NXCD; wgid = (xcd < r ? xcd * (q + 1) : r * (q + 1) + (xcd - r) * q) + off; }
        const int nig = WGM * nN, gid = wgid / nig, fm = gid * WGM, gsz = (nM - fm) < WGM ? (nM - fm) : WGM;
        u.pm = fm + ((wgid % nig) % gsz); u.pn = (wgid % nig) / gsz; return true;
    }
    __device__ __forceinline__ void a_ready(const Unit&) const {}
    __device__ __forceinline__ void done(const Unit&) const {}
};

__device__ __forceinline__ unsigned cvt_pk_bf16(float lo, float hi) { unsigned r; asm volatile("v_cvt_pk_bf16_f32 %0, %1, %2" : "=v"(r) : "v"(lo), "v"(hi)); return r; }
typedef float f32x2 __attribute__((ext_vector_type(2)));
template <class Epi, class Sched, bool ALIGN_EPI = false, bool SP2 = false>
__device__ __forceinline__ void gemm_phase(PG8_LAS unsigned char* lds, const Gemm g, const Sched& S, const Epi& E) {
    int tid_ = threadIdx.x; asm volatile("" : "+v"(tid_));
    const int tid = tid_, wid = __builtin_amdgcn_readfirstlane(tid >> 6), lane = tid & 63, wr = wid >> 2, wc = wid & 3, fr = lane & 15, fq = lane >> 4;
    const int K = g.K, nt = K / BK;
    unsigned voffA[2], voffB[2];
#pragma unroll
    for (int i = 0; i < 2; ++i) { int R, C; stage_rc(tid * 16 + i * 8192, R, C); const int Rb = Epi::PERM ? ((R & ~31) + perm32(R & 31)) : R;
        voffA[i] = (unsigned)(R * K + C) * 2u; voffB[i] = (unsigned)(Rb * K + C) * 2u; }
    const size_t kstep = (size_t)(BK * 2);
    const size_t hstep = (size_t)HALF * K * 2;
    const size_t tstep = 2 * hstep;
    const unsigned ldsw = (unsigned)wid * 1024u;
    const int aoff = lds_byte(wr * 64 + fr, fq * 8), boff = lds_byte(wc * 32 + fr, fq * 8);
#define PG8_SA(b, h) (((b) * 2 + (h)) * HTB)
#define PG8_SB(b, h) ((4 + (b) * 2 + (h)) * HTB)
#define PG8_STAGE(bufoff, gbase, voff) do { _Pragma("unroll") for (int _i = 0; _i < 2; ++_i) \
        __builtin_amdgcn_global_load_lds((const unsigned*)((const char*)(gbase) + (voff)[_i]), (PG8_LAS unsigned*)(lds + (bufoff) + ldsw + _i * 8192), 16, 0, 0); } while (0)
#define PG8_LDA(dst, b, h) do { _Pragma("unroll") for (int m = 0; m < 4; ++m) _Pragma("unroll") for (int k = 0; k < 2; ++k) dst[m][k] = *(const PG8_LAS bf16x8*)(lds + PG8_SA(b, h) + aoff + m * 2048 + k * 1024); } while (0)
#define PG8_LDB(dst, b, h) do { _Pragma("unroll") for (int n = 0; n < 2; ++n) _Pragma("unroll") for (int k = 0; k < 2; ++k) dst[n][k] = *(const PG8_LAS bf16x8*)(lds + PG8_SB(b, h) + boff + n * 2048 + k * 1024); } while (0)
#define PG8_MMA(ai, bj, At, Bt) do { __builtin_amdgcn_s_setprio(1); _Pragma("unroll") for (int m = 0; m < 4; ++m) _Pragma("unroll") for (int n = 0; n < 2; ++n) _Pragma("unroll") for (int k = 0; k < 2; ++k) \
        acc[ai][bj][m][n] = __builtin_amdgcn_mfma_f32_16x16x32_bf16(Bt[n][k], At[m][k], acc[ai][bj][m][n], 0, 0, 0); __builtin_amdgcn_s_setprio(0); } while (0)
#define PG8_WAIT_V(n) asm volatile("s_waitcnt vmcnt(" #n ")" ::: "memory")
#define PG8_WAIT_L(n) asm volatile("s_waitcnt lgkmcnt(" #n ")" ::: "memory")
#define PG8_BAR __builtin_amdgcn_s_barrier()
#define PG8_SCHED __builtin_amdgcn_sched_barrier(0)
    Unit cur, nxt; int ui = 0;
    if (!S.next(0, cur)) return;
    f32x4 acc[2][2][4][2];
#pragma unroll
    for (int a = 0; a < 2; ++a)
#pragma unroll
        for (int b = 0; b < 2; ++b)
#pragma unroll
            for (int m = 0; m < 4; ++m)
#pragma unroll
                for (int n = 0; n < 2; ++n) acc[a][b][m][n] = (f32x4){0.f, 0.f, 0.f, 0.f};
    bf16x8 At[4][2], B0[2][2], B1[2][2];
    const char* cA = (const char*)g.A + (size_t)cur.pm * tstep; const char* cB = (const char*)g.Bt + (size_t)cur.pn * tstep;
    S.a_ready(cur);
    if constexpr (SP2) {
        PG8_STAGE(PG8_SB(0, 0), cB, voffB); PG8_STAGE(PG8_SB(0, 1), cB + hstep, voffB); PG8_STAGE(PG8_SA(0, 0), cA, voffA); PG8_STAGE(PG8_SA(0, 1), cA + hstep, voffA);
        if (wr == 1) PG8_BAR;
        PG8_WAIT_V(2); PG8_BAR;
        PG8_STAGE(PG8_SB(1, 0), cB + kstep, voffB); PG8_STAGE(PG8_SA(1, 0), cA + kstep, voffA); PG8_STAGE(PG8_SB(1, 1), cB + hstep + kstep, voffB);
        PG8_WAIT_V(6); PG8_BAR;
    } else {
        PG8_STAGE(PG8_SB(0, 0), cB, voffB); PG8_STAGE(PG8_SA(0, 0), cA, voffA); PG8_STAGE(PG8_SB(0, 1), cB + hstep, voffB); PG8_STAGE(PG8_SA(0, 1), cA + hstep, voffA);
        if (wr == 1) PG8_BAR;
        PG8_WAIT_V(4); PG8_BAR;
        PG8_STAGE(PG8_SB(1, 0), cB + kstep, voffB); PG8_STAGE(PG8_SA(1, 0), cA + kstep, voffA); PG8_STAGE(PG8_SB(1, 1), cB + hstep + kstep, voffB);
        PG8_WAIT_V(6); PG8_BAR;
    }
    for (;;) {
        const bool has_next = S.next(ui + 1, nxt);
        const char* nA = has_next ? (const char*)g.A + (size_t)nxt.pm * tstep : cA; const char* nB = has_next ? (const char*)g.Bt + (size_t)nxt.pn * tstep : cB;
        for (int t = 0; t < nt; t += 2) {
            const bool last = (t == nt - 2);
            const char* a1 = cA + (size_t)(t + 1) * kstep;
            const char* a2 = last ? nA : cA + (size_t)(t + 2) * kstep; const char* b2 = last ? nB : cB + (size_t)(t + 2) * kstep;
            const char* a3 = a2 + kstep; const char* b3 = b2 + kstep;
            if (last && has_next) S.a_ready(nxt);
            if constexpr (SP2) {
            PG8_LDB(B0, 0, 0); PG8_LDB(B1, 0, 1); PG8_SCHED; PG8_LDA(At, 0, 0); PG8_STAGE(PG8_SA(1, 1), a1 + hstep, voffA);
            PG8_WAIT_V(8); PG8_WAIT_L(0); PG8_BAR; PG8_MMA(0, 0, At, B0); PG8_MMA(0, 1, At, B1); PG8_BAR; PG8_SCHED;
            PG8_LDA(At, 0, 1); PG8_STAGE(PG8_SB(0, 0), b2, voffB); PG8_STAGE(PG8_SB(0, 1), b2 + hstep, voffB); PG8_STAGE(PG8_SA(0, 0), a2, voffA);
            PG8_WAIT_V(8); PG8_WAIT_L(0); PG8_BAR; PG8_MMA(1, 0, At, B0); PG8_MMA(1, 1, At, B1); PG8_BAR; PG8_SCHED;
            PG8_LDB(B0, 1, 0); PG8_LDB(B1, 1, 1); PG8_SCHED; PG8_LDA(At, 1, 0); PG8_STAGE(PG8_SA(0, 1), a2 + hstep, voffA);
            PG8_WAIT_V(8); PG8_WAIT_L(0); PG8_BAR; PG8_MMA(0, 0, At, B0); PG8_MMA(0, 1, At, B1); PG8_BAR; PG8_SCHED;
            PG8_LDA(At, 1, 1); PG8_STAGE(PG8_SB(1, 0), b3, voffB); PG8_STAGE(PG8_SB(1, 1), b3 + hstep, voffB); PG8_STAGE(PG8_SA(1, 0), a3, voffA);
            PG8_WAIT_V(8); PG8_WAIT_L(0); PG8_BAR; PG8_MMA(1, 0, At, B0); PG8_MMA(1, 1, At, B1); PG8_BAR; PG8_SCHED;
            } else {
            PG8_LDB(B0, 0, 0); PG8_SCHED; PG8_LDA(At, 0, 0); PG8_STAGE(PG8_SA(1, 1), a1 + hstep, voffA);
            PG8_WAIT_L(8); PG8_BAR; PG8_WAIT_L(0); PG8_MMA(0, 0, At, B0); PG8_BAR; PG8_SCHED;
            PG8_LDB(B1, 0, 1); PG8_STAGE(PG8_SB(0, 0), b2, voffB);
            PG8_BAR; PG8_WAIT_L(0); PG8_MMA(0, 1, At, B1); PG8_BAR;
            PG8_LDA(At, 0, 1); PG8_STAGE(PG8_SA(0, 0), a2, voffA);
            PG8_BAR; PG8_WAIT_L(0); PG8_MMA(1, 0, At, B0); PG8_BAR; PG8_SCHED;
            PG8_STAGE(PG8_SB(0, 1), b2 + hstep, voffB);
            PG8_WAIT_V(6); PG8_BAR; PG8_MMA(1, 1, At, B1); PG8_BAR;
            PG8_LDB(B0, 1, 0); PG8_SCHED; PG8_LDA(At, 1, 0); PG8_STAGE(PG8_SA(0, 1), a2 + hstep, voffA);
            PG8_WAIT_L(8); PG8_BAR; PG8_WAIT_L(0); PG8_MMA(0, 0, At, B0); PG8_BAR; PG8_SCHED;
            PG8_LDB(B1, 1, 1); PG8_STAGE(PG8_SB(1, 0), b3, voffB);
            PG8_BAR; PG8_WAIT_L(0); PG8_MMA(0, 1, At, B1); PG8_BAR;
            PG8_LDA(At, 1, 1); PG8_STAGE(PG8_SA(1, 0), a3, voffA);
            PG8_BAR; PG8_WAIT_L(0); PG8_MMA(1, 0, At, B0); PG8_BAR; PG8_SCHED;
            PG8_STAGE(PG8_SB(1, 1), b3 + hstep, voffB);
            PG8_WAIT_V(6); PG8_BAR; PG8_MMA(1, 1, At, B1); PG8_BAR;
            }
        }
        if constexpr (ALIGN_EPI) { if (wr == 0) PG8_BAR; }
        if constexpr (!Epi::AFTER_DRAIN) { E(acc, cur, wr, wc, fr, fq); S.done(cur); }
        if (!has_next) break;
#pragma unroll
        for (int a = 0; a < 2; ++a)
#pragma unroll
            for (int b = 0; b < 2; ++b)
#pragma unroll
                for (int m = 0; m < 4; ++m)
#pragma unroll
                    for (int n = 0; n < 2; ++n) acc[a][b][m][n] = (f32x4){0.f, 0.f, 0.f, 0.f};
        cur = nxt; cA = nA; cB = nB; ++ui;
        if constexpr (ALIGN_EPI) { if (wr == 1) PG8_BAR; }
    }
    PG8_WAIT_V(0);
    if constexpr (!ALIGN_EPI) { if (wr == 0) PG8_BAR; }
    PG8_BAR;
    if constexpr (Epi::AFTER_DRAIN) { E.fused(acc, cur, wr, wc, fr, fq, lds, wid, lane); S.done(cur); }
#undef PG8_SA
#undef PG8_SB
#undef PG8_STAGE
#undef PG8_LDA
#undef PG8_LDB
#undef PG8_MMA
#undef PG8_WAIT_V
#undef PG8_WAIT_L
#undef PG8_BAR
#undef PG8_SCHED
}
}

#define LAS __attribute__((address_space(3)))
typedef unsigned short bf16;
typedef float f32x4 __attribute__((ext_vector_type(4)));
typedef float f32x2 __attribute__((ext_vector_type(2)));
typedef float f32x16 __attribute__((ext_vector_type(16)));
typedef short bf16x8 __attribute__((ext_vector_type(8)));
typedef short s16x4 __attribute__((ext_vector_type(4)));
typedef unsigned u32x4 __attribute__((ext_vector_type(4)));
typedef unsigned u32x2 __attribute__((ext_vector_type(2)));

constexpr int DM = 1024, NB = 32, TS = 2048, SB = 8, ST = 16, PAST = 4096;
constexpr int NPG = 2;
constexpr int RG = NB * TS / NPG;
constexpr int GBATCH = NB / NPG;
constexpr int NGRP = NPG + 1;
constexpr int NIN = 5888;
constexpr float LOG2E = 1.4426950408889634f;
constexpr float EPSN = 1e-6f;
constexpr int NSPLIT = 4;
constexpr int CACHE_ROWS = SB * PAST;

constexpr size_t O_YP = 0, O_YS = 67108864, O_KDP = 67239936, O_VDP = 134348800, O_CKVP = 201457664, O_KRP = 218234880,
                 O_KDS = 220332032, O_VDS = 220463104, O_CKVS = 220594176, O_KRS = 220626944;
constexpr size_t MiB = 1u << 20;
constexpr size_t WS_TAB = 0;
constexpr size_t WS_ROPE = 8192;
constexpr size_t WS_WIN = 1 * MiB;
constexpr size_t WS_WUQ = WS_WIN + (size_t)NIN * 1024 * 2;
constexpr size_t WS_WUKV = WS_WUQ + 1536 * 256 * 2;
constexpr size_t WS_WOD = WS_WUKV + 2048 * 256 * 2;
constexpr size_t WS_WOM = WS_WOD + 2 * MiB;
constexpr size_t WS_WOUT = WS_WOM + 2 * MiB;
constexpr size_t WS_WUP = WS_WOUT + 2 * MiB;
constexpr size_t WS_WDN = WS_WUP + 8 * MiB;
constexpr size_t WS_WEND = WS_WDN + 8 * MiB;
constexpr size_t WS_SAMP = 37 * MiB;
constexpr size_t WS_PART = 44 * MiB;
constexpr size_t WS_PO_D = WS_PART, WS_PO_M = WS_PART + 8 * MiB, WS_PM = WS_PART + 12 * MiB, WS_PL = WS_PM + 131072;
constexpr size_t WS_PROMPT = 58 * MiB;
constexpr size_t GRP_BYTES_PER_ROW = 27712;
constexpr size_t WS_NEED = WS_PROMPT + (size_t)RG * GRP_BYTES_PER_ROW;
static_assert(WS_WEND <= WS_SAMP && WS_SAMP + 256 * GRP_BYTES_PER_ROW <= WS_PART && WS_PL + 131072 <= WS_PROMPT, "ws map");
constexpr size_t C_KDC = 0, C_VDC = 64 * MiB, C_KNC = 128 * MiB, C_VMC = 192 * MiB, C_CKVC = 256 * MiB, C_KRC = 272 * MiB;

struct Args { const float* in[26]; float* out; unsigned char* ws; int pad0, pad1; };

struct Grp {
    const float* x; float* y; float* okd; float* ovd; float* ockv; float* okr;
    int nvalid, ntiles, sample;
    bf16 *QD, *KD, *VD, *QN, *U, *XN, *QR, *KN, *VM, *GD, *GM, *DO, *MO, *CQ, *CKV, *KR; float* ZS;
};
__device__ __forceinline__ Grp make_grp(const Args& a, int g) {
    Grp G; unsigned char* base; size_t RC;
    if (g == 0) {
        G.x = a.in[1]; G.y = a.out + O_YS; G.okd = a.out + O_KDS; G.ovd = a.out + O_VDS; G.ockv = a.out + O_CKVS; G.okr = a.out + O_KRS;
        G.nvalid = SB * ST; G.ntiles = 1; G.sample = 1; base = a.ws + WS_SAMP; RC = 256;
    } else {
        const size_t r0 = (size_t)(g - 1) * RG;
        G.x = a.in[0] + r0 * 1024; G.y = a.out + O_YP + r0 * 1024; G.okd = a.out + O_KDP + r0 * 1024; G.ovd = a.out + O_VDP + r0 * 1024;
        G.ockv = a.out + O_CKVP + r0 * 256; G.okr = a.out + O_KRP + r0 * 32;
        G.nvalid = RG; G.ntiles = RG / 256; G.sample = 0; base = a.ws + WS_PROMPT; RC = RG;
    }
    G.QD = (bf16*)(base); G.KD = (bf16*)(base + RC * 2048); G.VD = (bf16*)(base + RC * 4096); G.QN = (bf16*)(base + RC * 6144); G.U = (bf16*)base;
    G.XN = (bf16*)(base + RC * 8192); G.QR = (bf16*)(base + RC * 10240); G.KN = (bf16*)(base + RC * 11264); G.VM = (bf16*)(base + RC * 13312);
    G.GD = (bf16*)(base + RC * 15360); G.GM = (bf16*)(base + RC * 17408); G.DO = (bf16*)(base + RC * 19456); G.MO = (bf16*)(base + RC * 21504);
    G.ZS = (float*)(base + RC * 23552); G.CQ = (bf16*)(base + RC * 26624); G.CKV = (bf16*)(base + RC * 27136); G.KR = (bf16*)(base + RC * 27648);
    return G;
}

template <int M> __device__ __forceinline__ float swz_xor(float v) { return __int_as_float(__builtin_amdgcn_ds_swizzle(__float_as_int(v), 0x1F | (M << 10))); }
__device__ __forceinline__ float half_sum32(float v) { v += swz_xor<1>(v); v += swz_xor<2>(v); v += swz_xor<4>(v); v += swz_xor<8>(v); v += swz_xor<16>(v); return v; }
__device__ __forceinline__ float wave_sum(float v) {
    v = half_sum32(v);
    auto rr = __builtin_amdgcn_permlane32_swap(__float_as_uint(v), __float_as_uint(v), false, false);
    return __uint_as_float(rr[0]) + __uint_as_float(rr[1]);
}
__device__ __forceinline__ unsigned f2bf(float f) { unsigned u = __builtin_bit_cast(unsigned, f); return (u + 0x7fffu + ((u >> 16) & 1u)) >> 16; }
__device__ __forceinline__ unsigned pk2(float lo, float hi) { return f2bf(lo) | (f2bf(hi) << 16); }
__device__ __forceinline__ float bflo(unsigned w) { return __builtin_bit_cast(float, w << 16); }
__device__ __forceinline__ float bfhi(unsigned w) { return __builtin_bit_cast(float, w & 0xffff0000u); }
__device__ __forceinline__ void st_bf4(bf16* p, f32x4 v) { u32x2 w; w.x = pk2(v[0], v[1]); w.y = pk2(v[2], v[3]); *(u32x2*)p = w; }
__device__ __forceinline__ f32x4 ld_bf4(const bf16* p) { const u32x2 w = *(const u32x2*)p; return (f32x4){bflo(w.x), bfhi(w.x), bflo(w.y), bfhi(w.y)}; }
__device__ __forceinline__ float sigm(float x) { return 1.f / (1.f + __expf(-x)); }

#define EPI_LOOP(BODY) \
    _Pragma("unroll") for (int ai = 0; ai < 2; ++ai) _Pragma("unroll") for (int m = 0; m < 4; ++m) { const int row = u.pm * 256 + ai * 128 + wr * 64 + m * 16 + fr; const size_t rw = (size_t)row; (void)rw; \
    _Pragma("unroll") for (int bj = 0; bj < 2; ++bj) _Pragma("unroll") for (int n = 0; n < 2; ++n) { const int cl = bj * 128 + wc * 32 + n * 16 + 4 * fq; const f32x4 v = acc[ai][bj][m][n]; BODY } }

typedef const f32x4 (&AccRef)[2][2][4][2];

struct EpiIn {
    static constexpr bool PERM = false, AFTER_DRAIN = false;
    bf16 *QD, *KD, *VD, *GD, *GM; float *ZS, *okd, *ovd; int nvalid; float qs;
    __device__ __forceinline__ void operator()(AccRef acc, const pg8::Unit& u, int wr, int wc, int fr, int fq) const {
        const int t = u.pn;
        if (t < 4) { const int c0 = t * 256; EPI_LOOP( st_bf4(QD + rw * 1024 + c0 + cl, v * qs); ) }
        else if (t < 8) { const int c0 = (t - 4) * 256; EPI_LOOP( st_bf4(KD + rw * 1024 + c0 + cl, v); if (row < nvalid) *(f32x4*)(okd + rw * 1024 + c0 + cl) = v; ) }
        else if (t < 12) { const int c0 = (t - 8) * 256; EPI_LOOP( st_bf4(VD + rw * 1024 + c0 + cl, v); if (row < nvalid) *(f32x4*)(ovd + rw * 1024 + c0 + cl) = v; ) }
        else if (t < 15) { const int c0 = (t - 12) * 256; EPI_LOOP( *(f32x4*)(ZS + rw * 768 + c0 + cl) = v; ) }
        else if (t < 19) { const int c0 = (t - 15) * 256; EPI_LOOP( st_bf4(GD + rw * 1024 + c0 + cl, ((f32x4){sigm(v[0]), sigm(v[1]), sigm(v[2]), sigm(v[3])})); ) }
        else { const int c0 = (t - 19) * 256; EPI_LOOP( st_bf4(GM + rw * 1024 + c0 + cl, ((f32x4){sigm(v[0]), sigm(v[1]), sigm(v[2]), sigm(v[3])})); ) }
    }
};
struct EpiQ {
    static constexpr bool PERM = false, AFTER_DRAIN = false;
    bf16 *QN, *QR; const float* rope; int sample; float qs;
    __device__ __forceinline__ void operator()(AccRef acc, const pg8::Unit& u, int wr, int wc, int fr, int fq) const {
        const int t = u.pn;
        if (t < 4) { const int c0 = t * 256; EPI_LOOP( st_bf4(QN + rw * 1024 + c0 + cl, v * qs); ) }
        else {
            const int c0 = (t - 4) * 256;
#pragma unroll
            for (int ai = 0; ai < 2; ++ai)
#pragma unroll
                for (int m = 0; m < 4; ++m) {
                    const int row = u.pm * 256 + ai * 128 + wr * 64 + m * 16 + fr;
                    const int pos = sample ? (PAST + (row & (ST - 1))) : (row & (TS - 1));
                    const f32x4 cs0 = *(const f32x4*)(rope + (size_t)pos * 32 + 8 * fq), cs1 = *(const f32x4*)(rope + (size_t)pos * 32 + 8 * fq + 4);
#pragma unroll
                    for (int bj = 0; bj < 2; ++bj) {
                        const f32x4 x1 = acc[ai][bj][m][0], x2 = acc[ai][bj][m][1];
                        f32x4 o1, o2;
                        o1[0] = x1[0] * cs0[0] - x2[0] * cs0[1]; o2[0] = x2[0] * cs0[0] + x1[0] * cs0[1];
                        o1[1] = x1[1] * cs0[2] - x2[1] * cs0[3]; o2[1] = x2[1] * cs0[2] + x1[1] * cs0[3];
                        o1[2] = x1[2] * cs1[0] - x2[2] * cs1[1]; o2[2] = x2[2] * cs1[0] + x1[2] * cs1[1];
                        o1[3] = x1[3] * cs1[2] - x2[3] * cs1[3]; o2[3] = x2[3] * cs1[2] + x1[3] * cs1[3];
                        bf16* p = QR + (size_t)row * 512 + c0 + bj * 128 + wc * 32 + 4 * fq;
                        st_bf4(p, o1 * qs); st_bf4(p + 16, o2 * qs);
                    }
                }
        }
    }
};
struct EpiKV {
    static constexpr bool PERM = false, AFTER_DRAIN = false;
    bf16 *KN, *VM;
    __device__ __forceinline__ void operator()(AccRef acc, const pg8::Unit& u, int wr, int wc, int fr, int fq) const {
        const int t = u.pn; bf16* O = t < 4 ? KN : VM; const int c0 = (t & 3) * 256;
        EPI_LOOP( st_bf4(O + rw * 1024 + c0 + cl, v); )
    }
};
struct EpiM1 {
    static constexpr bool PERM = false, AFTER_DRAIN = false;
    const bf16* Gt; bf16* MG;
    __device__ __forceinline__ void operator()(AccRef acc, const pg8::Unit& u, int wr, int wc, int fr, int fq) const {
        const int c0 = u.pn * 256;
        EPI_LOOP( const f32x4 g = ld_bf4(Gt + rw * 1024 + c0 + cl); st_bf4(MG + rw * 1024 + c0 + cl, g * v); )
    }
};
struct EpiM2 {
    static constexpr bool PERM = false, AFTER_DRAIN = false;
    const bf16* Gt; bf16* MG;
    __device__ __forceinline__ void operator()(AccRef acc, const pg8::Unit& u, int wr, int wc, int fr, int fq) const {
        const int c0 = u.pn * 256;
        EPI_LOOP( const f32x4 g = ld_bf4(Gt + rw * 1024 + c0 + cl); const f32x4 o = ld_bf4(MG + rw * 1024 + c0 + cl); st_bf4(MG + rw * 1024 + c0 + cl, o + g * v); )
    }
};
struct EpiOut {
    static constexpr bool PERM = false, AFTER_DRAIN = false;
    const float* x; float* y; int nvalid;
    __device__ __forceinline__ void operator()(AccRef acc, const pg8::Unit& u, int wr, int wc, int fr, int fq) const {
        const int c0 = u.pn * 256;
        EPI_LOOP( if (row < nvalid) { const f32x4 b = *(const f32x4*)(x + rw * 1024 + c0 + cl); *(f32x4*)(y + rw * 1024 + c0 + cl) = b + v; } )
    }
};
struct EpiUp {
    static constexpr bool PERM = false, AFTER_DRAIN = false;
    bf16* U;
    __device__ __forceinline__ void operator()(AccRef acc, const pg8::Unit& u, int wr, int wc, int fr, int fq) const {
        const int c0 = u.pn * 256;
        EPI_LOOP( f32x4 r; r[0] = fmaxf(v[0], 0.f); r[1] = fmaxf(v[1], 0.f); r[2] = fmaxf(v[2], 0.f); r[3] = fmaxf(v[3], 0.f); st_bf4(U + rw * 4096 + c0 + cl, r * r); )
    }
};
struct EpiDown {
    static constexpr bool PERM = false, AFTER_DRAIN = false;
    float* y; int nvalid;
    __device__ __forceinline__ void operator()(AccRef acc, const pg8::Unit& u, int wr, int wc, int fr, int fq) const {
        const int c0 = u.pn * 256;
        EPI_LOOP( if (row < nvalid) { float* p = y + rw * 1024 + c0 + cl; *(f32x4*)p = *(const f32x4*)p + v; } )
    }
};

template <class Epi>
__device__ __forceinline__ void run_gemm(LAS unsigned char* lds, const bf16* A, const bf16* Bt, int M, int N, int K, const Epi& E) {
    pg8::Gemm g{A, Bt, M, N, K}; pg8::StaticOrder S; S.init(M, N, (int)gridDim.x, (int)blockIdx.x);
    pg8::gemm_phase<Epi, pg8::StaticOrder, true, true>(lds, g, S, E);
}

__device__ __forceinline__ void rms_rows_bf16(const float* src, bf16* dst, const float* gain, int nvalid, int ntotal, int gw, int ngw, int lane) {
    for (int r = gw; r < ntotal; r += ngw) {
        u32x2* o8 = (u32x2*)(dst + (size_t)r * 1024) + lane;
        if (r >= nvalid) {
#pragma unroll
            for (int j = 0; j < 4; ++j) o8[64 * j] = (u32x2){0u, 0u};
            continue;
        }
        const f32x4* xr = (const f32x4*)(src + (size_t)r * 1024) + lane;
        f32x4 v[4]; float s = 0.f;
#pragma unroll
        for (int j = 0; j < 4; ++j) { v[j] = xr[64 * j]; s += (v[j][0] * v[j][0] + v[j][1] * v[j][1]) + (v[j][2] * v[j][2] + v[j][3] * v[j][3]); }
        const float rs = 1.0f / sqrtf(wave_sum(s) * (1.f / 1024.f) + EPSN);
#pragma unroll
        for (int j = 0; j < 4; ++j) { const f32x4 g = ((const f32x4*)gain)[lane + 64 * j]; const f32x4 o = v[j] * rs * g; o8[64 * j] = (u32x2){pk2(o[0], o[1]), pk2(o[2], o[3])}; }
    }
}
__device__ __forceinline__ void rms_rows_f32_inplace(float* y, const float* gain, int nvalid, int gw, int ngw, int lane) {
    for (int r = gw; r < nvalid; r += ngw) {
        f32x4* xr = (f32x4*)(y + (size_t)r * 1024) + lane;
        f32x4 v[4]; float s = 0.f;
#pragma unroll
        for (int j = 0; j < 4; ++j) { v[j] = xr[64 * j]; s += (v[j][0] * v[j][0] + v[j][1] * v[j][1]) + (v[j][2] * v[j][2] + v[j][3] * v[j][3]); }
        const float rs = 1.0f / sqrtf(wave_sum(s) * (1.f / 1024.f) + EPSN);
#pragma unroll
        for (int j = 0; j < 4; ++j) { const f32x4 g = ((const f32x4*)gain)[lane + 64 * j]; xr[64 * j] = v[j] * rs * g; }
    }
}
__device__ __forceinline__ void phase_small(const Grp& G, const float* gq, const float* gkv, const float* rope, int gw, int ngw, int lane) {
    const int ntotal = G.ntiles * 256;
    for (int r = gw; r < ntotal; r += ngw) {
        const float* z = G.ZS + (size_t)r * 768;
        const f32x4 cq = ((const f32x4*)z)[lane], ck = ((const f32x4*)(z + 256))[lane];
        const float s1 = wave_sum((cq[0] * cq[0] + cq[1] * cq[1]) + (cq[2] * cq[2] + cq[3] * cq[3]));
        const float s2 = wave_sum((ck[0] * ck[0] + ck[1] * ck[1]) + (ck[2] * ck[2] + ck[3] * ck[3]));
        const float r1 = 1.0f / sqrtf(s1 * (1.f / 256.f) + EPSN), r2 = 1.0f / sqrtf(s2 * (1.f / 256.f) + EPSN);
        const f32x4 o1 = cq * r1 * ((const f32x4*)gq)[lane], o2 = ck * r2 * ((const f32x4*)gkv)[lane];
        ((u32x2*)(G.CQ + (size_t)r * 256))[lane] = (u32x2){pk2(o1[0], o1[1]), pk2(o1[2], o1[3])};
        ((u32x2*)(G.CKV + (size_t)r * 256))[lane] = (u32x2){pk2(o2[0], o2[1]), pk2(o2[2], o2[3])};
        if (r < G.nvalid) ((f32x4*)(G.ockv + (size_t)r * 256))[lane] = o2;
        if (lane < 16) {
            const int pos = G.sample ? (PAST + (r & (ST - 1))) : (r & (TS - 1));
            const float x1 = z[512 + lane], x2 = z[512 + 16 + lane];
            const f32x2 cs = *(const f32x2*)(rope + (size_t)pos * 32 + 2 * lane);
            const float a = x1 * cs[0] - x2 * cs[1], b = x2 * cs[0] + x1 * cs[1];
            G.KR[(size_t)r * 32 + lane] = (bf16)f2bf(a); G.KR[(size_t)r * 32 + 16 + lane] = (bf16)f2bf(b);
            if (r < G.nvalid) { G.okr[(size_t)r * 32 + lane] = a; G.okr[(size_t)r * 32 + 16 + lane] = b; }
        }
    }
}

__device__ __forceinline__ void tr_item(const float* W, int K, int N, bf16* WT, int k0, int n0, int drow0, LAS float* scr, int lane) {
#pragma unroll 8
    for (int i = 0; i < 32; ++i) { const int kk = 2 * i + (lane >> 5); scr[kk * 33 + (lane & 31)] = W[(size_t)(k0 + kk) * N + n0 + (lane & 31)]; }
    asm volatile("s_waitcnt lgkmcnt(0)" ::: "memory");
    const int c = lane & 7;
#pragma unroll
    for (int j = 0; j < 4; ++j) { const int n = (lane >> 3) + 8 * j; const LAS float* s = scr + (8 * c) * 33 + n;
        u32x4 o; o.x = pk2(s[0 * 33], s[1 * 33]); o.y = pk2(s[2 * 33], s[3 * 33]); o.z = pk2(s[4 * 33], s[5 * 33]); o.w = pk2(s[6 * 33], s[7 * 33]);
        *(u32x4*)(WT + (size_t)(drow0 + n) * K + k0 + 8 * c) = o; }
    asm volatile("s_waitcnt lgkmcnt(0)" ::: "memory");
}
__device__ __forceinline__ int map_in(int n0) {
    if (n0 < 3616) return n0;
    if (n0 < 4640) return n0 - 3616 + 3840;
    return n0 - 4640 + 4864;
}
__device__ __forceinline__ int map_uq(int n0) { const int hh = n0 / 96, d0 = n0 % 96; return d0 < 64 ? hh * 64 + d0 : 1024 + hh * 32 + (d0 - 64); }
__device__ __forceinline__ void cvt8(const float* src, bf16* dst, size_t n8, size_t gt, size_t ngt) {
    for (size_t i = gt; i < n8; i += ngt) { const f32x4 a = ((const f32x4*)src)[2 * i], b = ((const f32x4*)src)[2 * i + 1];
        ((u32x4*)dst)[i] = (u32x4){pk2(a[0], a[1]), pk2(a[2], a[3]), pk2(b[0], b[1]), pk2(b[2], b[3])}; }
}
__device__ __forceinline__ void phase_prologue(const Args& a, LAS unsigned char* lds, int gw, int ngw, int lane, int wave) {
    unsigned char* ws = a.ws;
    LAS float* scr = (LAS float*)(lds + wave * 16384);
    constexpr int I_IN = 16 * 177, I_UQ = 4 * 48, I_UK = 4 * 32, I_UV = 4 * 32, I_O = 16 * 32, I_UP = 16 * 128, I_DN = 64 * 32;
    constexpr int NITEMS = I_IN + I_UQ + I_UK + I_UV + 3 * I_O + I_UP + I_DN;
    for (int it = gw; it < NITEMS; it += ngw) {
        int r = it;
        if (r < I_IN) { const int kb = r / 177, nb = r % 177; tr_item(a.in[8], 1024, 5664, (bf16*)(ws + WS_WIN), 64 * kb, 32 * nb, map_in(32 * nb), scr, lane); continue; } r -= I_IN;
        if (r < I_UQ) { const int kb = r / 48, nb = r % 48; tr_item(a.in[15], 256, 1536, (bf16*)(ws + WS_WUQ), 64 * kb, 32 * nb, map_uq(32 * nb), scr, lane); continue; } r -= I_UQ;
        if (r < I_UK) { const int kb = r / 32, nb = r % 32; tr_item(a.in[17], 256, 1024, (bf16*)(ws + WS_WUKV), 64 * kb, 32 * nb, 32 * nb, scr, lane); continue; } r -= I_UK;
        if (r < I_UV) { const int kb = r / 32, nb = r % 32; tr_item(a.in[18], 256, 1024, (bf16*)(ws + WS_WUKV), 64 * kb, 32 * nb, 1024 + 32 * nb, scr, lane); continue; } r -= I_UV;
        if (r < I_O) { const int kb = r / 32, nb = r % 32; tr_item(a.in[19], 1024, 1024, (bf16*)(ws + WS_WOD), 64 * kb, 32 * nb, 32 * nb, scr, lane); continue; } r -= I_O;
        if (r < I_O) { const int kb = r / 32, nb = r % 32; tr_item(a.in[20], 1024, 1024, (bf16*)(ws + WS_WOM), 64 * kb, 32 * nb, 32 * nb, scr, lane); continue; } r -= I_O;
        if (r < I_O) { const int kb = r / 32, nb = r % 32; tr_item(a.in[21], 1024, 1024, (bf16*)(ws + WS_WOUT), 64 * kb, 32 * nb, 32 * nb, scr, lane); continue; } r -= I_O;
        if (r < I_UP) { const int kb = r / 128, nb = r % 128; tr_item(a.in[23], 1024, 4096, (bf16*)(ws + WS_WUP), 64 * kb, 32 * nb, 32 * nb, scr, lane); continue; } r -= I_UP;
        { const int kb = r / 32, nb = r % 32; tr_item(a.in[24], 4096, 1024, (bf16*)(ws + WS_WDN), 64 * kb, 32 * nb, 32 * nb, scr, lane); }
    }
    const size_t gt = (size_t)gw * 64 + lane, ngt = (size_t)ngw * 64;
    { u32x4* z = (u32x4*)(ws + WS_WIN + (size_t)3616 * 2048); for (size_t i = gt; i < (size_t)224 * 128; i += ngt) z[i] = (u32x4){0u, 0u, 0u, 0u}; }
    unsigned char* cb = ws + WS_PROMPT;
    cvt8(a.in[2], (bf16*)(cb + C_KDC), (size_t)CACHE_ROWS * 128, gt, ngt);
    cvt8(a.in[3], (bf16*)(cb + C_VDC), (size_t)CACHE_ROWS * 128, gt, ngt);
    cvt8(a.in[4], (bf16*)(cb + C_CKVC), (size_t)CACHE_ROWS * 32, gt, ngt);
    cvt8(a.in[5], (bf16*)(cb + C_KRC), (size_t)CACHE_ROWS * 4, gt, ngt);
    float* tab = (float*)(ws + WS_TAB);
    for (size_t i = gt; i < 8 * 192; i += ngt) {
        const int h = (int)i / 192, idx = (int)i % 192, rel = idx - 128, n = rel < 0 ? -rel : rel;
        int bucket = n;
        if (n >= 8) { int j = (31 - __clz(n * n)) - 6; bucket = 8 + j; if (bucket > 15) bucket = 15; }
        if (rel > 0) bucket += 16;
        tab[i] = a.in[6][bucket * 8 + h] * LOG2E;
    }
    if (gt == 0) {
        float d1 = 0.f, d2 = 0.f;
        for (int i = 0; i < 64; ++i) { d1 += a.in[9][i] * a.in[10][i]; d2 += a.in[11][i] * a.in[12][i]; }
        tab[1536] = expf(d1) - expf(d2) + 0.2f;
    }
    float* rope = (float*)(ws + WS_ROPE);
    for (size_t i = gt; i < (size_t)(PAST + ST) * 16; i += ngt) {
        const int pos = (int)(i >> 4), k = (int)(i & 15);
        const float inv = __builtin_amdgcn_exp2f(-(float)k * 0.8304820237218406f);
        const float ang = (float)pos * inv;
        const double rev = (double)ang * 0.15915494309189535;
        const float fr = (float)(rev - __builtin_rint(rev));
        rope[2 * i] = __builtin_amdgcn_cosf(fr); rope[2 * i + 1] = __builtin_amdgcn_sinf(fr);
    }
}

#ifndef ATTMASK
#define ATTMASK 15
#endif
constexpr int AL_TAB = 0, AL_WSF = 6144, AL_TILE = 8192;

__device__ __forceinline__ int crow(int r, int hi) { return (r & 3) + 8 * (r >> 2) + 4 * hi; }
__device__ __forceinline__ float xmax32(float v) { auto rr = __builtin_amdgcn_permlane32_swap(__float_as_uint(v), __float_as_uint(v), false, false); return fmaxf(__uint_as_float(rr[0]), __uint_as_float(rr[1])); }
__device__ __forceinline__ float xsum32(float v) { auto rr = __builtin_amdgcn_permlane32_swap(__float_as_uint(v), __float_as_uint(v), false, false); return __uint_as_float(rr[0]) + __uint_as_float(rr[1]); }
typedef __bf16 bf16x2_t __attribute__((ext_vector_type(2)));
__device__ __forceinline__ unsigned cvtpk(float lo, float hi) { f32x2 v = {lo, hi}; bf16x2_t b = __builtin_convertvector(v, bf16x2_t); return __builtin_bit_cast(unsigned, b); }
__device__ __forceinline__ bf16x8 pack8(float a0, float a1, float a2, float a3, float a4, float a5, float a6, float a7) {
    u32x4 w = {cvtpk(a0, a1), cvtpk(a2, a3), cvtpk(a4, a5), cvtpk(a6, a7)}; return __builtin_bit_cast(bf16x8, w);
}
typedef short v4i16_t __attribute__((ext_vector_type(4)));
__device__ __forceinline__ s16x4 vtr(const LAS unsigned char* p) { return __builtin_bit_cast(s16x4, __builtin_amdgcn_ds_read_tr16_b64_v4i16((LAS v4i16_t*)p)); }

template <int DQK, int DV> struct AttnState { bf16x8 qf[DQK / 16]; f32x16 o[DV / 32]; float m, l; };

template <int DQK, int DV, bool HAS_BIAS>
__device__ __forceinline__ void attn_tile(AttnState<DQK, DV>& st, const LAS unsigned char* Kt, const LAS unsigned char* Vt, int bias_mode, float cbias, const LAS float* tab, int rel0, int nkeys, LAS float* wsf, int lane) {
    constexpr int PK = DQK * 2 + 16, PV = DV * 2 + 64, KS = DQK / 16, NDB = DV / 32;
    const int q = lane & 31, hi = lane >> 5;
    f32x16 p0, p1;
    if (HAS_BIAS && bias_mode == 2) {
#pragma unroll
        for (int r = 0; r < 16; ++r) {
            const int k = crow(r, hi);
            const int i0 = min(max(rel0 + k + 128, 0), 191), i1 = min(max(rel0 + k + 160, 0), 191);
            p0[r] = tab[i0]; p1[r] = tab[i1];
        }
    } else {
        const float ini = (HAS_BIAS && bias_mode == 1) ? cbias : 0.f;
#pragma unroll
        for (int r = 0; r < 16; ++r) { p0[r] = ini; p1[r] = ini; }
    }
    const LAS unsigned char* kp = Kt + q * PK + hi * 16;
#pragma unroll
    for (int ks = 0; ks < KS; ++ks) {
        const bf16x8 a0 = *(const LAS bf16x8*)(kp + ks * 32);
        const bf16x8 a1 = *(const LAS bf16x8*)(kp + 32 * PK + ks * 32);
        p0 = __builtin_amdgcn_mfma_f32_32x32x16_bf16(a0, st.qf[ks], p0, 0, 0, 0);
        p1 = __builtin_amdgcn_mfma_f32_32x32x16_bf16(a1, st.qf[ks], p1, 0, 0, 0);
    }
    __builtin_amdgcn_sched_barrier(0);
    if (nkeys < 64) {
#pragma unroll
        for (int r = 0; r < 16; ++r) { const int k = crow(r, hi); if (k >= nkeys) p0[r] = -1e30f; if (k + 32 >= nkeys) p1[r] = -1e30f; }
    }
    float mx = fmaxf(p0[0], p1[0]);
#pragma unroll
    for (int r = 1; r < 16; ++r) mx = fmaxf(mx, fmaxf(p0[r], p1[r]));
    mx = xmax32(mx);
    const float mnew = fmaxf(st.m, mx);
    if (__any(mnew > st.m)) {
        const float f = __builtin_amdgcn_exp2f(st.m - mnew);
        st.l *= f; st.m = mnew;
        if (hi == 0) wsf[q] = f;
#pragma unroll
        for (int r = 0; r < 16; ++r) { const float fr = wsf[crow(r, hi)];
#pragma unroll
            for (int db = 0; db < NDB; ++db) st.o[db][r] *= fr; }
    }
    float sum = 0.f;
#pragma unroll
    for (int r = 0; r < 16; ++r) { p0[r] = __builtin_amdgcn_exp2f(p0[r] - st.m); p1[r] = __builtin_amdgcn_exp2f(p1[r] - st.m); sum += p0[r] + p1[r]; }
    st.l += sum;
    bf16x8 pf[4];
    pf[0] = pack8(p0[0], p0[1], p0[2], p0[3], p0[4], p0[5], p0[6], p0[7]);
    pf[1] = pack8(p0[8], p0[9], p0[10], p0[11], p0[12], p0[13], p0[14], p0[15]);
    pf[2] = pack8(p1[0], p1[1], p1[2], p1[3], p1[4], p1[5], p1[6], p1[7]);
    pf[3] = pack8(p1[8], p1[9], p1[10], p1[11], p1[12], p1[13], p1[14], p1[15]);
    __builtin_amdgcn_sched_barrier(0);
    const int q4 = (lane & 15) >> 2, blk = (lane >> 4) & 1, pp = lane & 3;
    const LAS unsigned char* vp = Vt + (4 * hi + q4) * PV + (16 * blk + 4 * pp) * 2;
#pragma unroll
    for (int db = 0; db < NDB; ++db) {
#pragma unroll
        for (int s4 = 0; s4 < 4; ++s4) {
            const s16x4 lo = vtr(vp + (16 * s4) * PV + db * 64), h4 = vtr(vp + (16 * s4 + 8) * PV + db * 64);
            const bf16x8 vb = {lo[0], lo[1], lo[2], lo[3], h4[0], h4[1], h4[2], h4[3]};
            st.o[db] = __builtin_amdgcn_mfma_f32_32x32x16_bf16(pf[s4], vb, st.o[db], 0, 0, 0);
        }
        if (NDB > 2 && (db & 1)) __builtin_amdgcn_sched_barrier(0);
    }
}

template <int DQK, int DV>
__device__ __forceinline__ void attn_init(AttnState<DQK, DV>& st) {
    st.m = -1e30f; st.l = 0.f;
#pragma unroll
    for (int db = 0; db < DV / 32; ++db)
#pragma unroll
        for (int r = 0; r < 16; ++r) st.o[db][r] = 0.f;
}

template <bool DIFF>
__device__ __forceinline__ void attn_unit_coop(const Grp& G, int b, int h, int qb, LAS unsigned char* lds, float lam, const float* subln) {
    constexpr int DQK = DIFF ? 64 : 96, DV = DIFF ? 128 : 64, PK = DQK * 2 + 16, PV = DV * 2 + 64, KB = 64 * PK, VB = 64 * PV, TB = KB + VB, NDB = DV / 32;
    int tid_ = threadIdx.x; asm volatile("" : "+v"(tid_));
    const int tid = tid_, lane = tid & 63, wid = __builtin_amdgcn_readfirstlane(tid >> 6), q = lane & 31, hi = lane >> 5;
    const size_t seq0 = (size_t)b * TS;
    const int qrow0 = qb * 256 + wid * 32;
    const int NT = 4 * qb + 4, my_nt = 4 * qb + (wid >> 1) + 1;
    const LAS float* tab = (const LAS float*)(lds + AL_TAB) + h * 192;
    LAS float* wsf = (LAS float*)(lds + AL_WSF) + wid * 64;
    LAS unsigned char* tiles = lds + AL_TILE;
    const float cbias = DIFF ? tab[0] : 0.f;
#pragma unroll 1
    for (int n = 0; n < (DIFF ? 2 : 1); ++n) {
        AttnState<DQK, DV> st; attn_init(st);
        if (DIFF) { const bf16* qp = G.QD + (seq0 + qrow0 + q) * 1024 + h * 128 + n * 64 + hi * 8;
#pragma unroll
            for (int ks = 0; ks < 4; ++ks) st.qf[ks] = *(const bf16x8*)(qp + ks * 16);
        } else { const bf16* qn = G.QN + (seq0 + qrow0 + q) * 1024 + h * 64 + hi * 8; const bf16* qr = G.QR + (seq0 + qrow0 + q) * 512 + h * 32 + hi * 8;
#pragma unroll
            for (int ks = 0; ks < 4; ++ks) st.qf[ks] = *(const bf16x8*)(qn + ks * 16);
#pragma unroll
            for (int ks = 0; ks < 2; ++ks) st.qf[4 + ks] = *(const bf16x8*)(qr + ks * 16);
        }
        const bf16* ksrc = (DIFF ? G.KD + h * 128 + n * 64 : G.KN + h * 64) + (seq0 + (tid >> 3)) * 1024 + (tid & 7) * 8;
        const int kdst = (tid >> 3) * PK + (tid & 7) * 16;
        const bf16* k2src = G.KR + (seq0 + ((tid & 255) >> 2)) * 32 + (tid & 3) * 8;
        const int k2dst = ((tid & 255) >> 2) * PK + 128 + (tid & 3) * 16;
        const bf16* vsrc = DIFF ? G.VD + (seq0 + (tid >> 4)) * 1024 + h * 128 + (tid & 15) * 8 : G.VM + (seq0 + (tid >> 3)) * 1024 + h * 64 + (tid & 7) * 8;
        const int vdst = DIFF ? KB + (tid >> 4) * PV + (tid & 15) * 16 : KB + (tid >> 3) * PV + (tid & 7) * 16;
        u32x4 rk, rk2 = {0u, 0u, 0u, 0u}, rv0, rv1 = {0u, 0u, 0u, 0u};
#define ATT_LOAD(j) do { rk = *(const u32x4*)(ksrc + (size_t)(j) * 64 * 1024); if (!DIFF && tid < 256) rk2 = *(const u32x4*)(k2src + (size_t)(j) * 64 * 32); \
        rv0 = *(const u32x4*)(vsrc + (size_t)(j) * 64 * 1024); if (DIFF) rv1 = *(const u32x4*)(vsrc + (size_t)(j) * 64 * 1024 + 32 * 1024); } while (0)
#define ATT_STORE(bufp) do { *(LAS u32x4*)((bufp) + kdst) = rk; if (!DIFF && tid < 256) *(LAS u32x4*)((bufp) + k2dst) = rk2; \
        *(LAS u32x4*)((bufp) + vdst) = rv0; if (DIFF) *(LAS u32x4*)((bufp) + vdst + 32 * PV) = rv1; } while (0)
        ATT_LOAD(0); ATT_STORE(tiles);
        __syncthreads();
        for (int j = 0; j < NT; ++j) {
            LAS unsigned char* cur = tiles + (j & 1) * TB; LAS unsigned char* nxt = tiles + ((j + 1) & 1) * TB;
            if (j + 1 < NT) ATT_LOAD(j + 1);
            if (j < my_nt) {
                const int kb = 64 * j;
                const int mode = DIFF ? ((kb + 63 - qrow0 <= -128) ? 1 : 2) : 0;
                attn_tile<DQK, DV, DIFF>(st, cur, cur + KB, mode, cbias, tab, kb - (qrow0 + q), 64, wsf, lane);
            }
            if (j + 1 < NT) ATT_STORE(nxt);
            __syncthreads();
        }
#undef ATT_LOAD
#undef ATT_STORE
        const float lt = xsum32(st.l);
        if (hi == 0) wsf[32 + q] = lt;
        float inv[16];
#pragma unroll
        for (int r = 0; r < 16; ++r) inv[r] = 1.0f / wsf[32 + crow(r, hi)];
        bf16* obase = (DIFF ? (n == 0 ? G.DO : G.XN) + h * 128 : G.MO + h * 64) + (seq0 + qrow0) * 1024 + q;
#pragma unroll
        for (int db = 0; db < NDB; ++db)
#pragma unroll
            for (int r = 0; r < 16; ++r) obase[(size_t)crow(r, hi) * 1024 + db * 32] = (bf16)f2bf(st.o[db][r] * inv[r]);
    }
}

__device__ __forceinline__ void phase_diffmix(const Grp& G, float lam, const float* subln, int gw, int ngw, int lane) {
    const int c = (lane & 7) * 16;
    float g[16];
#pragma unroll
    for (int i = 0; i < 16; ++i) g[i] = subln[c + i] * 0.8f;
    for (int r = gw; r < G.nvalid; r += ngw) {
        bf16* p1 = G.DO + (size_t)r * 1024 + lane * 16; const bf16* p2 = G.XN + (size_t)r * 1024 + lane * 16;
        const u32x4 a0 = ((const u32x4*)p1)[0], a1 = ((const u32x4*)p1)[1], b0 = ((const u32x4*)p2)[0], b1 = ((const u32x4*)p2)[1];
        float v[16];
#pragma unroll
        for (int i = 0; i < 4; ++i) { v[2 * i] = bflo(a0[i]) - lam * bflo(b0[i]); v[2 * i + 1] = bfhi(a0[i]) - lam * bfhi(b0[i]);
                                      v[8 + 2 * i] = bflo(a1[i]) - lam * bflo(b1[i]); v[8 + 2 * i + 1] = bfhi(a1[i]) - lam * bfhi(b1[i]); }
        float s = 0.f;
#pragma unroll
        for (int i = 0; i < 16; ++i) s += v[i] * v[i];
        s += swz_xor<1>(s); s += swz_xor<2>(s); s += swz_xor<4>(s);
        const float rs = 1.0f / sqrtf(s * (1.f / 128.f) + EPSN);
        u32x4 o0, o1;
#pragma unroll
        for (int i = 0; i < 4; ++i) { o0[i] = pk2(v[2 * i] * rs * g[2 * i], v[2 * i + 1] * rs * g[2 * i + 1]); o1[i] = pk2(v[8 + 2 * i] * rs * g[8 + 2 * i], v[8 + 2 * i + 1] * rs * g[8 + 2 * i + 1]); }
        ((u32x4*)p1)[0] = o0; ((u32x4*)p1)[1] = o1;
    }
}

template <bool DIFF>
__device__ __forceinline__ void attn_unit_wave(const Grp& G, const unsigned char* cb, int b, int h, int n, int j0, int j1, int wu, float* PO, float* PM, float* PL,
                                               LAS unsigned char* wt, LAS float* wsf, const LAS float* tab0, int lane_in) {
    int lane = lane_in; asm volatile("" : "+v"(lane));
    constexpr int DQK = DIFF ? 64 : 96, DV = DIFF ? 128 : 64, PK = DQK * 2 + 16, PV = DV * 2 + 64, KB = 64 * PK, NDB = DV / 32;
    const int q = lane & 31, hi = lane >> 5;
    const LAS float* tab = tab0 + h * 192;
    const float cbias = DIFF ? tab[0] : 0.f;
    AttnState<DQK, DV> st; attn_init(st);
    const size_t qrow = (size_t)b * ST + q;
    if (DIFF) { const bf16* qp = G.QD + qrow * 1024 + h * 128 + n * 64 + hi * 8;
#pragma unroll
        for (int ks = 0; ks < 4; ++ks) st.qf[ks] = *(const bf16x8*)(qp + ks * 16);
    } else { const bf16* qn = G.QN + qrow * 1024 + h * 64 + hi * 8; const bf16* qr = G.QR + qrow * 512 + h * 32 + hi * 8;
#pragma unroll
        for (int ks = 0; ks < 4; ++ks) st.qf[ks] = *(const bf16x8*)(qn + ks * 16);
#pragma unroll
        for (int ks = 0; ks < 2; ++ks) st.qf[4 + ks] = *(const bf16x8*)(qr + ks * 16);
    }
    for (int j = j0; j < j1; ++j) {
        const bf16 *kA, *kB2, *vA; int nkeys;
        if (j < 64) { const size_t r0 = (size_t)b * PAST + 64 * j; nkeys = 64;
            kA = DIFF ? (const bf16*)(cb + C_KDC) + r0 * 1024 + h * 128 + n * 64 : (const bf16*)(cb + C_KNC) + r0 * 1024 + h * 64;
            kB2 = (const bf16*)(cb + C_KRC) + r0 * 32;
            vA = DIFF ? (const bf16*)(cb + C_VDC) + r0 * 1024 + h * 128 : (const bf16*)(cb + C_VMC) + r0 * 1024 + h * 64;
        } else { const size_t r0 = (size_t)b * ST; nkeys = ST;
            kA = DIFF ? G.KD + r0 * 1024 + h * 128 + n * 64 : G.KN + r0 * 1024 + h * 64;
            kB2 = G.KR + r0 * 32;
            vA = DIFF ? G.VD + r0 * 1024 + h * 128 : G.VM + r0 * 1024 + h * 64;
        }
        { u32x4 t[8];
#pragma unroll
            for (int i = 0; i < 8; ++i) { const int idx = lane + 64 * i; t[i] = *(const u32x4*)(kA + (size_t)(idx >> 3) * 1024 + (idx & 7) * 8); }
#pragma unroll
            for (int i = 0; i < 8; ++i) { const int idx = lane + 64 * i; *(LAS u32x4*)(wt + (idx >> 3) * PK + (idx & 7) * 16) = t[i]; } }
        if (!DIFF) { u32x4 t[4];
#pragma unroll
            for (int i = 0; i < 4; ++i) { const int idx = lane + 64 * i; t[i] = *(const u32x4*)(kB2 + (size_t)(idx >> 2) * 32 + (idx & 3) * 8); }
#pragma unroll
            for (int i = 0; i < 4; ++i) { const int idx = lane + 64 * i; *(LAS u32x4*)(wt + (idx >> 2) * PK + 128 + (idx & 3) * 16) = t[i]; } }
        if (DIFF) {
#pragma unroll
            for (int hf = 0; hf < 2; ++hf) { u32x4 t[8];
#pragma unroll
                for (int i = 0; i < 8; ++i) { const int idx = lane + 64 * i + 512 * hf; t[i] = *(const u32x4*)(vA + (size_t)(idx >> 4) * 1024 + (idx & 15) * 8); }
#pragma unroll
                for (int i = 0; i < 8; ++i) { const int idx = lane + 64 * i + 512 * hf; *(LAS u32x4*)(wt + KB + (idx >> 4) * PV + (idx & 15) * 16) = t[i]; } }
        } else { u32x4 t[8];
#pragma unroll
            for (int i = 0; i < 8; ++i) { const int idx = lane + 64 * i; t[i] = *(const u32x4*)(vA + (size_t)(idx >> 3) * 1024 + (idx & 7) * 8); }
#pragma unroll
            for (int i = 0; i < 8; ++i) { const int idx = lane + 64 * i; *(LAS u32x4*)(wt + KB + (idx >> 3) * PV + (idx & 7) * 16) = t[i]; } }
        const int kb = 64 * j;
        const int mode = DIFF ? ((j <= 61) ? 1 : 2) : 0;
        attn_tile<DQK, DV, DIFF>(st, wt, wt + KB, mode, cbias, tab, kb - (PAST + q), nkeys, wsf, lane);
    }
    const float lt = xsum32(st.l);
    if (hi == 0) { PM[wu * 32 + q] = st.m; PL[wu * 32 + q] = lt; }
#pragma unroll
    for (int db = 0; db < NDB; ++db)
#pragma unroll
        for (int r = 0; r < 16; ++r) PO[((size_t)wu * 32 + crow(r, hi)) * DV + db * 32 + q] = st.o[db][r];
}

__device__ __forceinline__ void phase_combine(const Grp& G, const float* POd, const float* POm, const float* PM, const float* PL, float lam, const float* subln, int gw, int ngw, int lane) {
    for (int it = gw; it < SB * 8 * ST + SB * 16 * ST; it += ngw) {
        if (it < SB * 8 * ST) {
            const int qq = it & 15, h = (it >> 4) & 7, b = it >> 7;
            float val[2] = {0.f, 0.f};
#pragma unroll
            for (int n = 0; n < 2; ++n) {
                const int wu0 = ((b * 8 + h) * 2 + n) * NSPLIT;
                float M = -1e30f;
#pragma unroll
                for (int s = 0; s < NSPLIT; ++s) M = fmaxf(M, PM[(wu0 + s) * 32 + qq]);
                float L = 0.f, a0 = 0.f, a1 = 0.f;
#pragma unroll
                for (int s = 0; s < NSPLIT; ++s) { const float w = __builtin_amdgcn_exp2f(PM[(wu0 + s) * 32 + qq] - M); L += PL[(wu0 + s) * 32 + qq] * w;
                    const float* po = POd + ((size_t)(wu0 + s) * 32 + qq) * 128; a0 += po[lane] * w; a1 += po[lane + 64] * w; }
                const float sc = (n == 0 ? 1.f : -lam) / L;
                val[0] += a0 * sc; val[1] += a1 * sc;
            }
            const float ss = wave_sum(val[0] * val[0] + val[1] * val[1]);
            const float rs = 0.8f / sqrtf(ss * (1.f / 128.f) + EPSN);
            bf16* o = G.DO + (size_t)(b * ST + qq) * 1024 + h * 128;
            o[lane] = (bf16)f2bf(val[0] * rs * subln[lane]); o[lane + 64] = (bf16)f2bf(val[1] * rs * subln[lane + 64]);
        } else {
            const int i2 = it - SB * 8 * ST; const int qq = i2 & 15, h = (i2 >> 4) & 15, b = i2 >> 8;
            const int wu0 = 512 + (b * 16 + h) * NSPLIT;
            float M = -1e30f;
#pragma unroll
            for (int s = 0; s < NSPLIT; ++s) M = fmaxf(M, PM[(wu0 + s) * 32 + qq]);
            float L = 0.f, a0 = 0.f;
#pragma unroll
            for (int s = 0; s < NSPLIT; ++s) { const float w = __builtin_amdgcn_exp2f(PM[(wu0 + s) * 32 + qq] - M); L += PL[(wu0 + s) * 32 + qq] * w;
                a0 += POm[((size_t)(wu0 - 512 + s) * 32 + qq) * 64 + lane] * w; }
            G.MO[(size_t)(b * ST + qq) * 1024 + h * 64 + lane] = (bf16)f2bf(a0 / L);
        }
    }
}

__device__ __forceinline__ void phase_attention(const Args& a, const Grp& G, LAS unsigned char* lds) {
    int tid_ = threadIdx.x; asm volatile("" : "+v"(tid_));
    const int tid = tid_, lane = tid & 63, wid = __builtin_amdgcn_readfirstlane(tid >> 6);
    const float* tabg = (const float*)(a.ws + WS_TAB);
    for (int i = tid; i < 8 * 192; i += 512) ((LAS float*)(lds + AL_TAB))[i] = tabg[i];
    const float lam = tabg[1536];
    const float* subln = a.in[13];
    __syncthreads();
    if (G.sample) {
        if (wid < 4) {
            constexpr int TBD = 64 * (64 * 2 + 16) + 64 * (128 * 2 + 64);
            LAS unsigned char* wt = lds + AL_TILE + wid * TBD;
            LAS float* wsf = (LAS float*)(lds + AL_WSF) + wid * 64;
            const LAS float* tab0 = (const LAS float*)(lds + AL_TAB);
            const unsigned char* cb = a.ws + WS_PROMPT;
            for (int wu = (int)blockIdx.x * 4 + wid; wu < 1024; wu += (int)gridDim.x * 4) {
                const int s = wu & 3; const int j0 = s == 0 ? 0 : 17 + 16 * (s - 1), j1 = 17 + 16 * s;
                if (wu < 512) {
#if ATTMASK & 1
 const int n = (wu >> 2) & 1, h = (wu >> 3) & 7, b = wu >> 6;
                    attn_unit_wave<true>(G, cb, b, h, n, j0, j1, wu, (float*)(a.ws + WS_PO_D), (float*)(a.ws + WS_PM), (float*)(a.ws + WS_PL), wt, wsf, tab0, lane);
#endif
                } else {
#if ATTMASK & 2
 const int i2 = wu - 512; const int h = (i2 >> 2) & 15, b = i2 >> 6;
                    attn_unit_wave<false>(G, cb, b, h, 0, j0, j1, wu, (float*)(a.ws + WS_PO_M) - (size_t)512 * 32 * 64, (float*)(a.ws + WS_PM), (float*)(a.ws + WS_PL), wt, wsf, tab0, lane);
#endif
                }
            }
        }
    } else {
        for (int v = (int)blockIdx.x; v < 256; v += (int)gridDim.x) {
            { const int bh = v >> 1, b = bh >> 3, h = bh & 7, par = v & 1;
                for (int i = 0; i < 4; ++i) { const int qb = par ? ((i == 0) ? 6 : (i == 1) ? 1 : (i == 2) ? 4 : 3) : ((i == 0) ? 7 : (i == 1) ? 0 : (i == 2) ? 5 : 2);

#if ATTMASK & 4
                    attn_unit_coop<true>(G, b, h, qb, lds, lam, subln);
#endif
 } }
            { const int b = v >> 4, h = v & 15;

#if ATTMASK & 8
                for (int qb = 7; qb >= 0; --qb) attn_unit_coop<false>(G, b, h, qb, lds, lam, subln);
#endif
 }
        }
    }
}

constexpr int LDS_BYTES = 147456;
#ifndef PHMASK
#define PHMASK 0xffff
#endif

#define XB_TMO      128
#define XB_XCNT(j)  (256  + 64 * (j))
#define XB_XSUB(j)  (1280 + 64 * (j))
#define XB_XGEN(j)  (2304 + 64 * (j))
#define XB_TOP      3328
#define XB_TOPGEN   3392
#define XCD_BAR_WORDS 3456
#define XB_SPIN_CAP (1u << 18)

__device__ __forceinline__ unsigned xb_ld(unsigned* p)              { return __hip_atomic_load(p, __ATOMIC_RELAXED, __HIP_MEMORY_SCOPE_AGENT); }
__device__ __forceinline__ unsigned xb_add(unsigned* p, unsigned v) { return __hip_atomic_fetch_add(p, v, __ATOMIC_RELAXED, __HIP_MEMORY_SCOPE_AGENT); }
__device__ __forceinline__ unsigned xb_xcc_id() { return (unsigned)__builtin_amdgcn_s_getreg((3 << 11) | 20) & 0xFu; }
#define XB_SPIN(cond, bar) do { unsigned _sp = 0; while (cond) { __builtin_amdgcn_s_sleep(1); \
    if ((++_sp & 255u) == 0u) { if (xb_ld(&(bar)[XB_TMO])) break; if (_sp > XB_SPIN_CAP) { atomicAdd(&(bar)[XB_TMO], 1u); break; } } } } while (0)

struct XcdBarrier {
    unsigned* bar; unsigned x;
    volatile LAS unsigned* st;
};

__device__ __forceinline__ XcdBarrier xcd_barrier_post(unsigned* bar, volatile LAS unsigned* st) {
    XcdBarrier b; b.bar = bar; b.x = xb_xcc_id(); b.st = st;
    if (threadIdx.x == 0) (void)xb_add(&bar[XB_XCNT(b.x)], 1u);
    return b;
}
__device__ __forceinline__ void xcd_barrier_complete(unsigned* bar, unsigned x, unsigned& nloc, unsigned& nx) {
    const unsigned G = gridDim.x * gridDim.y * gridDim.z;
    unsigned sum, cnt, mine, sp = 0u;
    for (;;) {
        sum = 0u; cnt = 0u; mine = 0u;
#pragma unroll
        for (unsigned j = 0; j < 16; ++j) { const unsigned c = xb_ld(&bar[XB_XCNT(j)]); sum += c; cnt += (c > 0u) ? 1u : 0u; mine = (j == x) ? c : mine; }
        if (sum == G) break;
        __builtin_amdgcn_s_sleep(1);
        if ((++sp & 255u) == 0u) { if (xb_ld(&bar[XB_TMO])) break; if (sp > XB_SPIN_CAP) { atomicAdd(&bar[XB_TMO], 1u); break; } }
    }
    nloc = mine > 0u ? mine : 1u; nx = cnt > 0u ? cnt : 1u;
}

__device__ __forceinline__ void xcd_barrier(const XcdBarrier& b) {
    asm volatile("s_waitcnt vmcnt(0)" ::: "memory");
    __syncthreads();
    if (threadIdx.x == 0) {
        unsigned* bar = b.bar;
        __builtin_amdgcn_s_waitcnt(0);
        unsigned nloc = b.st[0], nx = b.st[1];
        if (nloc == 0u) { xcd_barrier_complete(bar, b.x, nloc, nx); b.st[0] = nloc; b.st[1] = nx; }
        const unsigned old = xb_add(&bar[XB_XSUB(b.x)], 1u);
        const unsigned gen = old / nloc;
        if (old + 1u == (gen + 1u) * nloc) {
            __builtin_amdgcn_fence(__ATOMIC_RELEASE, "agent");
            asm volatile("s_waitcnt vmcnt(0)" ::: "memory");
            const unsigned og = xb_add(&bar[XB_TOP], 1u);
            const unsigned tg = og / nx;
            if (og + 1u == (tg + 1u) * nx) xb_add(&bar[XB_TOPGEN], 1u);
            else XB_SPIN(xb_ld(&bar[XB_TOPGEN]) == tg, bar);
            __builtin_amdgcn_fence(__ATOMIC_ACQUIRE, "agent");
            xb_add(&bar[XB_XGEN(b.x)], 1u);
            asm volatile("s_waitcnt vmcnt(0)" ::: "memory");
        } else {
            XB_SPIN(xb_ld(&bar[XB_XGEN(b.x)]) == gen, bar);
            __builtin_amdgcn_fence(__ATOMIC_ACQUIRE, "agent");
            asm volatile("s_waitcnt vmcnt(0)" ::: "memory");
        }
    }
    __syncthreads();
}

constexpr size_t WS_BAR = 786432;
constexpr int LDS_BARST = 131072 + 512;
constexpr int LDS_PTAB = 131072;
__device__ __forceinline__ const void* lds_ptr(LAS const unsigned long long* pt, int i) {
    const unsigned long long v = pt[i];
    const unsigned lo = __builtin_amdgcn_readfirstlane((unsigned)v), hi = __builtin_amdgcn_readfirstlane((unsigned)(v >> 32));
    return (const void*)(const __attribute__((address_space(1))) void*)(((unsigned long long)hi << 32) | lo);
}
__device__ __forceinline__ Args load_args(LAS unsigned char* lds) {
    int z = 0; asm volatile("" : "+s"(z));
    LAS const unsigned long long* pt = (LAS const unsigned long long*)(lds + LDS_PTAB + z);
    Args a;
#pragma unroll
    for (int i = 0; i < 26; ++i) a.in[i] = (const float*)lds_ptr(pt, i);
    a.out = (float*)lds_ptr(pt, 26); a.ws = (unsigned char*)lds_ptr(pt, 27); a.pad0 = 0; a.pad1 = 0;
    return a;
}
__global__ void __launch_bounds__(512, 2) fwd_megakernel(Args ka) {
    extern __shared__ __attribute__((aligned(16))) unsigned char lds_raw[];
    LAS unsigned char* lds = (LAS unsigned char*)lds_raw;
    cg::grid_group grid = cg::this_grid();
    if (threadIdx.x == 0) {
        LAS unsigned long long* pt = (LAS unsigned long long*)(lds + LDS_PTAB);
#pragma unroll
        for (int i = 0; i < 26; ++i) pt[i] = (unsigned long long)ka.in[i];
        pt[26] = (unsigned long long)ka.out; pt[27] = (unsigned long long)ka.ws;
    }
    if (threadIdx.x == 0) { ((LAS unsigned*)(lds + LDS_BARST))[0] = 0u; ((LAS unsigned*)(lds + LDS_BARST))[1] = 0u; }
    __syncthreads();
    (void)xcd_barrier_post((unsigned*)(ka.ws + WS_BAR), (volatile LAS unsigned*)(lds + LDS_BARST));
#if PHMASK & 1
    { const int tid = threadIdx.x, lane = tid & 63, wave = __builtin_amdgcn_readfirstlane(tid >> 6); const Args a = load_args(lds);
      phase_prologue(a, lds, (int)blockIdx.x * 8 + wave, (int)gridDim.x * 8, lane, wave); }
#endif
    grid.sync();

#define GBAR() do { int z_ = 0; asm volatile("" : "+s"(z_)); XcdBarrier b_; b_.bar = (unsigned*)((unsigned char*)lds_ptr((LAS const unsigned long long*)(lds + LDS_PTAB + z_), 27) + WS_BAR); \
    b_.x = xb_xcc_id(); b_.st = (volatile LAS unsigned*)(lds + LDS_BARST + z_); xcd_barrier(b_); } while (0)
#define PH_BEGIN int tid_ = threadIdx.x, g_ = g; asm volatile("" : "+v"(tid_), "+s"(g_)); const int lane = tid_ & 63, wave = __builtin_amdgcn_readfirstlane(tid_ >> 6); \
    const int gw = (int)blockIdx.x * 8 + wave, ngw = (int)gridDim.x * 8; const Args a = load_args(lds); unsigned char* ws = a.ws; const float* rope = (const float*)(ws + WS_ROPE); (void)rope; const Grp G = make_grp(a, g_); const int M = G.ntiles * 256; (void)lane; (void)gw; (void)ngw; (void)M;
#pragma unroll 1
    for (int g = 0; g < NGRP; ++g) {
        { PH_BEGIN rms_rows_bf16(G.x, G.XN, a.in[7], G.nvalid, M, gw, ngw, lane); }
        GBAR();
#if PHMASK & 2
        { PH_BEGIN EpiIn E{G.QD, G.KD, G.VD, G.GD, G.GM, G.ZS, G.okd, G.ovd, G.nvalid, 0.125f * LOG2E};
          run_gemm(lds, G.XN, (const bf16*)(ws + WS_WIN), M, NIN, 1024, E); }
#endif
        GBAR();
        { PH_BEGIN phase_small(G, a.in[14], a.in[16], rope, gw, ngw, lane); }
        GBAR();
#if PHMASK & 4
        { PH_BEGIN EpiQ E{G.QN, G.QR, rope, G.sample, 0.10206207261596575f * LOG2E};
          run_gemm(lds, G.CQ, (const bf16*)(ws + WS_WUQ), M, 1536, 256, E); }
#endif
#if PHMASK & 8
        { PH_BEGIN EpiKV E{G.KN, G.VM};
          run_gemm(lds, G.CKV, (const bf16*)(ws + WS_WUKV), M, 2048, 256, E); }
        if (g == 0) { PH_BEGIN EpiKV E{(bf16*)(ws + WS_PROMPT + C_KNC), (bf16*)(ws + WS_PROMPT + C_VMC)};
          run_gemm(lds, (const bf16*)(ws + WS_PROMPT + C_CKVC), (const bf16*)(ws + WS_WUKV), CACHE_ROWS, 2048, 256, E); }
#endif
        GBAR();
#if PHMASK & 16
        { PH_BEGIN phase_attention(a, G, lds); }
#endif
        GBAR();
        if (g != 0) {
            { PH_BEGIN phase_diffmix(G, ((const float*)(ws + WS_TAB))[1536], a.in[13], gw, ngw, lane); }
            GBAR();
        }
        if (g == 0) {
            { PH_BEGIN phase_combine(G, (const float*)(ws + WS_PO_D), (const float*)(ws + WS_PO_M), (const float*)(ws + WS_PM), (const float*)(ws + WS_PL), ((const float*)(ws + WS_TAB))[1536], a.in[13], gw, ngw, lane); }
            GBAR();
        }
#if PHMASK & 32
        { PH_BEGIN EpiM1 E{G.GD, G.XN}; run_gemm(lds, G.DO, (const bf16*)(ws + WS_WOD), M, 1024, 1024, E); }
        { PH_BEGIN EpiM2 E{G.GM, G.XN}; run_gemm(lds, G.MO, (const bf16*)(ws + WS_WOM), M, 1024, 1024, E); }
#endif
        GBAR();
#if PHMASK & 64
        { PH_BEGIN EpiOut E{G.x, G.y, G.nvalid}; run_gemm(lds, G.XN, (const bf16*)(ws + WS_WOUT), M, 1024, 1024, E); }
#endif
        GBAR();
        { PH_BEGIN rms_rows_bf16(G.y, G.XN, a.in[22], G.nvalid, M, gw, ngw, lane); }
        GBAR();
#if PHMASK & 128
        { PH_BEGIN EpiUp E{G.U}; run_gemm(lds, G.XN, (const bf16*)(ws + WS_WUP), M, 4096, 1024, E); }
#endif
        GBAR();
#if PHMASK & 256
        { PH_BEGIN EpiDown E{G.y, G.nvalid}; run_gemm(lds, G.U, (const bf16*)(ws + WS_WDN), M, 1024, 4096, E); }
#endif
        GBAR();
        { PH_BEGIN rms_rows_f32_inplace(G.y, a.in[25], G.nvalid, gw, ngw, lane); }
    }
}

extern "C" void kernel_launch(void* const* d_in, const int* in_sizes, int n_in, void* d_out, int out_size, void* d_ws, size_t ws_size, hipStream_t stream) {
    static int grid = 0;
    if (grid == 0) {
        if (n_in != 26 || ws_size < WS_NEED) { fprintf(stderr, "kernel_launch: need 26 inputs and %zu bytes of workspace; got %d, %zu\n", (size_t)WS_NEED, n_in, ws_size); grid = -1; return; }
        int dev = 0, cus = 0, per_cu = 0;
        if (hipGetDevice(&dev) != hipSuccess || hipDeviceGetAttribute(&cus, hipDeviceAttributeMultiprocessorCount, dev) != hipSuccess) { grid = -1; return; }
        if (hipFuncSetAttribute((const void*)fwd_megakernel, hipFuncAttributeMaxDynamicSharedMemorySize, LDS_BYTES) != hipSuccess) { fprintf(stderr, "kernel_launch: hipFuncSetAttribute failed\n"); grid = -1; return; }
        if (hipOccupancyMaxActiveBlocksPerMultiprocessor(&per_cu, (const void*)fwd_megakernel, 512, LDS_BYTES) != hipSuccess || per_cu < 1) { fprintf(stderr, "kernel_launch: occupancy query says %d\n", per_cu); per_cu = 1; }
        (void)hipGetLastError();
        grid = cus;
    }
    if (grid < 0) return;
    if (hipMemsetAsync((char*)d_ws + WS_BAR, 0, 16384, stream) != hipSuccess) { fprintf(stderr, "kernel_launch: memset failed\n"); return; }
    Args a{};
    for (int i = 0; i < 26; ++i) a.in[i] = (const float*)d_in[i];
    a.out = (float*)d_out; a.ws = (unsigned char*)d_ws;
    void* args[] = {&a};
    hipError_t e = hipLaunchCooperativeKernel((const void*)fwd_megakernel, dim3(grid), dim3(512), args, LDS_BYTES, stream);
    if (e != hipSuccess) fprintf(stderr, "kernel_launch: cooperative launch failed: %s (grid %d)\n", hipGetErrorString(e), grid);
}
```

```cpp
#include <hip/hip_runtime.h>
#include <hip/hip_cooperative_groups.h>
#include <cstdio>
#include <cstdint>
namespace cg = cooperative_groups;
namespace pg8 {
#define PG8_LAS __attribute__((address_space(3)))
typedef unsigned short bf16_t;
typedef short bf16x8 __attribute__((ext_vector_type(8)));
typedef float f32x4 __attribute__((ext_vector_type(4)));
typedef unsigned u32x4 __attribute__((ext_vector_type(4)));
constexpr int BM = 256, BK = 64, HALF = 128, HTB = HALF * BK * 2  , STAGE_BYTES = 8 * HTB, NXCD = 8, WGM = 8;

__host__ __device__ __forceinline__ int lds_byte(int r, int c) { const int st = (r >> 4) * 2 + (c >> 5), rr = r & 15, cc = c & 31, ob = rr * 64 + cc * 2; return st * 1024 + (ob ^ (((ob >> 9) & 1) << 5)); }
__host__ __device__ __forceinline__ void stage_rc(int b, int& R, int& C) { const int st = b / 1024, sb = b % 1024, swz = sb ^ (((sb >> 9) & 1) << 5); R = (st >> 1) * 16 + swz / 64; C = (st & 1) * 32 + (swz % 64) / 2; }
__host__ __device__ __forceinline__ int perm32(int rho) { const int n = rho >> 4, i = rho & 15; return 8 * (i >> 2) + 4 * n + (i & 3); }

struct Unit { int pm, pn; };
struct Gemm { const bf16_t* A; const bf16_t* Bt; int M, N, K; };

struct StaticOrder {
    int nM, nN, nwg, G, c;
    __host__ __device__ void init(int M, int N, int G_, int c_) { nM = M / BM; nN = N / BM; nwg = nM * nN; G = G_; c = c_; }
    __host__ __device__ bool next(int i, Unit& u) const {
        const long L = (long)i * G + c; if (L >= nwg) return false;
        int wgid = (int)L; { const int q = nwg / NXCD, r = nwg % NXCD, xcd = wgid % NXCD, off = wgid / NXCD; wgid = (xcd < r ? xcd * (q + 1) : r * (q + 1) + (xcd - r) * q) + off; }
        const int nig = WGM * nN, gid = wgid / nig, fm = gid * WGM, gsz = (nM - fm) < WGM ? (nM - fm) : WGM;
        u.pm = fm + ((wgid % nig) % gsz); u.pn = (wgid % nig) / gsz; return true;
    }
    __device__ __forceinline__ void a_ready(const Unit&) const {}
    __device__ __forceinline__ void done(const Unit&) const {}
};

__device__ __forceinline__ unsigned cvt_pk_bf16(float lo, float hi) { unsigned r; asm volatile("v_cvt_pk_bf16_f32 %0, %1, %2" : "=v"(r) : "v"(lo), "v"(hi)); return r; }
typedef float f32x2 __attribute__((ext_vector_type(2)));
template <class Epi, class Sched, bool ALIGN_EPI = false, bool SP2 = false>
__device__ __forceinline__ void gemm_phase(PG8_LAS unsigned char* lds, const Gemm g, const Sched& S, const Epi& E, const int tid_in) {
    int tid_ = tid_in; asm volatile("" : "+v"(tid_));
    const int tid = tid_, wid = __builtin_amdgcn_readfirstlane(tid >> 6), lane = tid & 63, wr = wid >> 2, wc = wid & 3, fr = lane & 15, fq = lane >> 4;
    const int K = g.K, nt = K / BK;
    unsigned voffA[2], voffB[2];
#pragma unroll
    for (int i = 0; i < 2; ++i) { int R, C; stage_rc(tid * 16 + i * 8192, R, C); const int Rb = Epi::PERM ? ((R & ~31) + perm32(R & 31)) : R;
        voffA[i] = (unsigned)(R * K + C) * 2u; voffB[i] = (unsigned)(Rb * K + C) * 2u; }
    const size_t kstep = (size_t)(BK * 2);
    const size_t hstep = (size_t)HALF * K * 2;
    const size_t tstep = 2 * hstep;
    const unsigned ldsw = (unsigned)wid * 1024u;
    const int aoff = lds_byte(wr * 64 + fr, fq * 8), boff = lds_byte(wc * 32 + fr, fq * 8);
#define PG8_SA(b, h) (((b) * 2 + (h)) * HTB)
#define PG8_SB(b, h) ((4 + (b) * 2 + (h)) * HTB)
#define PG8_STAGE(bufoff, gbase, voff) do { _Pragma("unroll") for (int _i = 0; _i < 2; ++_i) \
        __builtin_amdgcn_global_load_lds((const unsigned*)((const char*)(gbase) + (voff)[_i]), (PG8_LAS unsigned*)(lds + (bufoff) + ldsw + _i * 8192), 16, 0, 0); } while (0)
#define PG8_LDA(dst, b, h) do { _Pragma("unroll") for (int m = 0; m < 4; ++m) _Pragma("unroll") for (int k = 0; k < 2; ++k) dst[m][k] = *(const PG8_LAS bf16x8*)(lds + PG8_SA(b, h) + aoff + m * 2048 + k * 1024); } while (0)
#define PG8_LDB(dst, b, h) do { _Pragma("unroll") for (int n = 0; n < 2; ++n) _Pragma("unroll") for (int k = 0; k < 2; ++k) dst[n][k] = *(const PG8_LAS bf16x8*)(lds + PG8_SB(b, h) + boff + n * 2048 + k * 1024); } while (0)
#define PG8_MMA(ai, bj, At, Bt) do { __builtin_amdgcn_s_setprio(1); _Pragma("unroll") for (int m = 0; m < 4; ++m) _Pragma("unroll") for (int n = 0; n < 2; ++n) _Pragma("unroll") for (int k = 0; k < 2; ++k) \
        acc[ai][bj][m][n] = __builtin_amdgcn_mfma_f32_16x16x32_bf16(Bt[n][k], At[m][k], acc[ai][bj][m][n], 0, 0, 0); __builtin_amdgcn_s_setprio(0); } while (0)
#define PG8_WAIT_V(n) asm volatile("s_waitcnt vmcnt(" #n ")" ::: "memory")
#define PG8_WAIT_L(n) asm volatile("s_waitcnt lgkmcnt(" #n ")" ::: "memory")
#define PG8_BAR __builtin_amdgcn_s_barrier()
#define PG8_SCHED __builtin_amdgcn_sched_barrier(0)
    Unit cur, nxt; int ui = 0;
    if (!S.next(0, cur)) return;
    f32x4 acc[2][2][4][2];
#pragma unroll
    for (int a = 0; a < 2; ++a)
#pragma unroll
        for (int b = 0; b < 2; ++b)
#pragma unroll
            for (int m = 0; m < 4; ++m)
#pragma unroll
                for (int n = 0; n < 2; ++n) acc[a][b][m][n] = (f32x4){0.f, 0.f, 0.f, 0.f};
    bf16x8 At[4][2], B0[2][2], B1[2][2];
    const char* cA = (const char*)g.A + (size_t)cur.pm * tstep; const char* cB = (const char*)g.Bt + (size_t)cur.pn * tstep;
    S.a_ready(cur);
    if constexpr (SP2) {
        PG8_STAGE(PG8_SB(0, 0), cB, voffB); PG8_STAGE(PG8_SB(0, 1), cB + hstep, voffB); PG8_STAGE(PG8_SA(0, 0), cA, voffA); PG8_STAGE(PG8_SA(0, 1), cA + hstep, voffA);
        if (wr == 1) PG8_BAR;
        PG8_WAIT_V(2); PG8_BAR;
        PG8_STAGE(PG8_SB(1, 0), cB + kstep, voffB); PG8_STAGE(PG8_SA(1, 0), cA + kstep, voffA); PG8_STAGE(PG8_SB(1, 1), cB + hstep + kstep, voffB);
        PG8_WAIT_V(6); PG8_BAR;
    } else {
        PG8_STAGE(PG8_SB(0, 0), cB, voffB); PG8_STAGE(PG8_SA(0, 0), cA, voffA); PG8_STAGE(PG8_SB(0, 1), cB + hstep, voffB); PG8_STAGE(PG8_SA(0, 1), cA + hstep, voffA);
        if (wr == 1) PG8_BAR;
        PG8_WAIT_V(4); PG8_BAR;
        PG8_STAGE(PG8_SB(1, 0), cB + kstep, voffB); PG8_STAGE(PG8_SA(1, 0), cA + kstep, voffA); PG8_STAGE(PG8_SB(1, 1), cB + hstep + kstep, voffB);
        PG8_WAIT_V(6); PG8_BAR;
    }
    for (;;) {
        const bool has_next = S.next(ui + 1, nxt);
        const char* nA = has_next ? (const char*)g.A + (size_t)nxt.pm * tstep : cA; const char* nB = has_next ? (const char*)g.Bt + (size_t)nxt.pn * tstep : cB;
        for (int t = 0; t < nt; t += 2) {
            const bool last = (t == nt - 2);
            const char* a1 = cA + (size_t)(t + 1) * kstep;
            const char* a2 = last ? nA : cA + (size_t)(t + 2) * kstep; const char* b2 = last ? nB : cB + (size_t)(t + 2) * kstep;
            const char* a3 = a2 + kstep; const char* b3 = b2 + kstep;
            if (last && has_next) S.a_ready(nxt);
            if constexpr (SP2) {
            PG8_LDB(B0, 0, 0); PG8_LDB(B1, 0, 1); PG8_SCHED; PG8_LDA(At, 0, 0); PG8_STAGE(PG8_SA(1, 1), a1 + hstep, voffA);
            PG8_WAIT_V(8); PG8_WAIT_L(0); PG8_BAR; PG8_MMA(0, 0, At, B0); PG8_MMA(0, 1, At, B1); PG8_BAR; PG8_SCHED;
            PG8_LDA(At, 0, 1); PG8_STAGE(PG8_SB(0, 0), b2, voffB); PG8_STAGE(PG8_SB(0, 1), b2 + hstep, voffB); PG8_STAGE(PG8_SA(0, 0), a2, voffA);
            PG8_WAIT_V(8); PG8_WAIT_L(0); PG8_BAR; PG8_MMA(1, 0, At, B0); PG8_MMA(1, 1, At, B1); PG8_BAR; PG8_SCHED;
            PG8_LDB(B0, 1, 0); PG8_LDB(B1, 1, 1); PG8_SCHED; PG8_LDA(At, 1, 0); PG8_STAGE(PG8_SA(0, 1), a2 + hstep, voffA);
            PG8_WAIT_V(8); PG8_WAIT_L(0); PG8_BAR; PG8_MMA(0, 0, At, B0); PG8_MMA(0, 1, At, B1); PG8_BAR; PG8_SCHED;
            PG8_LDA(At, 1, 1); PG8_STAGE(PG8_SB(1, 0), b3, voffB); PG8_STAGE(PG8_SB(1, 1), b3 + hstep, voffB); PG8_STAGE(PG8_SA(1, 0), a3, voffA);
            PG8_WAIT_V(8); PG8_WAIT_L(0); PG8_BAR; PG8_MMA(1, 0, At, B0); PG8_MMA(1, 1, At, B1); PG8_BAR; PG8_SCHED;
            } else {
            PG8_LDB(B0, 0, 0); PG8_SCHED; PG8_LDA(At, 0, 0); PG8_STAGE(PG8_SA(1, 1), a1 + hstep, voffA);
            PG8_WAIT_L(8); PG8_BAR; PG8_WAIT_L(0); PG8_MMA(0, 0, At, B0); PG8_BAR; PG8_SCHED;
            PG8_LDB(B1, 0, 1); PG8_STAGE(PG8_SB(0, 0), b2, voffB);
            PG8_BAR; PG8_WAIT_L(0); PG8_MMA(0, 1, At, B1); PG8_BAR;
            PG8_LDA(At, 0, 1); PG8_STAGE(PG8_SA(0, 0), a2, voffA);
            PG8_BAR; PG8_WAIT_L(0); PG8_MMA(1, 0, At, B0); PG8_BAR; PG8_SCHED;
            PG8_STAGE(PG8_SB(0, 1), b2 + hstep, voffB);
            PG8_WAIT_V(6); PG8_BAR; PG8_MMA(1, 1, At, B1); PG8_BAR;
            PG8_LDB(B0, 1, 0); PG8_SCHED; PG8_LDA(At, 1, 0); PG8_STAGE(PG8_SA(0, 1), a2 + hstep, voffA);
            PG8_WAIT_L(8); PG8_BAR; PG8_WAIT_L(0); PG8_MMA(0, 0, At, B0); PG8_BAR; PG8_SCHED;
            PG8_LDB(B1, 1, 1); PG8_STAGE(PG8_SB(1, 0), b3, voffB);
            PG8_BAR; PG8_WAIT_L(0); PG8_MMA(0, 1, At, B1); PG8_BAR;
            PG8_LDA(At, 1, 1); PG8_STAGE(PG8_SA(1, 0), a3, voffA);
            PG8_BAR; PG8_WAIT_L(0); PG8_MMA(1, 0, At, B0); PG8_BAR; PG8_SCHED;
            PG8_STAGE(PG8_SB(1, 1), b3 + hstep, voffB);
            PG8_WAIT_V(6); PG8_BAR; PG8_MMA(1, 1, At, B1); PG8_BAR;
            }
        }
        if constexpr (ALIGN_EPI) { if (wr == 0) PG8_BAR; }
        if constexpr (!Epi::AFTER_DRAIN) { E(acc, cur, wr, wc, fr, fq); S.done(cur); }
        if (!has_next) break;
#pragma unroll
        for (int a = 0; a < 2; ++a)
#pragma unroll
            for (int b = 0; b < 2; ++b)
#pragma unroll
                for (int m = 0; m < 4; ++m)
#pragma unroll
                    for (int n = 0; n < 2; ++n) acc[a][b][m][n] = (f32x4){0.f, 0.f, 0.f, 0.f};
        cur = nxt; cA = nA; cB = nB; ++ui;
        if constexpr (ALIGN_EPI) { if (wr == 1) PG8_BAR; }
    }
    PG8_WAIT_V(0);
    if constexpr (!ALIGN_EPI) { if (wr == 0) PG8_BAR; }
    PG8_BAR;
    if constexpr (Epi::AFTER_DRAIN) { E.fused(acc, cur, wr, wc, fr, fq, lds, wid, lane); S.done(cur); }
#undef PG8_SA
#undef PG8_SB
#undef PG8_STAGE
#undef PG8_LDA
#undef PG8_LDB
#undef PG8_MMA
#undef PG8_WAIT_V
#undef PG8_WAIT_L
#undef PG8_BAR
#undef PG8_SCHED
}
}

#define LAS __attribute__((address_space(3)))
typedef unsigned short bf16;
typedef float f32x4 __attribute__((ext_vector_type(4)));
typedef float f32x2 __attribute__((ext_vector_type(2)));
typedef float f32x16 __attribute__((ext_vector_type(16)));
typedef short bf16x8 __attribute__((ext_vector_type(8)));
typedef short s16x4 __attribute__((ext_vector_type(4)));
typedef unsigned u32x4 __attribute__((ext_vector_type(4)));
typedef unsigned u32x2 __attribute__((ext_vector_type(2)));

constexpr int DM = 1024, NB = 32, TS = 2048, SB = 8, ST = 16, PAST = 4096;
constexpr int NPG = 2;
constexpr int RG = NB * TS / NPG;
constexpr int GBATCH = NB / NPG;
constexpr int NGRP = NPG + 1;
constexpr int NIN = 5888;
constexpr float LOG2E = 1.4426950408889634f;
constexpr float EPSN = 1e-6f;
constexpr int NSPLIT = 4;
constexpr int CACHE_ROWS = SB * PAST;

constexpr size_t O_YP = 0, O_YS = 67108864, O_KDP = 67239936, O_VDP = 134348800, O_CKVP = 201457664, O_KRP = 218234880,
                 O_KDS = 220332032, O_VDS = 220463104, O_CKVS = 220594176, O_KRS = 220626944;
constexpr size_t MiB = 1u << 20;
constexpr size_t WS_TAB = 0;
constexpr size_t WS_ROPE = 8192;
constexpr size_t WS_WIN = 1 * MiB;
constexpr size_t WS_WUQ = WS_WIN + (size_t)NIN * 1024 * 2;
constexpr size_t WS_WUKV = WS_WUQ + 1536 * 256 * 2;
constexpr size_t WS_WOD = WS_WUKV + 2048 * 256 * 2;
constexpr size_t WS_WOM = WS_WOD + 2 * MiB;
constexpr size_t WS_WOUT = WS_WOM + 2 * MiB;
constexpr size_t WS_WUP = WS_WOUT + 2 * MiB;
constexpr size_t WS_WDN = WS_WUP + 8 * MiB;
constexpr size_t WS_WEND = WS_WDN + 8 * MiB;
constexpr size_t WS_SAMP = 37 * MiB;
constexpr size_t WS_PART = 44 * MiB;
constexpr size_t WS_PO_D = WS_PART, WS_PO_M = WS_PART + 8 * MiB, WS_PM = WS_PART + 12 * MiB, WS_PL = WS_PM + 131072;
constexpr size_t WS_PROMPT = 58 * MiB;
constexpr size_t GRP_BYTES_PER_ROW = 27712;
constexpr size_t WS_NEED = WS_PROMPT + (size_t)RG * GRP_BYTES_PER_ROW;
static_assert(WS_WEND <= WS_SAMP && WS_SAMP + 256 * GRP_BYTES_PER_ROW <= WS_PART && WS_PL + 131072 <= WS_PROMPT, "ws map");
constexpr size_t C_KDC = 0, C_VDC = 64 * MiB, C_KNC = 128 * MiB, C_VMC = 192 * MiB, C_CKVC = 256 * MiB, C_KRC = 272 * MiB;

struct Args { const float* in[26]; float* out; unsigned char* ws; int pad0, pad1; };

struct Grp {
    const float* x; float* y; float* okd; float* ovd; float* ockv; float* okr;
    int nvalid, ntiles, sample;
    bf16 *QD, *KD, *VD, *QN, *U, *XN, *QR, *KN, *VM, *GD, *GM, *DO, *MO, *CQ, *CKV, *KR; float* ZS;
};
__device__ __forceinline__ Grp make_grp(const Args& a, int g) {
    Grp G; unsigned char* base; size_t RC;
    if (g == 0) {
        G.x = a.in[1]; G.y = a.out + O_YS; G.okd = a.out + O_KDS; G.ovd = a.out + O_VDS; G.ockv = a.out + O_CKVS; G.okr = a.out + O_KRS;
        G.nvalid = SB * ST; G.ntiles = 1; G.sample = 1; base = a.ws + WS_SAMP; RC = 256;
    } else {
        const size_t r0 = (size_t)(g - 1) * RG;
        G.x = a.in[0] + r0 * 1024; G.y = a.out + O_YP + r0 * 1024; G.okd = a.out + O_KDP + r0 * 1024; G.ovd = a.out + O_VDP + r0 * 1024;
        G.ockv = a.out + O_CKVP + r0 * 256; G.okr = a.out + O_KRP + r0 * 32;
        G.nvalid = RG; G.ntiles = RG / 256; G.sample = 0; base = a.ws + WS_PROMPT; RC = RG;
    }
    G.QD = (bf16*)(base); G.KD = (bf16*)(base + RC * 2048); G.VD = (bf16*)(base + RC * 4096); G.QN = (bf16*)(base + RC * 6144); G.U = (bf16*)base;
    G.XN = (bf16*)(base + RC * 8192); G.QR = (bf16*)(base + RC * 10240); G.KN = (bf16*)(base + RC * 11264); G.VM = (bf16*)(base + RC * 13312);
    G.GD = (bf16*)(base + RC * 15360); G.GM = (bf16*)(base + RC * 17408); G.DO = (bf16*)(base + RC * 19456); G.MO = (bf16*)(base + RC * 21504);
    G.ZS = (float*)(base + RC * 23552); G.CQ = (bf16*)(base + RC * 26624); G.CKV = (bf16*)(base + RC * 27136); G.KR = (bf16*)(base + RC * 27648);
    return G;
}

template <int M> __device__ __forceinline__ float swz_xor(float v) { return __int_as_float(__builtin_amdgcn_ds_swizzle(__float_as_int(v), 0x1F | (M << 10))); }
__device__ __forceinline__ float half_sum32(float v) { v += swz_xor<1>(v); v += swz_xor<2>(v); v += swz_xor<4>(v); v += swz_xor<8>(v); v += swz_xor<16>(v); return v; }
__device__ __forceinline__ float wave_sum(float v) {
    v = half_sum32(v);
    auto rr = __builtin_amdgcn_permlane32_swap(__float_as_uint(v), __float_as_uint(v), false, false);
    return __uint_as_float(rr[0]) + __uint_as_float(rr[1]);
}
__device__ __forceinline__ unsigned f2bf(float f) { unsigned u = __builtin_bit_cast(unsigned, f); return (u + 0x7fffu + ((u >> 16) & 1u)) >> 16; }
__device__ __forceinline__ unsigned pk2(float lo, float hi) { return f2bf(lo) | (f2bf(hi) << 16); }
__device__ __forceinline__ float bflo(unsigned w) { return __builtin_bit_cast(float, w << 16); }
__device__ __forceinline__ float bfhi(unsigned w) { return __builtin_bit_cast(float, w & 0xffff0000u); }
__device__ __forceinline__ void st_bf4(bf16* p, f32x4 v) { u32x2 w; w.x = pk2(v[0], v[1]); w.y = pk2(v[2], v[3]); *(u32x2*)p = w; }
__device__ __forceinline__ f32x4 ld_bf4(const bf16* p) { const u32x2 w = *(const u32x2*)p; return (f32x4){bflo(w.x), bfhi(w.x), bflo(w.y), bfhi(w.y)}; }
__device__ __forceinline__ float sigm(float x) { return 1.f / (1.f + __expf(-x)); }

#define EPI_LOOP(BODY) \
    _Pragma("unroll") for (int ai = 0; ai < 2; ++ai) _Pragma("unroll") for (int m = 0; m < 4; ++m) { const int row = u.pm * 256 + ai * 128 + wr * 64 + m * 16 + fr; const size_t rw = (size_t)row; (void)rw; \
    _Pragma("unroll") for (int bj = 0; bj < 2; ++bj) _Pragma("unroll") for (int n = 0; n < 2; ++n) { const int cl = bj * 128 + wc * 32 + n * 16 + 4 * fq; const f32x4 v = acc[ai][bj][m][n]; BODY } }

typedef const f32x4 (&AccRef)[2][2][4][2];

struct EpiIn {
    static constexpr bool PERM = false, AFTER_DRAIN = false;
    bf16 *QD, *KD, *VD, *GD, *GM; float *ZS, *okd, *ovd; int nvalid; float qs;
    __device__ __forceinline__ void operator()(AccRef acc, const pg8::Unit& u, int wr, int wc, int fr, int fq) const {
        const int t = u.pn;
        if (t < 4) { const int c0 = t * 256; EPI_LOOP( st_bf4(QD + rw * 1024 + c0 + cl, v * qs); ) }
        else if (t < 8) { const int c0 = (t - 4) * 256; EPI_LOOP( st_bf4(KD + rw * 1024 + c0 + cl, v); if (row < nvalid) *(f32x4*)(okd + rw * 1024 + c0 + cl) = v; ) }
        else if (t < 12) { const int c0 = (t - 8) * 256; EPI_LOOP( st_bf4(VD + rw * 1024 + c0 + cl, v); if (row < nvalid) *(f32x4*)(ovd + rw * 1024 + c0 + cl) = v; ) }
        else if (t < 15) { const int c0 = (t - 12) * 256; EPI_LOOP( *(f32x4*)(ZS + rw * 768 + c0 + cl) = v; ) }
        else if (t < 19) { const int c0 = (t - 15) * 256; EPI_LOOP( st_bf4(GD + rw * 1024 + c0 + cl, ((f32x4){sigm(v[0]), sigm(v[1]), sigm(v[2]), sigm(v[3])})); ) }
        else { const int c0 = (t - 19) * 256; EPI_LOOP( st_bf4(GM + rw * 1024 + c0 + cl, ((f32x4){sigm(v[0]), sigm(v[1]), sigm(v[2]), sigm(v[3])})); ) }
    }
};
struct EpiQ {
    static constexpr bool PERM = false, AFTER_DRAIN = false;
    bf16 *QN, *QR; const float* rope; int sample; float qs;
    __device__ __forceinline__ void operator()(AccRef acc, const pg8::Unit& u, int wr, int wc, int fr, int fq) const {
        const int t = u.pn;
        if (t < 4) { const int c0 = t * 256; EPI_LOOP( st_bf4(QN + rw * 1024 + c0 + cl, v * qs); ) }
        else {
            const int c0 = (t - 4) * 256;
#pragma unroll
            for (int ai = 0; ai < 2; ++ai)
#pragma unroll
                for (int m = 0; m < 4; ++m) {
                    const int row = u.pm * 256 + ai * 128 + wr * 64 + m * 16 + fr;
                    const int pos = sample ? (PAST + (row & (ST - 1))) : (row & (TS - 1));
                    const f32x4 cs0 = *(const f32x4*)(rope + (size_t)pos * 32 + 8 * fq), cs1 = *(const f32x4*)(rope + (size_t)pos * 32 + 8 * fq + 4);
#pragma unroll
                    for (int bj = 0; bj < 2; ++bj) {
                        const f32x4 x1 = acc[ai][bj][m][0], x2 = acc[ai][bj][m][1];
                        f32x4 o1, o2;
                        o1[0] = x1[0] * cs0[0] - x2[0] * cs0[1]; o2[0] = x2[0] * cs0[0] + x1[0] * cs0[1];
                        o1[1] = x1[1] * cs0[2] - x2[1] * cs0[3]; o2[1] = x2[1] * cs0[2] + x1[1] * cs0[3];
                        o1[2] = x1[2] * cs1[0] - x2[2] * cs1[1]; o2[2] = x2[2] * cs1[0] + x1[2] * cs1[1];
                        o1[3] = x1[3] * cs1[2] - x2[3] * cs1[3]; o2[3] = x2[3] * cs1[2] + x1[3] * cs1[3];
                        bf16* p = QR + (size_t)row * 512 + c0 + bj * 128 + wc * 32 + 4 * fq;
                        st_bf4(p, o1 * qs); st_bf4(p + 16, o2 * qs);
                    }
                }
        }
    }
};
struct EpiKV {
    static constexpr bool PERM = false, AFTER_DRAIN = false;
    bf16 *KN, *VM;
    __device__ __forceinline__ void operator()(AccRef acc, const pg8::Unit& u, int wr, int wc, int fr, int fq) const {
        const int t = u.pn; bf16* O = t < 4 ? KN : VM; const int c0 = (t & 3) * 256;
        EPI_LOOP( st_bf4(O + rw * 1024 + c0 + cl, v); )
    }
};
struct EpiM1 {
    static constexpr bool PERM = false, AFTER_DRAIN = false;
    const bf16* Gt; bf16* MG;
    __device__ __forceinline__ void operator()(AccRef acc, const pg8::Unit& u, int wr, int wc, int fr, int fq) const {
        const int c0 = u.pn * 256;
        EPI_LOOP( const f32x4 g = ld_bf4(Gt + rw * 1024 + c0 + cl); st_bf4(MG + rw * 1024 + c0 + cl, g * v); )
    }
};
struct EpiM2 {
    static constexpr bool PERM = false, AFTER_DRAIN = false;
    const bf16* Gt; bf16* MG;
    __device__ __forceinline__ void operator()(AccRef acc, const pg8::Unit& u, int wr, int wc, int fr, int fq) const {
        const int c0 = u.pn * 256;
        EPI_LOOP( const f32x4 g = ld_bf4(Gt + rw * 1024 + c0 + cl); const f32x4 o = ld_bf4(MG + rw * 1024 + c0 + cl); st_bf4(MG + rw * 1024 + c0 + cl, o + g * v); )
    }
};
struct EpiOut {
    static constexpr bool PERM = false, AFTER_DRAIN = false;
    const float* x; float* y; int nvalid;
    __device__ __forceinline__ void operator()(AccRef acc, const pg8::Unit& u, int wr, int wc, int fr, int fq) const {
        const int c0 = u.pn * 256;
        EPI_LOOP( if (row < nvalid) { const f32x4 b = *(const f32x4*)(x + rw * 1024 + c0 + cl); *(f32x4*)(y + rw * 1024 + c0 + cl) = b + v; } )
    }
};
struct EpiUp {
    static constexpr bool PERM = false, AFTER_DRAIN = false;
    bf16* U;
    __device__ __forceinline__ void operator()(AccRef acc, const pg8::Unit& u, int wr, int wc, int fr, int fq) const {
        const int c0 = u.pn * 256;
        EPI_LOOP( f32x4 r; r[0] = fmaxf(v[0], 0.f); r[1] = fmaxf(v[1], 0.f); r[2] = fmaxf(v[2], 0.f); r[3] = fmaxf(v[3], 0.f); st_bf4(U + rw * 4096 + c0 + cl, r * r); )
    }
};
struct EpiDown {
    static constexpr bool PERM = false, AFTER_DRAIN = false;
    float* y; int nvalid;
    __device__ __forceinline__ void operator()(AccRef acc, const pg8::Unit& u, int wr, int wc, int fr, int fq) const {
        const int c0 = u.pn * 256;
        EPI_LOOP( if (row < nvalid) { float* p = y + rw * 1024 + c0 + cl; *(f32x4*)p = *(const f32x4*)p + v; } )
    }
};

template <class Epi>
__device__ __forceinline__ void run_gemm(LAS unsigned char* lds, const bf16* A, const bf16* Bt, int M, int N, int K, const Epi& E, const int tid_in) {
    pg8::Gemm g{A, Bt, M, N, K}; pg8::StaticOrder S; S.init(M, N, (int)gridDim.x, (int)blockIdx.x);
    pg8::gemm_phase<Epi, pg8::StaticOrder, true, true>(lds, g, S, E, tid_in);
}

__device__ __forceinline__ void rms_rows_bf16(const float* src, bf16* dst, const float* gain, int nvalid, int ntotal, int gw, int ngw, int lane) {
    for (int r = gw; r < ntotal; r += ngw) {
        u32x2* o8 = (u32x2*)(dst + (size_t)r * 1024) + lane;
        if (r >= nvalid) {
#pragma unroll
            for (int j = 0; j < 4; ++j) o8[64 * j] = (u32x2){0u, 0u};
            continue;
        }
        const f32x4* xr = (const f32x4*)(src + (size_t)r * 1024) + lane;
        f32x4 v[4]; float s = 0.f;
#pragma unroll
        for (int j = 0; j < 4; ++j) { v[j] = xr[64 * j]; s += (v[j][0] * v[j][0] + v[j][1] * v[j][1]) + (v[j][2] * v[j][2] + v[j][3] * v[j][3]); }
        const float rs = 1.0f / sqrtf(wave_sum(s) * (1.f / 1024.f) + EPSN);
#pragma unroll
        for (int j = 0; j < 4; ++j) { const f32x4 g = ((const f32x4*)gain)[lane + 64 * j]; const f32x4 o = v[j] * rs * g; o8[64 * j] = (u32x2){pk2(o[0], o[1]), pk2(o[2], o[3])}; }
    }
}
__device__ __forceinline__ void rms_rows_f32_inplace(float* y, const float* gain, int nvalid, int gw, int ngw, int lane) {
    for (int r = gw; r < nvalid; r += ngw) {
        f32x4* xr = (f32x4*)(y + (size_t)r * 1024) + lane;
        f32x4 v[4]; float s = 0.f;
#pragma unroll
        for (int j = 0; j < 4; ++j) { v[j] = xr[64 * j]; s += (v[j][0] * v[j][0] + v[j][1] * v[j][1]) + (v[j][2] * v[j][2] + v[j][3] * v[j][3]); }
        const float rs = 1.0f / sqrtf(wave_sum(s) * (1.f / 1024.f) + EPSN);
#pragma unroll
        for (int j = 0; j < 4; ++j) { const f32x4 g = ((const f32x4*)gain)[lane + 64 * j]; xr[64 * j] = v[j] * rs * g; }
    }
}
__device__ __forceinline__ void phase_small(const Grp& G, const float* gq, const float* gkv, const float* rope, int gw, int ngw, int lane) {
    const int ntotal = G.ntiles * 256;
    for (int r = gw; r < ntotal; r += ngw) {
        const float* z = G.ZS + (size_t)r * 768;
        const f32x4 cq = ((const f32x4*)z)[lane], ck = ((const f32x4*)(z + 256))[lane];
        const float s1 = wave_sum((cq[0] * cq[0] + cq[1] * cq[1]) + (cq[2] * cq[2] + cq[3] * cq[3]));
        const float s2 = wave_sum((ck[0] * ck[0] + ck[1] * ck[1]) + (ck[2] * ck[2] + ck[3] * ck[3]));
        const float r1 = 1.0f / sqrtf(s1 * (1.f / 256.f) + EPSN), r2 = 1.0f / sqrtf(s2 * (1.f / 256.f) + EPSN);
        const f32x4 o1 = cq * r1 * ((const f32x4*)gq)[lane], o2 = ck * r2 * ((const f32x4*)gkv)[lane];
        ((u32x2*)(G.CQ + (size_t)r * 256))[lane] = (u32x2){pk2(o1[0], o1[1]), pk2(o1[2], o1[3])};
        ((u32x2*)(G.CKV + (size_t)r * 256))[lane] = (u32x2){pk2(o2[0], o2[1]), pk2(o2[2], o2[3])};
        if (r < G.nvalid) ((f32x4*)(G.ockv + (size_t)r * 256))[lane] = o2;
        if (lane < 16) {
            const int pos = G.sample ? (PAST + (r & (ST - 1))) : (r & (TS - 1));
            const float x1 = z[512 + lane], x2 = z[512 + 16 + lane];
            const f32x2 cs = *(const f32x2*)(rope + (size_t)pos * 32 + 2 * lane);
            const float a = x1 * cs[0] - x2 * cs[1], b = x2 * cs[0] + x1 * cs[1];
            G.KR[(size_t)r * 32 + lane] = (bf16)f2bf(a); G.KR[(size_t)r * 32 + 16 + lane] = (bf16)f2bf(b);
            if (r < G.nvalid) { G.okr[(size_t)r * 32 + lane] = a; G.okr[(size_t)r * 32 + 16 + lane] = b; }
        }
    }
}

__device__ __forceinline__ void tr_item(const float* W, int K, int N, bf16* WT, int k0, int n0, int drow0, LAS float* scr, int lane) {
#pragma unroll 8
    for (int i = 0; i < 32; ++i) { const int kk = 2 * i + (lane >> 5); scr[kk * 33 + (lane & 31)] = W[(size_t)(k0 + kk) * N + n0 + (lane & 31)]; }
    asm volatile("s_waitcnt lgkmcnt(0)" ::: "memory");
    const int c = lane & 7;
#pragma unroll
    for (int j = 0; j < 4; ++j) { const int n = (lane >> 3) + 8 * j; const LAS float* s = scr + (8 * c) * 33 + n;
        u32x4 o; o.x = pk2(s[0 * 33], s[1 * 33]); o.y = pk2(s[2 * 33], s[3 * 33]); o.z = pk2(s[4 * 33], s[5 * 33]); o.w = pk2(s[6 * 33], s[7 * 33]);
        *(u32x4*)(WT + (size_t)(drow0 + n) * K + k0 + 8 * c) = o; }
    asm volatile("s_waitcnt lgkmcnt(0)" ::: "memory");
}
__device__ __forceinline__ int map_in(int n0) {
    if (n0 < 3616) return n0;
    if (n0 < 4640) return n0 - 3616 + 3840;
    return n0 - 4640 + 4864;
}
__device__ __forceinline__ int map_uq(int n0) { const int hh = n0 / 96, d0 = n0 % 96; return d0 < 64 ? hh * 64 + d0 : 1024 + hh * 32 + (d0 - 64); }
__device__ __forceinline__ void cvt8(const float* src, bf16* dst, size_t n8, size_t gt, size_t ngt) {
    for (size_t i = gt; i < n8; i += ngt) { const f32x4 a = ((const f32x4*)src)[2 * i], b = ((const f32x4*)src)[2 * i + 1];
        ((u32x4*)dst)[i] = (u32x4){pk2(a[0], a[1]), pk2(a[2], a[3]), pk2(b[0], b[1]), pk2(b[2], b[3])}; }
}
__device__ __forceinline__ void phase_prologue(const Args& a, LAS unsigned char* lds, int gw, int ngw, int lane, int wave) {
    unsigned char* ws = a.ws;
    LAS float* scr = (LAS float*)(lds + wave * 16384);
    constexpr int I_IN = 16 * 177, I_UQ = 4 * 48, I_UK = 4 * 32, I_UV = 4 * 32, I_O = 16 * 32, I_UP = 16 * 128, I_DN = 64 * 32;
    constexpr int NITEMS = I_IN + I_UQ + I_UK + I_UV + 3 * I_O + I_UP + I_DN;
    for (int it = gw; it < NITEMS; it += ngw) {
        int r = it;
        if (r < I_IN) { const int kb = r / 177, nb = r % 177; tr_item(a.in[8], 1024, 5664, (bf16*)(ws + WS_WIN), 64 * kb, 32 * nb, map_in(32 * nb), scr, lane); continue; } r -= I_IN;
        if (r < I_UQ) { const int kb = r / 48, nb = r % 48; tr_item(a.in[15], 256, 1536, (bf16*)(ws + WS_WUQ), 64 * kb, 32 * nb, map_uq(32 * nb), scr, lane); continue; } r -= I_UQ;
        if (r < I_UK) { const int kb = r / 32, nb = r % 32; tr_item(a.in[17], 256, 1024, (bf16*)(ws + WS_WUKV), 64 * kb, 32 * nb, 32 * nb, scr, lane); continue; } r -= I_UK;
        if (r < I_UV) { const int kb = r / 32, nb = r % 32; tr_item(a.in[18], 256, 1024, (bf16*)(ws + WS_WUKV), 64 * kb, 32 * nb, 1024 + 32 * nb, scr, lane); continue; } r -= I_UV;
        if (r < I_O) { const int kb = r / 32, nb = r % 32; tr_item(a.in[19], 1024, 1024, (bf16*)(ws + WS_WOD), 64 * kb, 32 * nb, 32 * nb, scr, lane); continue; } r -= I_O;
        if (r < I_O) { const int kb = r / 32, nb = r % 32; tr_item(a.in[20], 1024, 1024, (bf16*)(ws + WS_WOM), 64 * kb, 32 * nb, 32 * nb, scr, lane); continue; } r -= I_O;
        if (r < I_O) { const int kb = r / 32, nb = r % 32; tr_item(a.in[21], 1024, 1024, (bf16*)(ws + WS_WOUT), 64 * kb, 32 * nb, 32 * nb, scr, lane); continue; } r -= I_O;
        if (r < I_UP) { const int kb = r / 128, nb = r % 128; tr_item(a.in[23], 1024, 4096, (bf16*)(ws + WS_WUP), 64 * kb, 32 * nb, 32 * nb, scr, lane); continue; } r -= I_UP;
        { const int kb = r / 32, nb = r % 32; tr_item(a.in[24], 4096, 1024, (bf16*)(ws + WS_WDN), 64 * kb, 32 * nb, 32 * nb, scr, lane); }
    }
    const size_t gt = (size_t)gw * 64 + lane, ngt = (size_t)ngw * 64;
    { u32x4* z = (u32x4*)(ws + WS_WIN + (size_t)3616 * 2048); for (size_t i = gt; i < (size_t)224 * 128; i += ngt) z[i] = (u32x4){0u, 0u, 0u, 0u}; }
    unsigned char* cb = ws + WS_PROMPT;
    cvt8(a.in[2], (bf16*)(cb + C_KDC), (size_t)CACHE_ROWS * 128, gt, ngt);
    cvt8(a.in[3], (bf16*)(cb + C_VDC), (size_t)CACHE_ROWS * 128, gt, ngt);
    cvt8(a.in[4], (bf16*)(cb + C_CKVC), (size_t)CACHE_ROWS * 32, gt, ngt);
    cvt8(a.in[5], (bf16*)(cb + C_KRC), (size_t)CACHE_ROWS * 4, gt, ngt);
    float* tab = (float*)(ws + WS_TAB);
    for (size_t i = gt; i < 8 * 192; i += ngt) {
        const int h = (int)i / 192, idx = (int)i % 192, rel = idx - 128, n = rel < 0 ? -rel : rel;
        int bucket = n;
        if (n >= 8) { int j = (31 - __clz(n * n)) - 6; bucket = 8 + j; if (bucket > 15) bucket = 15; }
        if (rel > 0) bucket += 16;
        tab[i] = (a.in[6][bucket * 8 + h] - a.in[6][15 * 8 + h]) * LOG2E;
    }
    if (gt == 0) {
        float d1 = 0.f, d2 = 0.f;
        for (int i = 0; i < 64; ++i) { d1 += a.in[9][i] * a.in[10][i]; d2 += a.in[11][i] * a.in[12][i]; }
        tab[1536] = expf(d1) - expf(d2) + 0.2f;
    }
    float* rope = (float*)(ws + WS_ROPE);
    for (size_t i = gt; i < (size_t)(PAST + ST) * 16; i += ngt) {
        const int pos = (int)(i >> 4), k = (int)(i & 15);
        const float inv = __builtin_amdgcn_exp2f(-(float)k * 0.8304820237218406f);
        const float ang = (float)pos * inv;
        const double rev = (double)ang * 0.15915494309189535;
        const float fr = (float)(rev - __builtin_rint(rev));
        rope[2 * i] = __builtin_amdgcn_cosf(fr); rope[2 * i + 1] = __builtin_amdgcn_sinf(fr);
    }
}

#ifndef ATTMASK
#define ATTMASK 15
#endif
constexpr int AL_TAB = 0, AL_WSF = 6144, AL_TILE = 8192;

__device__ __forceinline__ int crow(int r, int hi) { return (r & 3) + 8 * (r >> 2) + 4 * hi; }
__device__ __forceinline__ float xmax32(float v) { auto rr = __builtin_amdgcn_permlane32_swap(__float_as_uint(v), __float_as_uint(v), false, false); return fmaxf(__uint_as_float(rr[0]), __uint_as_float(rr[1])); }
__device__ __forceinline__ float xsum32(float v) { auto rr = __builtin_amdgcn_permlane32_swap(__float_as_uint(v), __float_as_uint(v), false, false); return __uint_as_float(rr[0]) + __uint_as_float(rr[1]); }
typedef __bf16 bf16x2_t __attribute__((ext_vector_type(2)));
__device__ __forceinline__ unsigned cvtpk(float lo, float hi) { f32x2 v = {lo, hi}; bf16x2_t b = __builtin_convertvector(v, bf16x2_t); return __builtin_bit_cast(unsigned, b); }
__device__ __forceinline__ bf16x8 pack8(float a0, float a1, float a2, float a3, float a4, float a5, float a6, float a7) {
    u32x4 w = {cvtpk(a0, a1), cvtpk(a2, a3), cvtpk(a4, a5), cvtpk(a6, a7)}; return __builtin_bit_cast(bf16x8, w);
}
typedef short v4i16_t __attribute__((ext_vector_type(4)));
__device__ __forceinline__ s16x4 vtr(const LAS unsigned char* p) { return __builtin_bit_cast(s16x4, __builtin_amdgcn_ds_read_tr16_b64_v4i16((LAS v4i16_t*)p)); }

template <int DQK, int DV> struct AttnState { bf16x8 qf[DQK / 16]; f32x16 o[DV / 32]; f32x16 negm; float m, l; };
constexpr float ATT_THR = 8.0f;

template <int DQK, int DV, bool HAS_BIAS>
__device__ __forceinline__ void attn_tile(AttnState<DQK, DV>& st, const LAS unsigned char* Kt, const LAS unsigned char* Vt, int bias_mode, const LAS float* tab, int rel0, int nkeys, bool first, LAS float* wsf, int lane) {
    constexpr int PK = DQK * 2 + 16, PV = DV * 2 + 64, KS = DQK / 16, NDB = DV / 32;
    const int q = lane & 31, hi = lane >> 5;
    f32x16 p0, p1;
    const LAS unsigned char* kp = Kt + q * PK + hi * 16;
    bf16x8 ka[KS], kb[KS];
#pragma unroll
    for (int ks = 0; ks < KS; ++ks) { ka[ks] = *(const LAS bf16x8*)(kp + ks * 32); kb[ks] = *(const LAS bf16x8*)(kp + 32 * PK + ks * 32); }
    if (HAS_BIAS && bias_mode == 2) {
        asm volatile("" ::: "memory");
#pragma unroll
        for (int r = 0; r < 16; ++r) {
            const int k = crow(r, hi);
            const int i0 = min(max(rel0 + k + 128, 0), 191), i1 = min(max(rel0 + k + 160, 0), 191);
            p0[r] = tab[i0] + st.negm[r]; p1[r] = tab[i1] + st.negm[r];
        }
        p0 = __builtin_amdgcn_mfma_f32_32x32x16_bf16(ka[0], st.qf[0], p0, 0, 0, 0);
        p1 = __builtin_amdgcn_mfma_f32_32x32x16_bf16(kb[0], st.qf[0], p1, 0, 0, 0);
    } else {
        p0 = __builtin_amdgcn_mfma_f32_32x32x16_bf16(ka[0], st.qf[0], st.negm, 0, 0, 0);
        p1 = __builtin_amdgcn_mfma_f32_32x32x16_bf16(kb[0], st.qf[0], st.negm, 0, 0, 0);
    }
#pragma unroll
    for (int ks = 1; ks < KS; ++ks) {
        p0 = __builtin_amdgcn_mfma_f32_32x32x16_bf16(ka[ks], st.qf[ks], p0, 0, 0, 0);
        p1 = __builtin_amdgcn_mfma_f32_32x32x16_bf16(kb[ks], st.qf[ks], p1, 0, 0, 0);
    }
    const int q4 = (lane & 15) >> 2, blk = (lane >> 4) & 1, pp = lane & 3;
    const LAS unsigned char* vp = Vt + (4 * hi + q4) * PV + (16 * blk + 4 * pp) * 2;
    s16x4 vlo[2][4], vhi[2][4];
#pragma unroll
    for (int s4 = 0; s4 < 4; ++s4) { vlo[0][s4] = vtr(vp + (16 * s4) * PV); vhi[0][s4] = vtr(vp + (16 * s4 + 8) * PV); }
    __builtin_amdgcn_sched_barrier(0);
    if (nkeys < 64) {
#pragma unroll
        for (int r = 0; r < 16; ++r) { const int k = crow(r, hi); if (k >= nkeys) p0[r] = -1e30f; if (k + 32 >= nkeys) p1[r] = -1e30f; }
    }
    float mxa = __builtin_fmaxf(__builtin_fmaxf(p0[0], p0[1]), p1[0]), mxb = __builtin_fmaxf(__builtin_fmaxf(p0[2], p0[3]), p1[1]);
    mxa = __builtin_fmaxf(__builtin_fmaxf(mxa, p1[2]), p1[3]);
#pragma unroll
    for (int r = 4; r < 16; r += 4) {
        mxa = __builtin_fmaxf(__builtin_fmaxf(mxa, p0[r]), p0[r + 1]); mxb = __builtin_fmaxf(__builtin_fmaxf(mxb, p0[r + 2]), p0[r + 3]);
        mxa = __builtin_fmaxf(__builtin_fmaxf(mxa, p1[r]), p1[r + 1]); mxb = __builtin_fmaxf(__builtin_fmaxf(mxb, p1[r + 2]), p1[r + 3]);
    }
    const float mx = xmax32(__builtin_fmaxf(mxa, mxb));
    if (first || __any(mx > ATT_THR)) {
        const float dl = first ? mx : __builtin_fmaxf(mx, 0.f);
        st.m += dl;
#pragma unroll
        for (int r = 0; r < 16; ++r) { st.negm[r] = -st.m; p0[r] -= dl; p1[r] -= dl; }
        const float f = __builtin_amdgcn_exp2f(-dl);
        st.l *= f;
        if (hi == 0) wsf[q] = f;
#pragma unroll
        for (int r = 0; r < 16; ++r) { const float fr = wsf[crow(r, hi)];
#pragma unroll
            for (int db = 0; db < NDB; ++db) st.o[db][r] *= fr; }
    }
    float sum0 = 0.f, sum1 = 0.f;
#pragma unroll
    for (int r = 0; r < 16; ++r) { p0[r] = __builtin_amdgcn_exp2f(p0[r]); p1[r] = __builtin_amdgcn_exp2f(p1[r]); sum0 += p0[r]; sum1 += p1[r]; }
    st.l += sum0 + sum1;
    bf16x8 pf[4];
    pf[0] = pack8(p0[0], p0[1], p0[2], p0[3], p0[4], p0[5], p0[6], p0[7]);
    pf[1] = pack8(p0[8], p0[9], p0[10], p0[11], p0[12], p0[13], p0[14], p0[15]);
    pf[2] = pack8(p1[0], p1[1], p1[2], p1[3], p1[4], p1[5], p1[6], p1[7]);
    pf[3] = pack8(p1[8], p1[9], p1[10], p1[11], p1[12], p1[13], p1[14], p1[15]);
    __builtin_amdgcn_sched_barrier(0);
#pragma unroll
    for (int db = 0; db < NDB; ++db) {
        if (db + 1 < NDB) {
#pragma unroll
            for (int s4 = 0; s4 < 4; ++s4) { vlo[(db + 1) & 1][s4] = vtr(vp + (16 * s4) * PV + (db + 1) * 64); vhi[(db + 1) & 1][s4] = vtr(vp + (16 * s4 + 8) * PV + (db + 1) * 64); }
        }
#pragma unroll
        for (int s4 = 0; s4 < 4; ++s4) {
            const s16x4 lo = vlo[db & 1][s4], h4 = vhi[db & 1][s4];
            const bf16x8 vb = {lo[0], lo[1], lo[2], lo[3], h4[0], h4[1], h4[2], h4[3]};
            st.o[db] = __builtin_amdgcn_mfma_f32_32x32x16_bf16(pf[s4], vb, st.o[db], 0, 0, 0);
        }
        __builtin_amdgcn_sched_barrier(0);
    }
}

template <int DQK, int DV>
__device__ __forceinline__ void attn_init(AttnState<DQK, DV>& st) {
    st.m = 0.f; st.l = 0.f;
#pragma unroll
    for (int r = 0; r < 16; ++r) st.negm[r] = 0.f;
#pragma unroll
    for (int db = 0; db < DV / 32; ++db)
#pragma unroll
        for (int r = 0; r < 16; ++r) st.o[db][r] = 0.f;
}

template <bool DIFF>
__device__ __forceinline__ void attn_unit_coop(const Grp& G, int b, int h, int qb, int n, LAS unsigned char* lds, const int tid_in) {
    constexpr int DQK = DIFF ? 64 : 96, DV = DIFF ? 128 : 64, PK = DQK * 2 + 16, PV = DV * 2 + 64, KB = 64 * PK, VB = 64 * PV, TB = KB + VB, NDB = DV / 32;
    int tid_ = tid_in; asm volatile("" : "+v"(tid_));
    const int tid = tid_, lane = tid & 63, wid = __builtin_amdgcn_readfirstlane(tid >> 6), q = lane & 31, hi = lane >> 5;
    const size_t seq0 = (size_t)b * TS;
    const int qrow0 = qb * 256 + wid * 32;
    const int NT = 4 * qb + 4, my_nt = 4 * qb + (wid >> 1) + 1;
    const LAS float* tab = (const LAS float*)(lds + AL_TAB) + h * 192;
    LAS float* wsf = (LAS float*)(lds + AL_WSF) + wid * 64;
    LAS unsigned char* tiles = lds + AL_TILE;
    {
        AttnState<DQK, DV> st; attn_init(st);
        if (DIFF) { const bf16* qp = G.QD + (seq0 + qrow0 + q) * 1024 + h * 128 + n * 64 + hi * 8;
#pragma unroll
            for (int ks = 0; ks < 4; ++ks) st.qf[ks] = *(const bf16x8*)(qp + ks * 16);
        } else { const bf16* qn = G.QN + (seq0 + qrow0 + q) * 1024 + h * 64 + hi * 8; const bf16* qr = G.QR + (seq0 + qrow0 + q) * 512 + h * 32 + hi * 8;
#pragma unroll
            for (int ks = 0; ks < 4; ++ks) st.qf[ks] = *(const bf16x8*)(qn + ks * 16);
#pragma unroll
            for (int ks = 0; ks < 2; ++ks) st.qf[4 + ks] = *(const bf16x8*)(qr + ks * 16);
        }
        const bf16* ksrc = (DIFF ? G.KD + h * 128 + n * 64 : G.KN + h * 64) + (seq0 + (tid >> 3)) * 1024 + (tid & 7) * 8;
        const int kdst = (tid >> 3) * PK + (tid & 7) * 16;
        const bf16* k2src = G.KR + (seq0 + ((tid & 255) >> 2)) * 32 + (tid & 3) * 8;
        const int k2dst = ((tid & 255) >> 2) * PK + 128 + (tid & 3) * 16;
        const bf16* vsrc = DIFF ? G.VD + (seq0 + (tid >> 4)) * 1024 + h * 128 + (tid & 15) * 8 : G.VM + (seq0 + (tid >> 3)) * 1024 + h * 64 + (tid & 7) * 8;
        const int vdst = DIFF ? KB + (tid >> 4) * PV + (tid & 15) * 16 : KB + (tid >> 3) * PV + (tid & 7) * 16;
        u32x4 rkA, rk2A = {0u, 0u, 0u, 0u}, rv0A, rv1A = {0u, 0u, 0u, 0u}, rkB = {0u, 0u, 0u, 0u}, rk2B = {0u, 0u, 0u, 0u}, rv0B = {0u, 0u, 0u, 0u}, rv1B = {0u, 0u, 0u, 0u};
#define ATT_LOAD(S, j) do { rk##S = *(const u32x4*)(ksrc + (size_t)(j) * 64 * 1024); if (!DIFF && tid < 256) rk2##S = *(const u32x4*)(k2src + (size_t)(j) * 64 * 32); \
        rv0##S = *(const u32x4*)(vsrc + (size_t)(j) * 64 * 1024); if (DIFF) rv1##S = *(const u32x4*)(vsrc + (size_t)(j) * 64 * 1024 + 32 * 1024); } while (0)
#define ATT_STORE(S, bufp) do { *(LAS u32x4*)((bufp) + kdst) = rk##S; if (!DIFF && tid < 256) *(LAS u32x4*)((bufp) + k2dst) = rk2##S; \
        *(LAS u32x4*)((bufp) + vdst) = rv0##S; if (DIFF) *(LAS u32x4*)((bufp) + vdst + 32 * PV) = rv1##S; } while (0)
#define ATT_COMPUTE(j, bufp) do { if ((j) < my_nt) { const int kb_ = 64 * (j); const int mode_ = DIFF ? ((kb_ + 63 - qrow0 <= -128) ? 1 : 2) : 0; \
        attn_tile<DQK, DV, DIFF>(st, (bufp), (bufp) + KB, mode_, tab, kb_ - (qrow0 + q), 64, (j) == 0, wsf, lane); } } while (0)
        ATT_LOAD(A, 0); ATT_STORE(A, tiles);
        __syncthreads();
        ATT_LOAD(A, 1);
        for (int j = 0; j < NT; j += 2) {
            LAS unsigned char* b0 = tiles + (j & 1) * TB; LAS unsigned char* b1 = tiles + ((j + 1) & 1) * TB;
            if (j + 2 < NT) ATT_LOAD(B, j + 2);
            ATT_COMPUTE(j, b0);
            ATT_STORE(A, b1);
            __syncthreads();
            if (j + 3 < NT) ATT_LOAD(A, j + 3);
            ATT_COMPUTE(j + 1, b1);
            if (j + 2 < NT) ATT_STORE(B, b0);
            __syncthreads();
        }
#undef ATT_LOAD
#undef ATT_STORE
#undef ATT_COMPUTE
        const float lt = xsum32(st.l);
        if (hi == 0) wsf[32 + q] = lt;
        float inv[16];
#pragma unroll
        for (int r = 0; r < 16; ++r) inv[r] = 1.0f / wsf[32 + crow(r, hi)];
        bf16* obase = (DIFF ? (n == 0 ? G.DO : G.XN) + h * 128 : G.MO + h * 64) + (seq0 + qrow0) * 1024 + q;
#pragma unroll
        for (int db = 0; db < NDB; ++db)
#pragma unroll
            for (int r = 0; r < 16; ++r) obase[(size_t)crow(r, hi) * 1024 + db * 32] = (bf16)f2bf(st.o[db][r] * inv[r]);
    }
}

__device__ __forceinline__ void phase_diffmix(const Grp& G, float lam, const float* subln, int gw, int ngw, int lane) {
    const int c = (lane & 7) * 16;
    float g[16];
#pragma unroll
    for (int i = 0; i < 16; ++i) g[i] = subln[c + i] * 0.8f;
    for (int r = gw; r < G.nvalid; r += ngw) {
        bf16* p1 = G.DO + (size_t)r * 1024 + lane * 16; const bf16* p2 = G.XN + (size_t)r * 1024 + lane * 16;
        const u32x4 a0 = ((const u32x4*)p1)[0], a1 = ((const u32x4*)p1)[1], b0 = ((const u32x4*)p2)[0], b1 = ((const u32x4*)p2)[1];
        float v[16];
#pragma unroll
        for (int i = 0; i < 4; ++i) { v[2 * i] = bflo(a0[i]) - lam * bflo(b0[i]); v[2 * i + 1] = bfhi(a0[i]) - lam * bfhi(b0[i]);
                                      v[8 + 2 * i] = bflo(a1[i]) - lam * bflo(b1[i]); v[8 + 2 * i + 1] = bfhi(a1[i]) - lam * bfhi(b1[i]); }
        float s = 0.f;
#pragma unroll
        for (int i = 0; i < 16; ++i) s += v[i] * v[i];
        s += swz_xor<1>(s); s += swz_xor<2>(s); s += swz_xor<4>(s);
        const float rs = 1.0f / sqrtf(s * (1.f / 128.f) + EPSN);
        u32x4 o0, o1;
#pragma unroll
        for (int i = 0; i < 4; ++i) { o0[i] = pk2(v[2 * i] * rs * g[2 * i], v[2 * i + 1] * rs * g[2 * i + 1]); o1[i] = pk2(v[8 + 2 * i] * rs * g[8 + 2 * i], v[8 + 2 * i + 1] * rs * g[8 + 2 * i + 1]); }
        ((u32x4*)p1)[0] = o0; ((u32x4*)p1)[1] = o1;
    }
}

template <bool DIFF>
__device__ __forceinline__ void attn_unit_wave(const Grp& G, const unsigned char* cb, int b, int h, int n, int j0, int j1, int wu, float* PO, float* PM, float* PL,
                                               LAS unsigned char* wt, LAS float* wsf, const LAS float* tab0, int lane_in) {
    int lane = lane_in; asm volatile("" : "+v"(lane)); lane &= 63;
    constexpr int DQK = DIFF ? 64 : 96, DV = DIFF ? 128 : 64, PK = DQK * 2 + 16, PV = DV * 2 + 64, KB = 64 * PK, NDB = DV / 32;
    const int q = lane & 31, hi = lane >> 5;
    const LAS float* tab = tab0 + h * 192;
    AttnState<DQK, DV> st; attn_init(st);
    const size_t qrow = (size_t)b * ST + q;
    if (DIFF) { const bf16* qp = G.QD + qrow * 1024 + h * 128 + n * 64 + hi * 8;
#pragma unroll
        for (int ks = 0; ks < 4; ++ks) st.qf[ks] = *(const bf16x8*)(qp + ks * 16);
    } else { const bf16* qn = G.QN + qrow * 1024 + h * 64 + hi * 8; const bf16* qr = G.QR + qrow * 512 + h * 32 + hi * 8;
#pragma unroll
        for (int ks = 0; ks < 4; ++ks) st.qf[ks] = *(const bf16x8*)(qn + ks * 16);
#pragma unroll
        for (int ks = 0; ks < 2; ++ks) st.qf[4 + ks] = *(const bf16x8*)(qr + ks * 16);
    }
    for (int j = j0; j < j1; ++j) {
        const bf16 *kA, *kB2, *vA; int nkeys;
        if (j < 64) { const size_t r0 = (size_t)b * PAST + 64 * j; nkeys = 64;
            kA = DIFF ? (const bf16*)(cb + C_KDC) + r0 * 1024 + h * 128 + n * 64 : (const bf16*)(cb + C_KNC) + r0 * 1024 + h * 64;
            kB2 = (const bf16*)(cb + C_KRC) + r0 * 32;
            vA = DIFF ? (const bf16*)(cb + C_VDC) + r0 * 1024 + h * 128 : (const bf16*)(cb + C_VMC) + r0 * 1024 + h * 64;
        } else { const size_t r0 = (size_t)b * ST; nkeys = ST;
            kA = DIFF ? G.KD + r0 * 1024 + h * 128 + n * 64 : G.KN + r0 * 1024 + h * 64;
            kB2 = G.KR + r0 * 32;
            vA = DIFF ? G.VD + r0 * 1024 + h * 128 : G.VM + r0 * 1024 + h * 64;
        }
        { u32x4 t[8];
#pragma unroll
            for (int i = 0; i < 8; ++i) { const int idx = lane + 64 * i; t[i] = *(const u32x4*)(kA + (size_t)(idx >> 3) * 1024 + (idx & 7) * 8); }
#pragma unroll
            for (int i = 0; i < 8; ++i) { const int idx = lane + 64 * i; *(LAS u32x4*)(wt + (idx >> 3) * PK + (idx & 7) * 16) = t[i]; } }
        if (!DIFF) { u32x4 t[4];
#pragma unroll
            for (int i = 0; i < 4; ++i) { const int idx = lane + 64 * i; t[i] = *(const u32x4*)(kB2 + (size_t)(idx >> 2) * 32 + (idx & 3) * 8); }
#pragma unroll
            for (int i = 0; i < 4; ++i) { const int idx = lane + 64 * i; *(LAS u32x4*)(wt + (idx >> 2) * PK + 128 + (idx & 3) * 16) = t[i]; } }
        if (DIFF) {
#pragma unroll
            for (int hf = 0; hf < 2; ++hf) { u32x4 t[8];
#pragma unroll
                for (int i = 0; i < 8; ++i) { const int idx = lane + 64 * i + 512 * hf; t[i] = *(const u32x4*)(vA + (size_t)(idx >> 4) * 1024 + (idx & 15) * 8); }
#pragma unroll
                for (int i = 0; i < 8; ++i) { const int idx = lane + 64 * i + 512 * hf; *(LAS u32x4*)(wt + KB + (idx >> 4) * PV + (idx & 15) * 16) = t[i]; } }
        } else { u32x4 t[8];
#pragma unroll
            for (int i = 0; i < 8; ++i) { const int idx = lane + 64 * i; t[i] = *(const u32x4*)(vA + (size_t)(idx >> 3) * 1024 + (idx & 7) * 8); }
#pragma unroll
            for (int i = 0; i < 8; ++i) { const int idx = lane + 64 * i; *(LAS u32x4*)(wt + KB + (idx >> 3) * PV + (idx & 7) * 16) = t[i]; } }
        const int kb = 64 * j;
        const int mode = DIFF ? ((j <= 61) ? 1 : 2) : 0;
        attn_tile<DQK, DV, DIFF>(st, wt, wt + KB, mode, tab, kb - (PAST + q), nkeys, j == j0, wsf, lane);
    }
    const float lt = xsum32(st.l);
    if (hi == 0) { PM[wu * 32 + q] = st.m; PL[wu * 32 + q] = lt; }
#pragma unroll
    for (int db = 0; db < NDB; ++db)
#pragma unroll
        for (int r = 0; r < 16; ++r) PO[((size_t)wu * 32 + crow(r, hi)) * DV + db * 32 + q] = st.o[db][r];
}

__device__ __forceinline__ void phase_combine(const Grp& G, const float* POd, const float* POm, const float* PM, const float* PL, float lam, const float* subln, int gw, int ngw, int lane) {
    for (int it = gw; it < SB * 8 * ST + SB * 16 * ST; it += ngw) {
        if (it < SB * 8 * ST) {
            const int qq = it & 15, h = (it >> 4) & 7, b = it >> 7;
            float val[2] = {0.f, 0.f};
#pragma unroll
            for (int n = 0; n < 2; ++n) {
                const int wu0 = ((b * 8 + h) * 2 + n) * NSPLIT;
                float M = -1e30f;
#pragma unroll
                for (int s = 0; s < NSPLIT; ++s) M = fmaxf(M, PM[(wu0 + s) * 32 + qq]);
                float L = 0.f, a0 = 0.f, a1 = 0.f;
#pragma unroll
                for (int s = 0; s < NSPLIT; ++s) { const float w = __builtin_amdgcn_exp2f(PM[(wu0 + s) * 32 + qq] - M); L += PL[(wu0 + s) * 32 + qq] * w;
                    const float* po = POd + ((size_t)(wu0 + s) * 32 + qq) * 128; a0 += po[lane] * w; a1 += po[lane + 64] * w; }
                const float sc = (n == 0 ? 1.f : -lam) / L;
                val[0] += a0 * sc; val[1] += a1 * sc;
            }
            const float ss = wave_sum(val[0] * val[0] + val[1] * val[1]);
            const float rs = 0.8f / sqrtf(ss * (1.f / 128.f) + EPSN);
            bf16* o = G.DO + (size_t)(b * ST + qq) * 1024 + h * 128;
            o[lane] = (bf16)f2bf(val[0] * rs * subln[lane]); o[lane + 64] = (bf16)f2bf(val[1] * rs * subln[lane + 64]);
        } else {
            const int i2 = it - SB * 8 * ST; const int qq = i2 & 15, h = (i2 >> 4) & 15, b = i2 >> 8;
            const int wu0 = 512 + (b * 16 + h) * NSPLIT;
            float M = -1e30f;
#pragma unroll
            for (int s = 0; s < NSPLIT; ++s) M = fmaxf(M, PM[(wu0 + s) * 32 + qq]);
            float L = 0.f, a0 = 0.f;
#pragma unroll
            for (int s = 0; s < NSPLIT; ++s) { const float w = __builtin_amdgcn_exp2f(PM[(wu0 + s) * 32 + qq] - M); L += PL[(wu0 + s) * 32 + qq] * w;
                a0 += POm[((size_t)(wu0 - 512 + s) * 32 + qq) * 64 + lane] * w; }
            G.MO[(size_t)(b * ST + qq) * 1024 + h * 64 + lane] = (bf16)f2bf(a0 / L);
        }
    }
}

__device__ __forceinline__ void phase_attention(const Args& a, const Grp& G, LAS unsigned char* lds, const int tid_in) {
    int tid_ = tid_in; asm volatile("" : "+v"(tid_));
    const int tid = tid_, lane = tid & 63, wid = __builtin_amdgcn_readfirstlane(tid >> 6);
    const float* tabg = (const float*)(a.ws + WS_TAB);
    for (int i = tid; i < 8 * 192; i += 512) ((LAS float*)(lds + AL_TAB))[i] = tabg[i];
    const float lam = tabg[1536];
    const float* subln = a.in[13];
    __syncthreads();
    if (G.sample) {
        if (wid < 4) {
            constexpr int TBD = 64 * (64 * 2 + 16) + 64 * (128 * 2 + 64);
            LAS unsigned char* wt = lds + AL_TILE + wid * TBD;
            LAS float* wsf = (LAS float*)(lds + AL_WSF) + wid * 64;
            const LAS float* tab0 = (const LAS float*)(lds + AL_TAB);
            const unsigned char* cb = a.ws + WS_PROMPT;
            for (int wu = (int)blockIdx.x * 4 + wid; wu < 1024; wu += (int)gridDim.x * 4) {
                const int s = wu & 3; const int j0 = s == 0 ? 0 : 17 + 16 * (s - 1), j1 = 17 + 16 * s;
                if (wu < 512) {
#if ATTMASK & 1
 const int n = (wu >> 2) & 1, h = (wu >> 3) & 7, b = wu >> 6;
                    attn_unit_wave<true>(G, cb, b, h, n, j0, j1, wu, (float*)(a.ws + WS_PO_D), (float*)(a.ws + WS_PM), (float*)(a.ws + WS_PL), wt, wsf, tab0, tid);
#endif
                } else {
#if ATTMASK & 2
 const int i2 = wu - 512; const int h = (i2 >> 2) & 15, b = i2 >> 6;
                    attn_unit_wave<false>(G, cb, b, h, 0, j0, j1, wu, (float*)(a.ws + WS_PO_M) - (size_t)512 * 32 * 64, (float*)(a.ws + WS_PM), (float*)(a.ws + WS_PL), wt, wsf, tab0, tid);
#endif
                }
            }
        }
    } else {
        const int Gn = (int)gridDim.x, bx = (int)blockIdx.x;
        const int vcu = (Gn % 8 == 0) ? (bx % 8) * (Gn / 8) + bx / 8 : bx;
        for (int v = vcu; v < 256; v += Gn) {
            const int p = v & 3;
#if ATTMASK & 4
            for (int r = 0; r < GBATCH * 8 / 64; ++r) { const int bh = r * 64 + (v >> 2), b = bh >> 3, h = bh & 7;
                for (int n = 0; n < 2; ++n)
                    for (int i = 0; i < 2; ++i) attn_unit_coop<true>(G, b, h, i ? p : 7 - p, n, lds, tid_in); }
#endif
#if ATTMASK & 8
            for (int r = 0; r < GBATCH * 16 / 64; ++r) { const int bh = r * 64 + (v >> 2), b = bh >> 4, h = bh & 15;
                for (int i = 0; i < 2; ++i) attn_unit_coop<false>(G, b, h, i ? p : 7 - p, 0, lds, tid_in); }
#endif
        }
    }
}

constexpr int LDS_BYTES = 147456;
#ifndef PHMASK
#define PHMASK 0xffff
#endif

#define XB_TMO      128
#define XB_XCNT(j)  (256  + 64 * (j))
#define XB_XSUB(j)  (1280 + 64 * (j))
#define XB_XGEN(j)  (2304 + 64 * (j))
#define XB_TOP      3328
#define XB_TOPGEN   3392
#define XCD_BAR_WORDS 3456
#define XB_SPIN_CAP (1u << 18)

__device__ __forceinline__ unsigned xb_ld(unsigned* p)              { return __hip_atomic_load(p, __ATOMIC_RELAXED, __HIP_MEMORY_SCOPE_AGENT); }
__device__ __forceinline__ unsigned xb_add(unsigned* p, unsigned v) { return __hip_atomic_fetch_add(p, v, __ATOMIC_RELAXED, __HIP_MEMORY_SCOPE_AGENT); }
__device__ __forceinline__ unsigned xb_xcc_id() { return (unsigned)__builtin_amdgcn_s_getreg((3 << 11) | 20) & 0xFu; }
#define XB_SPIN(cond, bar) do { unsigned _sp = 0; while (cond) { __builtin_amdgcn_s_sleep(1); \
    if ((++_sp & 255u) == 0u) { if (xb_ld(&(bar)[XB_TMO])) break; if (_sp > XB_SPIN_CAP) { atomicAdd(&(bar)[XB_TMO], 1u); break; } } } } while (0)

struct XcdBarrier {
    unsigned* bar; unsigned x;
    volatile LAS unsigned* st;
};

__device__ __forceinline__ XcdBarrier xcd_barrier_post(unsigned* bar, volatile LAS unsigned* st) {
    XcdBarrier b; b.bar = bar; b.x = xb_xcc_id(); b.st = st;
    if (threadIdx.x == 0) (void)xb_add(&bar[XB_XCNT(b.x)], 1u);
    return b;
}
__device__ __forceinline__ void xcd_barrier_complete(unsigned* bar, unsigned x, unsigned& nloc, unsigned& nx) {
    const unsigned G = gridDim.x * gridDim.y * gridDim.z;
    unsigned sum, cnt, mine, sp = 0u;
    for (;;) {
        sum = 0u; cnt = 0u; mine = 0u;
#pragma unroll
        for (unsigned j = 0; j < 16; ++j) { const unsigned c = xb_ld(&bar[XB_XCNT(j)]); sum += c; cnt += (c > 0u) ? 1u : 0u; mine = (j == x) ? c : mine; }
        if (sum == G) break;
        __builtin_amdgcn_s_sleep(1);
        if ((++sp & 255u) == 0u) { if (xb_ld(&bar[XB_TMO])) break; if (sp > XB_SPIN_CAP) { atomicAdd(&bar[XB_TMO], 1u); break; } }
    }
    nloc = mine > 0u ? mine : 1u; nx = cnt > 0u ? cnt : 1u;
}

__device__ __forceinline__ void xcd_barrier(const XcdBarrier& b, const bool is_t0) {
    asm volatile("s_waitcnt vmcnt(0)" ::: "memory");
    __syncthreads();
    if (is_t0) {
        unsigned* bar = b.bar;
        __builtin_amdgcn_s_waitcnt(0);
        unsigned nloc = b.st[0], nx = b.st[1];
        if (nloc == 0u) { xcd_barrier_complete(bar, b.x, nloc, nx); b.st[0] = nloc; b.st[1] = nx; }
        const unsigned old = xb_add(&bar[XB_XSUB(b.x)], 1u);
        const unsigned gen = old / nloc;
        if (old + 1u == (gen + 1u) * nloc) {
            __builtin_amdgcn_fence(__ATOMIC_RELEASE, "agent");
            asm volatile("s_waitcnt vmcnt(0)" ::: "memory");
            const unsigned og = xb_add(&bar[XB_TOP], 1u);
            const unsigned tg = og / nx;
            if (og + 1u == (tg + 1u) * nx) xb_add(&bar[XB_TOPGEN], 1u);
            else XB_SPIN(xb_ld(&bar[XB_TOPGEN]) == tg, bar);
            __builtin_amdgcn_fence(__ATOMIC_ACQUIRE, "agent");
            xb_add(&bar[XB_XGEN(b.x)], 1u);
            asm volatile("s_waitcnt vmcnt(0)" ::: "memory");
        } else {
            XB_SPIN(xb_ld(&bar[XB_XGEN(b.x)]) == gen, bar);
            __builtin_amdgcn_fence(__ATOMIC_ACQUIRE, "agent");
            asm volatile("s_waitcnt vmcnt(0)" ::: "memory");
        }
    }
    __syncthreads();
}

constexpr size_t WS_BAR = 786432;
constexpr int LDS_BARST = 131072 + 512;
constexpr int LDS_PTAB = 131072;
__device__ __forceinline__ const void* lds_ptr(LAS const unsigned long long* pt, int i) {
    const unsigned long long v = pt[i];
    const unsigned lo = __builtin_amdgcn_readfirstlane((unsigned)v), hi = __builtin_amdgcn_readfirstlane((unsigned)(v >> 32));
    return (const void*)(const __attribute__((address_space(1))) void*)(((unsigned long long)hi << 32) | lo);
}
__device__ __forceinline__ Args load_args(LAS unsigned char* lds) {
    int z = 0; asm volatile("" : "+s"(z));
    LAS const unsigned long long* pt = (LAS const unsigned long long*)(lds + LDS_PTAB + z);
    Args a;
#pragma unroll
    for (int i = 0; i < 26; ++i) a.in[i] = (const float*)lds_ptr(pt, i);
    a.out = (float*)lds_ptr(pt, 26); a.ws = (unsigned char*)lds_ptr(pt, 27); a.pad0 = 0; a.pad1 = 0;
    return a;
}
__global__ void __launch_bounds__(512, 2) fwd_megakernel(Args ka) {
    extern __shared__ __attribute__((aligned(16))) unsigned char lds_raw[];
    LAS unsigned char* lds = (LAS unsigned char*)lds_raw;
    cg::grid_group grid = cg::this_grid();
    if (threadIdx.x == 0) {
        LAS unsigned long long* pt = (LAS unsigned long long*)(lds + LDS_PTAB);
#pragma unroll
        for (int i = 0; i < 26; ++i) pt[i] = (unsigned long long)ka.in[i];
        pt[26] = (unsigned long long)ka.out; pt[27] = (unsigned long long)ka.ws;
    }
    if (threadIdx.x == 0) { ((LAS unsigned*)(lds + LDS_BARST))[0] = 0u; ((LAS unsigned*)(lds + LDS_BARST))[1] = 0u; }
    __syncthreads();
    const int s_wave = __builtin_amdgcn_readfirstlane((int)threadIdx.x >> 6);
    (void)xcd_barrier_post((unsigned*)(ka.ws + WS_BAR), (volatile LAS unsigned*)(lds + LDS_BARST));
#if PHMASK & 1
    { const int tid = threadIdx.x, lane = tid & 63, wave = __builtin_amdgcn_readfirstlane(tid >> 6); const Args a = load_args(lds);
      phase_prologue(a, lds, (int)blockIdx.x * 8 + wave, (int)gridDim.x * 8, lane, wave); }
#endif
    grid.sync();

#define GBAR() do { int z_ = 0; asm volatile("" : "+s"(z_)); XcdBarrier b_; b_.bar = (unsigned*)((unsigned char*)lds_ptr((LAS const unsigned long long*)(lds + LDS_PTAB + z_), 27) + WS_BAR); \
    b_.x = xb_xcc_id(); b_.st = (volatile LAS unsigned*)(lds + LDS_BARST + z_); xcd_barrier(b_, s_wave == 0 && __builtin_amdgcn_mbcnt_hi(~0u, __builtin_amdgcn_mbcnt_lo(~0u, (unsigned)z_)) == 0u); } while (0)
#define PH_BEGIN int w_ = s_wave, g_ = g; asm volatile("" : "+s"(w_), "+s"(g_)); int zz_ = 0; asm volatile("" : "+s"(zz_)); int lane_ = (int)__builtin_amdgcn_mbcnt_hi(~0u, __builtin_amdgcn_mbcnt_lo(~0u, (unsigned)zz_)); asm volatile("" : "+v"(lane_)); const int lane = lane_, wave = w_, tid_ = w_ * 64 + lane; (void)tid_; \
    const int gw = (int)blockIdx.x * 8 + wave, ngw = (int)gridDim.x * 8; const Args a = load_args(lds); unsigned char* ws = a.ws; const float* rope = (const float*)(ws + WS_ROPE); (void)rope; const Grp G = make_grp(a, g_); const int M = G.ntiles * 256; (void)lane; (void)gw; (void)ngw; (void)M;
#pragma unroll 1
    for (int g = 0; g < NGRP; ++g) {
        { PH_BEGIN rms_rows_bf16(G.x, G.XN, a.in[7], G.nvalid, M, gw, ngw, lane); }
        GBAR();
#if PHMASK & 2
        { PH_BEGIN EpiIn E{G.QD, G.KD, G.VD, G.GD, G.GM, G.ZS, G.okd, G.ovd, G.nvalid, 0.125f * LOG2E};
          run_gemm(lds, G.XN, (const bf16*)(ws + WS_WIN), M, NIN, 1024, E, tid_); }
#endif
        GBAR();
        { PH_BEGIN phase_small(G, a.in[14], a.in[16], rope, gw, ngw, lane); }
        GBAR();
#if PHMASK & 4
        { PH_BEGIN EpiQ E{G.QN, G.QR, rope, G.sample, 0.10206207261596575f * LOG2E};
          run_gemm(lds, G.CQ, (const bf16*)(ws + WS_WUQ), M, 1536, 256, E, tid_); }
#endif
#if PHMASK & 8
        { PH_BEGIN EpiKV E{G.KN, G.VM};
          run_gemm(lds, G.CKV, (const bf16*)(ws + WS_WUKV), M, 2048, 256, E, tid_); }
        if (g == 0) { PH_BEGIN EpiKV E{(bf16*)(ws + WS_PROMPT + C_KNC), (bf16*)(ws + WS_PROMPT + C_VMC)};
          run_gemm(lds, (const bf16*)(ws + WS_PROMPT + C_CKVC), (const bf16*)(ws + WS_WUKV), CACHE_ROWS, 2048, 256, E, tid_); }
#endif
        GBAR();
#if PHMASK & 16
        { PH_BEGIN phase_attention(a, G, lds, tid_); }
#endif
        GBAR();
        if (g != 0) {
            { PH_BEGIN phase_diffmix(G, ((const float*)(ws + WS_TAB))[1536], a.in[13], gw, ngw, lane); }
            GBAR();
        }
        if (g == 0) {
            { PH_BEGIN phase_combine(G, (const float*)(ws + WS_PO_D), (const float*)(ws + WS_PO_M), (const float*)(ws + WS_PM), (const float*)(ws + WS_PL), ((const float*)(ws + WS_TAB))[1536], a.in[13], gw, ngw, lane); }
            GBAR();
        }
#if PHMASK & 32
        { PH_BEGIN EpiM1 E{G.GD, G.XN}; run_gemm(lds, G.DO, (const bf16*)(ws + WS_WOD), M, 1024, 1024, E, tid_); }
        { PH_BEGIN EpiM2 E{G.GM, G.XN}; run_gemm(lds, G.MO, (const bf16*)(ws + WS_WOM), M, 1024, 1024, E, tid_); }
#endif
        GBAR();
#if PHMASK & 64
        { PH_BEGIN EpiOut E{G.x, G.y, G.nvalid}; run_gemm(lds, G.XN, (const bf16*)(ws + WS_WOUT), M, 1024, 1024, E, tid_); }
#endif
        GBAR();
        { PH_BEGIN rms_rows_bf16(G.y, G.XN, a.in[22], G.nvalid, M, gw, ngw, lane); }
        GBAR();
#if PHMASK & 128
        { PH_BEGIN EpiUp E{G.U}; run_gemm(lds, G.XN, (const bf16*)(ws + WS_WUP), M, 4096, 1024, E, tid_); }
#endif
        GBAR();
#if PHMASK & 256
        { PH_BEGIN EpiDown E{G.y, G.nvalid}; run_gemm(lds, G.U, (const bf16*)(ws + WS_WDN), M, 1024, 4096, E, tid_); }
#endif
        GBAR();
        { PH_BEGIN rms_rows_f32_inplace(G.y, a.in[25], G.nvalid, gw, ngw, lane); }
    }
}

extern "C" void kernel_launch(void* const* d_in, const int* in_sizes, int n_in, void* d_out, int out_size, void* d_ws, size_t ws_size, hipStream_t stream) {
    static int grid = 0;
    if (grid == 0) {
        if (n_in != 26 || ws_size < WS_NEED) { fprintf(stderr, "kernel_launch: need 26 inputs and %zu bytes of workspace; got %d, %zu\n", (size_t)WS_NEED, n_in, ws_size); grid = -1; return; }
        int dev = 0, cus = 0, per_cu = 0;
        if (hipGetDevice(&dev) != hipSuccess || hipDeviceGetAttribute(&cus, hipDeviceAttributeMultiprocessorCount, dev) != hipSuccess) { grid = -1; return; }
        if (hipFuncSetAttribute((const void*)fwd_megakernel, hipFuncAttributeMaxDynamicSharedMemorySize, LDS_BYTES) != hipSuccess) { fprintf(stderr, "kernel_launch: hipFuncSetAttribute failed\n"); grid = -1; return; }
        if (hipOccupancyMaxActiveBlocksPerMultiprocessor(&per_cu, (const void*)fwd_megakernel, 512, LDS_BYTES) != hipSuccess || per_cu < 1) { fprintf(stderr, "kernel_launch: occupancy query says %d\n", per_cu); per_cu = 1; }
        (void)hipGetLastError();
        grid = cus;
    }
    if (grid < 0) return;
    if (hipMemsetAsync((char*)d_ws + WS_BAR, 0, 16384, stream) != hipSuccess) { fprintf(stderr, "kernel_launch: memset failed\n"); return; }
    Args a{};
    for (int i = 0; i < 26; ++i) a.in[i] = (const float*)d_in[i];
    a.out = (float*)d_out; a.ws = (unsigned char*)d_ws;
    void* args[] = {&a};
    hipError_t e = hipLaunchCooperativeKernel((const void*)fwd_megakernel, dim3(grid), dim3(512), args, LDS_BYTES, stream);
    if (e != hipSuccess) fprintf(stderr, "kernel_launch: cooperative launch failed: %s (grid %d)\n", hipGetErrorString(e), grid);
}
```

```cpp
#include <hip/hip_runtime.h>
#include <hip/hip_cooperative_groups.h>
#include <cstdio>
#include <cstdint>
namespace cg = cooperative_groups;
namespace pg8 {
#define PG8_LAS __attribute__((address_space(3)))
typedef unsigned short bf16_t;
typedef short bf16x8 __attribute__((ext_vector_type(8)));
typedef float f32x4 __attribute__((ext_vector_type(4)));
typedef unsigned u32x4 __attribute__((ext_vector_type(4)));
constexpr int BM = 256, BK = 64, HALF = 128, HTB = HALF * BK * 2  , STAGE_BYTES = 8 * HTB, NXCD = 8, WGM = 8;

__host__ __device__ __forceinline__ int lds_byte(int r, int c) { const int st = (r >> 4) * 2 + (c >> 5), rr = r & 15, cc = c & 31, ob = rr * 64 + cc * 2; return st * 1024 + (ob ^ (((ob >> 9) & 1) << 5)); }
__host__ __device__ __forceinline__ void stage_rc(int b, int& R, int& C) { const int st = b / 1024, sb = b % 1024, swz = sb ^ (((sb >> 9) & 1) << 5); R = (st >> 1) * 16 + swz / 64; C = (st & 1) * 32 + (swz % 64) / 2; }
__host__ __device__ __forceinline__ int perm32(int rho) { const int n = rho >> 4, i = rho & 15; return 8 * (i >> 2) + 4 * n + (i & 3); }

struct Unit { int pm, pn; };
struct Gemm { const bf16_t* A; const bf16_t* Bt; int M, N, K; };

struct StaticOrder {
    int nM, nN, nwg, G, c;
    __host__ __device__ void init(int M, int N, int G_, int c_) { nM = M / BM; nN = N / BM; nwg = nM * nN; G = G_; c = c_; }
    __host__ __device__ bool next(int i, Unit& u) const {
        const long L = (long)i * G + c; if (L >= nwg) return false;
        int wgid = (int)L; { const int q = nwg / NXCD, r = nwg % NXCD, xcd = wgid % NXCD, off = wgid / NXCD; wgid = (xcd < r ? xcd * (q + 1) : r * (q + 1) + (xcd - r) * q) + off; }
        const int nig = WGM * nN, gid = wgid / nig, fm = gid * WGM, gsz = (nM - fm) < WGM ? (nM - fm) : WGM;
        u.pm = fm + ((wgid % nig) % gsz); u.pn = (wgid % nig) / gsz; return true;
    }
    __device__ __forceinline__ void a_ready(const Unit&) const {}
    __device__ __forceinline__ void done(const Unit&) const {}
};

__device__ __forceinline__ unsigned cvt_pk_bf16(float lo, float hi) { unsigned r; asm volatile("v_cvt_pk_bf16_f32 %0, %1, %2" : "=v"(r) : "v"(lo), "v"(hi)); return r; }
typedef float f32x2 __attribute__((ext_vector_type(2)));
template <class Epi, class Sched, bool ALIGN_EPI = false, bool SP2 = false>
__device__ __forceinline__ void gemm_phase(PG8_LAS unsigned char* lds, const Gemm g, const Sched& S, const Epi& E, const int tid_in) {
    int tid_ = tid_in; asm volatile("" : "+v"(tid_));
    const int tid = tid_, wid = __builtin_amdgcn_readfirstlane(tid >> 6), lane = tid & 63, wr = wid >> 2, wc = wid & 3, fr = lane & 15, fq = lane >> 4;
    const int K = g.K, nt = K / BK;
    unsigned voffA[2], voffB[2];
#pragma unroll
    for (int i = 0; i < 2; ++i) { int R, C; stage_rc(tid * 16 + i * 8192, R, C); const int Rb = Epi::PERM ? ((R & ~31) + perm32(R & 31)) : R;
        voffA[i] = (unsigned)(R * K + C) * 2u; voffB[i] = (unsigned)(Rb * K + C) * 2u; }
    const size_t kstep = (size_t)(BK * 2);
    const size_t hstep = (size_t)HALF * K * 2;
    const size_t tstep = 2 * hstep;
    const unsigned ldsw = (unsigned)wid * 1024u;
    const int aoff = lds_byte(wr * 64 + fr, fq * 8), boff = lds_byte(wc * 32 + fr, fq * 8);
#define PG8_SA(b, h) (((b) * 2 + (h)) * HTB)
#define PG8_SB(b, h) ((4 + (b) * 2 + (h)) * HTB)
#define PG8_STAGE(bufoff, gbase, voff) do { _Pragma("unroll") for (int _i = 0; _i < 2; ++_i) \
        __builtin_amdgcn_global_load_lds((const unsigned*)((const char*)(gbase) + (voff)[_i]), (PG8_LAS unsigned*)(lds + (bufoff) + ldsw + _i * 8192), 16, 0, 0); } while (0)
#define PG8_LDA(dst, b, h) do { _Pragma("unroll") for (int m = 0; m < 4; ++m) _Pragma("unroll") for (int k = 0; k < 2; ++k) dst[m][k] = *(const PG8_LAS bf16x8*)(lds + PG8_SA(b, h) + aoff + m * 2048 + k * 1024); } while (0)
#define PG8_LDB(dst, b, h) do { _Pragma("unroll") for (int n = 0; n < 2; ++n) _Pragma("unroll") for (int k = 0; k < 2; ++k) dst[n][k] = *(const PG8_LAS bf16x8*)(lds + PG8_SB(b, h) + boff + n * 2048 + k * 1024); } while (0)
#define PG8_MMA(ai, bj, At, Bt) do { __builtin_amdgcn_s_setprio(1); _Pragma("unroll") for (int m = 0; m < 4; ++m) _Pragma("unroll") for (int n = 0; n < 2; ++n) _Pragma("unroll") for (int k = 0; k < 2; ++k) \
        acc[ai][bj][m][n] = __builtin_amdgcn_mfma_f32_16x16x32_bf16(Bt[n][k], At[m][k], acc[ai][bj][m][n], 0, 0, 0); __builtin_amdgcn_s_setprio(0); } while (0)
#define PG8_WAIT_V(n) asm volatile("s_waitcnt vmcnt(" #n ")" ::: "memory")
#define PG8_WAIT_L(n) asm volatile("s_waitcnt lgkmcnt(" #n ")" ::: "memory")
#define PG8_BAR __builtin_amdgcn_s_barrier()
#define PG8_SCHED __builtin_amdgcn_sched_barrier(0)
    Unit cur, nxt; int ui = 0;
    if (!S.next(0, cur)) return;
    f32x4 acc[2][2][4][2];
#pragma unroll
    for (int a = 0; a < 2; ++a)
#pragma unroll
        for (int b = 0; b < 2; ++b)
#pragma unroll
            for (int m = 0; m < 4; ++m)
#pragma unroll
                for (int n = 0; n < 2; ++n) acc[a][b][m][n] = (f32x4){0.f, 0.f, 0.f, 0.f};
    bf16x8 At[4][2], B0[2][2], B1[2][2];
    const char* cA = (const char*)g.A + (size_t)cur.pm * tstep; const char* cB = (const char*)g.Bt + (size_t)cur.pn * tstep;
    S.a_ready(cur);
    if constexpr (SP2) {
        PG8_STAGE(PG8_SB(0, 0), cB, voffB); PG8_STAGE(PG8_SB(0, 1), cB + hstep, voffB); PG8_STAGE(PG8_SA(0, 0), cA, voffA); PG8_STAGE(PG8_SA(0, 1), cA + hstep, voffA);
        if (wr == 1) PG8_BAR;
        PG8_WAIT_V(2); PG8_BAR;
        PG8_STAGE(PG8_SB(1, 0), cB + kstep, voffB); PG8_STAGE(PG8_SA(1, 0), cA + kstep, voffA); PG8_STAGE(PG8_SB(1, 1), cB + hstep + kstep, voffB);
        PG8_WAIT_V(6); PG8_BAR;
    } else {
        PG8_STAGE(PG8_SB(0, 0), cB, voffB); PG8_STAGE(PG8_SA(0, 0), cA, voffA); PG8_STAGE(PG8_SB(0, 1), cB + hstep, voffB); PG8_STAGE(PG8_SA(0, 1), cA + hstep, voffA);
        if (wr == 1) PG8_BAR;
        PG8_WAIT_V(4); PG8_BAR;
        PG8_STAGE(PG8_SB(1, 0), cB + kstep, voffB); PG8_STAGE(PG8_SA(1, 0), cA + kstep, voffA); PG8_STAGE(PG8_SB(1, 1), cB + hstep + kstep, voffB);
        PG8_WAIT_V(6); PG8_BAR;
    }
    for (;;) {
        const bool has_next = S.next(ui + 1, nxt);
        const char* nA = has_next ? (const char*)g.A + (size_t)nxt.pm * tstep : cA; const char* nB = has_next ? (const char*)g.Bt + (size_t)nxt.pn * tstep : cB;
        for (int t = 0; t < nt; t += 2) {
            const bool last = (t == nt - 2);
            const char* a1 = cA + (size_t)(t + 1) * kstep;
            const char* a2 = last ? nA : cA + (size_t)(t + 2) * kstep; const char* b2 = last ? nB : cB + (size_t)(t + 2) * kstep;
            const char* a3 = a2 + kstep; const char* b3 = b2 + kstep;
            if (last && has_next) S.a_ready(nxt);
            if constexpr (SP2) {
            PG8_LDB(B0, 0, 0); PG8_LDB(B1, 0, 1); PG8_SCHED; PG8_LDA(At, 0, 0); PG8_STAGE(PG8_SA(1, 1), a1 + hstep, voffA);
            PG8_WAIT_V(8); PG8_WAIT_L(0); PG8_BAR; PG8_MMA(0, 0, At, B0); PG8_MMA(0, 1, At, B1); PG8_BAR; PG8_SCHED;
            PG8_LDA(At, 0, 1); PG8_STAGE(PG8_SB(0, 0), b2, voffB); PG8_STAGE(PG8_SB(0, 1), b2 + hstep, voffB); PG8_STAGE(PG8_SA(0, 0), a2, voffA);
            PG8_WAIT_V(8); PG8_WAIT_L(0); PG8_BAR; PG8_MMA(1, 0, At, B0); PG8_MMA(1, 1, At, B1); PG8_BAR; PG8_SCHED;
            PG8_LDB(B0, 1, 0); PG8_LDB(B1, 1, 1); PG8_SCHED; PG8_LDA(At, 1, 0); PG8_STAGE(PG8_SA(0, 1), a2 + hstep, voffA);
            PG8_WAIT_V(8); PG8_WAIT_L(0); PG8_BAR; PG8_MMA(0, 0, At, B0); PG8_MMA(0, 1, At, B1); PG8_BAR; PG8_SCHED;
            PG8_LDA(At, 1, 1); PG8_STAGE(PG8_SB(1, 0), b3, voffB); PG8_STAGE(PG8_SB(1, 1), b3 + hstep, voffB); PG8_STAGE(PG8_SA(1, 0), a3, voffA);
            PG8_WAIT_V(8); PG8_WAIT_L(0); PG8_BAR; PG8_MMA(1, 0, At, B0); PG8_MMA(1, 1, At, B1); PG8_BAR; PG8_SCHED;
            } else {
            PG8_LDB(B0, 0, 0); PG8_SCHED; PG8_LDA(At, 0, 0); PG8_STAGE(PG8_SA(1, 1), a1 + hstep, voffA);
            PG8_WAIT_L(8); PG8_BAR; PG8_WAIT_L(0); PG8_MMA(0, 0, At, B0); PG8_BAR; PG8_SCHED;
            PG8_LDB(B1, 0, 1); PG8_STAGE(PG8_SB(0, 0), b2, voffB);
            PG8_BAR; PG8_WAIT_L(0); PG8_MMA(0, 1, At, B1); PG8_BAR;
            PG8_LDA(At, 0, 1); PG8_STAGE(PG8_SA(0, 0), a2, voffA);
            PG8_BAR; PG8_WAIT_L(0); PG8_MMA(1, 0, At, B0); PG8_BAR; PG8_SCHED;
            PG8_STAGE(PG8_SB(0, 1), b2 + hstep, voffB);
            PG8_WAIT_V(6); PG8_BAR; PG8_MMA(1, 1, At, B1); PG8_BAR;
            PG8_LDB(B0, 1, 0); PG8_SCHED; PG8_LDA(At, 1, 0); PG8_STAGE(PG8_SA(0, 1), a2 + hstep, voffA);
            PG8_WAIT_L(8); PG8_BAR; PG8_WAIT_L(0); PG8_MMA(0, 0, At, B0); PG8_BAR; PG8_SCHED;
            PG8_LDB(B1, 1, 1); PG8_STAGE(PG8_SB(1, 0), b3, voffB);
            PG8_BAR; PG8_WAIT_L(0); PG8_MMA(0, 1, At, B1); PG8_BAR;
            PG8_LDA(At, 1, 1); PG8_STAGE(PG8_SA(1, 0), a3, voffA);
            PG8_BAR; PG8_WAIT_L(0); PG8_MMA(1, 0, At, B0); PG8_BAR; PG8_SCHED;
            PG8_STAGE(PG8_SB(1, 1), b3 + hstep, voffB);
            PG8_WAIT_V(6); PG8_BAR; PG8_MMA(1, 1, At, B1); PG8_BAR;
            }
        }
        if constexpr (ALIGN_EPI) { if (wr == 0) PG8_BAR; }
        if constexpr (!Epi::AFTER_DRAIN) { E(acc, cur, wr, wc, fr, fq); S.done(cur); }
        if (!has_next) break;
#pragma unroll
        for (int a = 0; a < 2; ++a)
#pragma unroll
            for (int b = 0; b < 2; ++b)
#pragma unroll
                for (int m = 0; m < 4; ++m)
#pragma unroll
                    for (int n = 0; n < 2; ++n) acc[a][b][m][n] = (f32x4){0.f, 0.f, 0.f, 0.f};
        cur = nxt; cA = nA; cB = nB; ++ui;
        if constexpr (ALIGN_EPI) { if (wr == 1) PG8_BAR; }
    }
    PG8_WAIT_V(0);
    if constexpr (!ALIGN_EPI) { if (wr == 0) PG8_BAR; }
    PG8_BAR;
    if constexpr (Epi::AFTER_DRAIN) { E.fused(acc, cur, wr, wc, fr, fq, lds, wid, lane); S.done(cur); }
#undef PG8_SA
#undef PG8_SB
#undef PG8_STAGE
#undef PG8_LDA
#undef PG8_LDB
#undef PG8_MMA
#undef PG8_WAIT_V
#undef PG8_WAIT_L
#undef PG8_BAR
#undef PG8_SCHED
}
}

#define LAS __attribute__((address_space(3)))
typedef unsigned short bf16;
typedef float f32x4 __attribute__((ext_vector_type(4)));
typedef float f32x2 __attribute__((ext_vector_type(2)));
typedef float f32x16 __attribute__((ext_vector_type(16)));
typedef short bf16x8 __attribute__((ext_vector_type(8)));
typedef short s16x4 __attribute__((ext_vector_type(4)));
typedef unsigned u32x4 __attribute__((ext_vector_type(4)));
typedef unsigned u32x2 __attribute__((ext_vector_type(2)));

constexpr int DM = 1024, NB = 32, TS = 2048, SB = 8, ST = 16, PAST = 4096;
constexpr int NPG = 2;
constexpr int RG = NB * TS / NPG;
constexpr int GBATCH = NB / NPG;
constexpr int NGRP = NPG + 1;
constexpr int NIN = 5888;
constexpr float LOG2E = 1.4426950408889634f;
constexpr float EPSN = 1e-6f;
constexpr int NSPLIT = 4;
constexpr int CACHE_ROWS = SB * PAST;

constexpr size_t O_YP = 0, O_YS = 67108864, O_KDP = 67239936, O_VDP = 134348800, O_CKVP = 201457664, O_KRP = 218234880,
                 O_KDS = 220332032, O_VDS = 220463104, O_CKVS = 220594176, O_KRS = 220626944;
constexpr size_t MiB = 1u << 20;
constexpr size_t WS_TAB = 0;
constexpr size_t WS_ROPE = 8192;
constexpr size_t WS_WIN = 1 * MiB;
constexpr size_t WS_WUQ = WS_WIN + (size_t)NIN * 1024 * 2;
constexpr size_t WS_WUKV = WS_WUQ + 1536 * 256 * 2;
constexpr size_t WS_WOD = WS_WUKV + 2048 * 256 * 2;
constexpr size_t WS_WOM = WS_WOD + 2 * MiB;
constexpr size_t WS_WOUT = WS_WOM + 2 * MiB;
constexpr size_t WS_WUP = WS_WOUT + 2 * MiB;
constexpr size_t WS_WDN = WS_WUP + 8 * MiB;
constexpr size_t WS_WEND = WS_WDN + 8 * MiB;
constexpr size_t WS_SAMP = 37 * MiB;
constexpr size_t WS_PART = 44 * MiB;
constexpr size_t WS_PO_D = WS_PART, WS_PO_M = WS_PART + 8 * MiB, WS_PM = WS_PART + 12 * MiB, WS_PL = WS_PM + 131072;
constexpr size_t WS_PROMPT = 58 * MiB;
constexpr size_t GRP_BYTES_PER_ROW = 27712;
constexpr size_t WS_NEED = WS_PROMPT + (size_t)RG * GRP_BYTES_PER_ROW;
static_assert(WS_WEND <= WS_SAMP && WS_SAMP + 256 * GRP_BYTES_PER_ROW <= WS_PART && WS_PL + 131072 <= WS_PROMPT, "ws map");
constexpr size_t C_KDC = 0, C_VDC = 64 * MiB, C_KNC = 128 * MiB, C_VMC = 192 * MiB, C_CKVC = 256 * MiB, C_KRC = 272 * MiB;

struct Args { const float* in[26]; float* out; unsigned char* ws; int pad0, pad1; };

struct Grp {
    const float* x; float* y; float* okd; float* ovd; float* ockv; float* okr;
    int nvalid, ntiles, sample;
    bf16 *QD, *KD, *VD, *QN, *U, *XN, *QR, *KN, *VM, *GD, *GM, *DO, *MO, *CQ, *CKV, *KR; float* ZS;
};
__device__ __forceinline__ Grp make_grp(const Args& a, int g) {
    Grp G; unsigned char* base; size_t RC;
    if (g == 0) {
        G.x = a.in[1]; G.y = a.out + O_YS; G.okd = a.out + O_KDS; G.ovd = a.out + O_VDS; G.ockv = a.out + O_CKVS; G.okr = a.out + O_KRS;
        G.nvalid = SB * ST; G.ntiles = 1; G.sample = 1; base = a.ws + WS_SAMP; RC = 256;
    } else {
        const size_t r0 = (size_t)(g - 1) * RG;
        G.x = a.in[0] + r0 * 1024; G.y = a.out + O_YP + r0 * 1024; G.okd = a.out + O_KDP + r0 * 1024; G.ovd = a.out + O_VDP + r0 * 1024;
        G.ockv = a.out + O_CKVP + r0 * 256; G.okr = a.out + O_KRP + r0 * 32;
        G.nvalid = RG; G.ntiles = RG / 256; G.sample = 0; base = a.ws + WS_PROMPT; RC = RG;
    }
    G.QD = (bf16*)(base); G.KD = (bf16*)(base + RC * 2048); G.VD = (bf16*)(base + RC * 4096); G.QN = (bf16*)(base + RC * 6144); G.U = (bf16*)base;
    G.XN = (bf16*)(base + RC * 8192); G.QR = (bf16*)(base + RC * 10240); G.KN = (bf16*)(base + RC * 11264); G.VM = (bf16*)(base + RC * 13312);
    G.GD = (bf16*)(base + RC * 15360); G.GM = (bf16*)(base + RC * 17408); G.DO = (bf16*)(base + RC * 19456); G.MO = (bf16*)(base + RC * 21504);
    G.ZS = (float*)(base + RC * 23552); G.CQ = (bf16*)(base + RC * 26624); G.CKV = (bf16*)(base + RC * 27136); G.KR = (bf16*)(base + RC * 27648);
    return G;
}

template <int M> __device__ __forceinline__ float swz_xor(float v) { return __int_as_float(__builtin_amdgcn_ds_swizzle(__float_as_int(v), 0x1F | (M << 10))); }
__device__ __forceinline__ float half_sum32(float v) { v += swz_xor<1>(v); v += swz_xor<2>(v); v += swz_xor<4>(v); v += swz_xor<8>(v); v += swz_xor<16>(v); return v; }
__device__ __forceinline__ float wave_sum(float v) {
    v = half_sum32(v);
    auto rr = __builtin_amdgcn_permlane32_swap(__float_as_uint(v), __float_as_uint(v), false, false);
    return __uint_as_float(rr[0]) + __uint_as_float(rr[1]);
}
typedef __bf16 bf16x2_hw __attribute__((ext_vector_type(2)));
__device__ __forceinline__ unsigned pk2(float lo, float hi) { f32x2 v = {lo, hi}; bf16x2_hw b = __builtin_convertvector(v, bf16x2_hw); return __builtin_bit_cast(unsigned, b); }
__device__ __forceinline__ unsigned f2bf(float f) { return pk2(f, 0.f) & 0xffffu; }
__device__ __forceinline__ float bflo(unsigned w) { return __builtin_bit_cast(float, w << 16); }
__device__ __forceinline__ float bfhi(unsigned w) { return __builtin_bit_cast(float, w & 0xffff0000u); }
__device__ __forceinline__ void st_bf4(bf16* p, f32x4 v) { u32x2 w; w.x = pk2(v[0], v[1]); w.y = pk2(v[2], v[3]); *(u32x2*)p = w; }
__device__ __forceinline__ f32x4 ld_bf4(const bf16* p) { const u32x2 w = *(const u32x2*)p; return (f32x4){bflo(w.x), bfhi(w.x), bflo(w.y), bfhi(w.y)}; }
__device__ __forceinline__ float sigm(float x) { return 1.f / (1.f + __expf(-x)); }

#define EPI_LOOP(BODY) \
    _Pragma("unroll") for (int ai = 0; ai < 2; ++ai) _Pragma("unroll") for (int m = 0; m < 4; ++m) { const int row = u.pm * 256 + ai * 128 + wr * 64 + m * 16 + fr; const size_t rw = (size_t)row; (void)rw; \
    _Pragma("unroll") for (int bj = 0; bj < 2; ++bj) _Pragma("unroll") for (int n = 0; n < 2; ++n) { const int cl = bj * 128 + wc * 32 + n * 16 + 4 * fq; const f32x4 v = acc[ai][bj][m][n]; BODY } asm volatile("" ::: "memory"); }

#define EPI_LOOP_P(...) \
    _Pragma("unroll") for (int ai = 0; ai < 2; ++ai) _Pragma("unroll") for (int m = 0; m < 4; ++m) { const int row = u.pm * 256 + ai * 128 + wr * 64 + m * 16 + fr; const size_t rw = (size_t)row; (void)rw; \
    _Pragma("unroll") for (int bj = 0; bj < 2; ++bj) { const int cl = bj * 128 + wc * 32 + 8 * fq; const f32x4 v0 = acc[ai][bj][m][0], v1 = acc[ai][bj][m][1]; __VA_ARGS__ } asm volatile("" ::: "memory"); }
__device__ __forceinline__ void st_bf8(bf16* p, f32x4 a, f32x4 b) { u32x4 w; w.x = pk2(a[0], a[1]); w.y = pk2(a[2], a[3]); w.z = pk2(b[0], b[1]); w.w = pk2(b[2], b[3]); *(u32x4*)p = w; }
__device__ __forceinline__ void ld_bf8(const bf16* p, f32x4& a, f32x4& b) { const u32x4 w = *(const u32x4*)p; a = (f32x4){bflo(w.x), bfhi(w.x), bflo(w.y), bfhi(w.y)}; b = (f32x4){bflo(w.z), bfhi(w.z), bflo(w.w), bfhi(w.w)}; }
__device__ __forceinline__ f32x4 sigm4(f32x4 v) { return (f32x4){sigm(v[0]), sigm(v[1]), sigm(v[2]), sigm(v[3])}; }
typedef const f32x4 (&AccRef)[2][2][4][2];

struct EpiIn {
    static constexpr bool PERM = true, AFTER_DRAIN = false;
    bf16 *QD, *KD, *VD, *GD, *GM; float *ZS, *okd, *ovd; int nvalid; float qs;
    __device__ __forceinline__ void operator()(AccRef acc, const pg8::Unit& u, int wr, int wc, int fr, int fq) const {
        const int t = u.pn;
        if (t < 4) { const int c0 = t * 256; EPI_LOOP_P( st_bf8(QD + rw * 1024 + c0 + cl, v0 * qs, v1 * qs); ) }
        else if (t < 8) { const int c0 = (t - 4) * 256; EPI_LOOP_P( st_bf8(KD + rw * 1024 + c0 + cl, v0, v1); if (row < nvalid) { float* o = okd + rw * 1024 + c0 + cl; *(f32x4*)o = v0; *(f32x4*)(o + 4) = v1; } ) }
        else if (t < 12) { const int c0 = (t - 8) * 256; EPI_LOOP_P( st_bf8(VD + rw * 1024 + c0 + cl, v0, v1); if (row < nvalid) { float* o = ovd + rw * 1024 + c0 + cl; *(f32x4*)o = v0; *(f32x4*)(o + 4) = v1; } ) }
        else if (t < 15) { const int c0 = (t - 12) * 256; EPI_LOOP_P( float* o = ZS + rw * 768 + c0 + cl; *(f32x4*)o = v0; *(f32x4*)(o + 4) = v1; ) }
        else if (t < 19) { const int c0 = (t - 15) * 256; EPI_LOOP_P( st_bf8(GD + rw * 1024 + c0 + cl, sigm4(v0), sigm4(v1)); ) }
        else { const int c0 = (t - 19) * 256; EPI_LOOP_P( st_bf8(GM + rw * 1024 + c0 + cl, sigm4(v0), sigm4(v1)); ) }
    }
};
struct EpiQ {
    static constexpr bool PERM = false, AFTER_DRAIN = false;
    bf16 *QN, *QR; const float* rope; int sample; float qs;
    __device__ __forceinline__ void operator()(AccRef acc, const pg8::Unit& u, int wr, int wc, int fr, int fq) const {
        const int t = u.pn;
        if (t < 4) { const int c0 = t * 256; EPI_LOOP( st_bf4(QN + rw * 1024 + c0 + cl, v * qs); ) }
        else {
            const int c0 = (t - 4) * 256;
#pragma unroll
            for (int ai = 0; ai < 2; ++ai)
#pragma unroll
                for (int m = 0; m < 4; ++m) {
                    const int row = u.pm * 256 + ai * 128 + wr * 64 + m * 16 + fr;
                    const int pos = sample ? (PAST + (row & (ST - 1))) : (row & (TS - 1));
                    const f32x4 cs0 = *(const f32x4*)(rope + (size_t)pos * 32 + 8 * fq), cs1 = *(const f32x4*)(rope + (size_t)pos * 32 + 8 * fq + 4);
#pragma unroll
                    for (int bj = 0; bj < 2; ++bj) {
                        const f32x4 x1 = acc[ai][bj][m][0], x2 = acc[ai][bj][m][1];
                        f32x4 o1, o2;
                        o1[0] = x1[0] * cs0[0] - x2[0] * cs0[1]; o2[0] = x2[0] * cs0[0] + x1[0] * cs0[1];
                        o1[1] = x1[1] * cs0[2] - x2[1] * cs0[3]; o2[1] = x2[1] * cs0[2] + x1[1] * cs0[3];
                        o1[2] = x1[2] * cs1[0] - x2[2] * cs1[1]; o2[2] = x2[2] * cs1[0] + x1[2] * cs1[1];
                        o1[3] = x1[3] * cs1[2] - x2[3] * cs1[3]; o2[3] = x2[3] * cs1[2] + x1[3] * cs1[3];
                        bf16* p = QR + (size_t)row * 512 + c0 + bj * 128 + wc * 32 + 4 * fq;
                        st_bf4(p, o1 * qs); st_bf4(p + 16, o2 * qs);
                    }
                    asm volatile("" ::: "memory");
                }
        }
    }
};
struct EpiKV {
    static constexpr bool PERM = true, AFTER_DRAIN = false;
    bf16 *KN, *VM;
    __device__ __forceinline__ void operator()(AccRef acc, const pg8::Unit& u, int wr, int wc, int fr, int fq) const {
        const int t = u.pn; bf16* O = t < 4 ? KN : VM; const int c0 = (t & 3) * 256;
        EPI_LOOP_P( st_bf8(O + rw * 1024 + c0 + cl, v0, v1); )
    }
};
struct EpiM1 {
    static constexpr bool PERM = true, AFTER_DRAIN = false;
    const bf16* Gt; bf16* MG;
    __device__ __forceinline__ void operator()(AccRef acc, const pg8::Unit& u, int wr, int wc, int fr, int fq) const {
        const int c0 = u.pn * 256;
        EPI_LOOP_P( f32x4 g0, g1; ld_bf8(Gt + rw * 1024 + c0 + cl, g0, g1); st_bf8(MG + rw * 1024 + c0 + cl, g0 * v0, g1 * v1); )
    }
};
struct EpiM2 {
    static constexpr bool PERM = true, AFTER_DRAIN = false;
    const bf16* Gt; bf16* MG;
    __device__ __forceinline__ void operator()(AccRef acc, const pg8::Unit& u, int wr, int wc, int fr, int fq) const {
        const int c0 = u.pn * 256;
        EPI_LOOP_P( f32x4 g0, g1, o0, o1; ld_bf8(Gt + rw * 1024 + c0 + cl, g0, g1); ld_bf8(MG + rw * 1024 + c0 + cl, o0, o1); st_bf8(MG + rw * 1024 + c0 + cl, o0 + g0 * v0, o1 + g1 * v1); )
    }
};
struct EpiOut {
    static constexpr bool PERM = true, AFTER_DRAIN = false;
    const float* x; float* y; int nvalid;
    __device__ __forceinline__ void operator()(AccRef acc, const pg8::Unit& u, int wr, int wc, int fr, int fq) const {
        const int c0 = u.pn * 256;
        EPI_LOOP_P( if (row < nvalid) { const float* xb = x + rw * 1024 + c0 + cl; float* o = y + rw * 1024 + c0 + cl; const f32x4 b0 = *(const f32x4*)xb, b1 = *(const f32x4*)(xb + 4); *(f32x4*)o = b0 + v0; *(f32x4*)(o + 4) = b1 + v1; } )
    }
};
struct EpiUp {
    static constexpr bool PERM = true, AFTER_DRAIN = false;
    bf16* U;
    __device__ __forceinline__ void operator()(AccRef acc, const pg8::Unit& u, int wr, int wc, int fr, int fq) const {
        const int c0 = u.pn * 256;
        EPI_LOOP_P( f32x4 r0, r1; r0[0] = fmaxf(v0[0], 0.f); r0[1] = fmaxf(v0[1], 0.f); r0[2] = fmaxf(v0[2], 0.f); r0[3] = fmaxf(v0[3], 0.f); r1[0] = fmaxf(v1[0], 0.f); r1[1] = fmaxf(v1[1], 0.f); r1[2] = fmaxf(v1[2], 0.f); r1[3] = fmaxf(v1[3], 0.f);
                    st_bf8(U + rw * 4096 + c0 + cl, r0 * r0, r1 * r1); )
    }
};
struct EpiDown {
    static constexpr bool PERM = true, AFTER_DRAIN = false;
    float* y; int nvalid;
    __device__ __forceinline__ void operator()(AccRef acc, const pg8::Unit& u, int wr, int wc, int fr, int fq) const {
        const int c0 = u.pn * 256;
        EPI_LOOP_P( if (row < nvalid) { float* p = y + rw * 1024 + c0 + cl; const f32x4 b0 = *(const f32x4*)p, b1 = *(const f32x4*)(p + 4); *(f32x4*)p = b0 + v0; *(f32x4*)(p + 4) = b1 + v1; } )
    }
};

template <class Epi>
__device__ __forceinline__ void run_gemm(LAS unsigned char* lds, const bf16* A, const bf16* Bt, int M, int N, int K, const Epi& E, const int tid_in) {
    int Kr = K; asm volatile("" : "+s"(Kr));
    pg8::Gemm g{A, Bt, M, N, Kr}; pg8::StaticOrder S; S.init(M, N, (int)gridDim.x, (int)blockIdx.x);
    pg8::gemm_phase<Epi, pg8::StaticOrder, true, true>(lds, g, S, E, tid_in);
}

__device__ __forceinline__ void rms_rows_bf16(const float* src, bf16* dst, const float* gain, int nvalid, int ntotal, int gw, int ngw, int lane) {
    for (int r = gw; r < ntotal; r += ngw) {
        u32x2* o8 = (u32x2*)(dst + (size_t)r * 1024) + lane;
        if (r >= nvalid) {
#pragma unroll
            for (int j = 0; j < 4; ++j) o8[64 * j] = (u32x2){0u, 0u};
            continue;
        }
        const f32x4* xr = (const f32x4*)(src + (size_t)r * 1024) + lane;
        f32x4 v[4]; float s = 0.f;
#pragma unroll
        for (int j = 0; j < 4; ++j) { v[j] = xr[64 * j]; s += (v[j][0] * v[j][0] + v[j][1] * v[j][1]) + (v[j][2] * v[j][2] + v[j][3] * v[j][3]); }
        const float rs = 1.0f / sqrtf(wave_sum(s) * (1.f / 1024.f) + EPSN);
#pragma unroll
        for (int j = 0; j < 4; ++j) { const f32x4 g = ((const f32x4*)gain)[lane + 64 * j]; const f32x4 o = v[j] * rs * g; o8[64 * j] = (u32x2){pk2(o[0], o[1]), pk2(o[2], o[3])}; }
    }
}
__device__ __forceinline__ void rms_rows_f32_inplace(float* y, const float* gain, int nvalid, int gw, int ngw, int lane) {
    for (int r = gw; r < nvalid; r += ngw) {
        f32x4* xr = (f32x4*)(y + (size_t)r * 1024) + lane;
        f32x4 v[4]; float s = 0.f;
#pragma unroll
        for (int j = 0; j < 4; ++j) { v[j] = xr[64 * j]; s += (v[j][0] * v[j][0] + v[j][1] * v[j][1]) + (v[j][2] * v[j][2] + v[j][3] * v[j][3]); }
        const float rs = 1.0f / sqrtf(wave_sum(s) * (1.f / 1024.f) + EPSN);
#pragma unroll
        for (int j = 0; j < 4; ++j) { const f32x4 g = ((const f32x4*)gain)[lane + 64 * j]; xr[64 * j] = v[j] * rs * g; }
    }
}
__device__ __forceinline__ void phase_small(const Grp& G, const float* gq, const float* gkv, const float* rope, int gw, int ngw, int lane) {
    const int ntotal = G.ntiles * 256;
    for (int r = gw; r < ntotal; r += ngw) {
        const float* z = G.ZS + (size_t)r * 768;
        const f32x4 cq = ((const f32x4*)z)[lane], ck = ((const f32x4*)(z + 256))[lane];
        const float s1 = wave_sum((cq[0] * cq[0] + cq[1] * cq[1]) + (cq[2] * cq[2] + cq[3] * cq[3]));
        const float s2 = wave_sum((ck[0] * ck[0] + ck[1] * ck[1]) + (ck[2] * ck[2] + ck[3] * ck[3]));
        const float r1 = 1.0f / sqrtf(s1 * (1.f / 256.f) + EPSN), r2 = 1.0f / sqrtf(s2 * (1.f / 256.f) + EPSN);
        const f32x4 o1 = cq * r1 * ((const f32x4*)gq)[lane], o2 = ck * r2 * ((const f32x4*)gkv)[lane];
        ((u32x2*)(G.CQ + (size_t)r * 256))[lane] = (u32x2){pk2(o1[0], o1[1]), pk2(o1[2], o1[3])};
        ((u32x2*)(G.CKV + (size_t)r * 256))[lane] = (u32x2){pk2(o2[0], o2[1]), pk2(o2[2], o2[3])};
        if (r < G.nvalid) ((f32x4*)(G.ockv + (size_t)r * 256))[lane] = o2;
        if (lane < 16) {
            const int pos = G.sample ? (PAST + (r & (ST - 1))) : (r & (TS - 1));
            const float x1 = z[512 + lane], x2 = z[512 + 16 + lane];
            const f32x2 cs = *(const f32x2*)(rope + (size_t)pos * 32 + 2 * lane);
            const float a = x1 * cs[0] - x2 * cs[1], b = x2 * cs[0] + x1 * cs[1];
            G.KR[(size_t)r * 32 + lane] = (bf16)f2bf(a); G.KR[(size_t)r * 32 + 16 + lane] = (bf16)f2bf(b);
            if (r < G.nvalid) { G.okr[(size_t)r * 32 + lane] = a; G.okr[(size_t)r * 32 + 16 + lane] = b; }
        }
    }
}

__device__ __forceinline__ void tr_item(const float* W, int K, int N, bf16* WT, int k0, int n0, int drow0, LAS float* scr, int lane) {
#pragma unroll 8
    for (int i = 0; i < 32; ++i) { const int kk = 2 * i + (lane >> 5); scr[kk * 33 + (lane & 31)] = W[(size_t)(k0 + kk) * N + n0 + (lane & 31)]; }
    asm volatile("s_waitcnt lgkmcnt(0)" ::: "memory");
    const int c = lane & 7;
#pragma unroll
    for (int j = 0; j < 4; ++j) { const int n = (lane >> 3) + 8 * j; const LAS float* s = scr + (8 * c) * 33 + n;
        u32x4 o; o.x = pk2(s[0 * 33], s[1 * 33]); o.y = pk2(s[2 * 33], s[3 * 33]); o.z = pk2(s[4 * 33], s[5 * 33]); o.w = pk2(s[6 * 33], s[7 * 33]);
        *(u32x4*)(WT + (size_t)(drow0 + n) * K + k0 + 8 * c) = o; }
    asm volatile("s_waitcnt lgkmcnt(0)" ::: "memory");
}
__device__ __forceinline__ int map_in(int n0) {
    if (n0 < 3616) return n0;
    if (n0 < 4640) return n0 - 3616 + 3840;
    return n0 - 4640 + 4864;
}
__device__ __forceinline__ int map_uq(int n0) { const int hh = n0 / 96, d0 = n0 % 96; return d0 < 64 ? hh * 64 + d0 : 1024 + hh * 32 + (d0 - 64); }
__device__ __forceinline__ void cvt8(const float* src, bf16* dst, size_t n8, size_t gt, size_t ngt) {
    for (size_t i = gt; i < n8; i += ngt) { const f32x4 a = ((const f32x4*)src)[2 * i], b = ((const f32x4*)src)[2 * i + 1];
        ((u32x4*)dst)[i] = (u32x4){pk2(a[0], a[1]), pk2(a[2], a[3]), pk2(b[0], b[1]), pk2(b[2], b[3])}; }
}
__device__ __forceinline__ void phase_prologue(const Args& a, LAS unsigned char* lds, int gw, int ngw, int lane, int wave) {
    unsigned char* ws = a.ws;
    LAS float* scr = (LAS float*)(lds + wave * 16384);
    constexpr int I_IN = 16 * 177, I_UQ = 4 * 48, I_UK = 4 * 32, I_UV = 4 * 32, I_O = 16 * 32, I_UP = 16 * 128, I_DN = 64 * 32;
    constexpr int NITEMS = I_IN + I_UQ + I_UK + I_UV + 3 * I_O + I_UP + I_DN;
    for (int it = gw; it < NITEMS; it += ngw) {
        int r = it;
        if (r < I_IN) { const int kb = r / 177, nb = r % 177; tr_item(a.in[8], 1024, 5664, (bf16*)(ws + WS_WIN), 64 * kb, 32 * nb, map_in(32 * nb), scr, lane); continue; } r -= I_IN;
        if (r < I_UQ) { const int kb = r / 48, nb = r % 48; tr_item(a.in[15], 256, 1536, (bf16*)(ws + WS_WUQ), 64 * kb, 32 * nb, map_uq(32 * nb), scr, lane); continue; } r -= I_UQ;
        if (r < I_UK) { const int kb = r / 32, nb = r % 32; tr_item(a.in[17], 256, 1024, (bf16*)(ws + WS_WUKV), 64 * kb, 32 * nb, 32 * nb, scr, lane); continue; } r -= I_UK;
        if (r < I_UV) { const int kb = r / 32, nb = r % 32; tr_item(a.in[18], 256, 1024, (bf16*)(ws + WS_WUKV), 64 * kb, 32 * nb, 1024 + 32 * nb, scr, lane); continue; } r -= I_UV;
        if (r < I_O) { const int kb = r / 32, nb = r % 32; tr_item(a.in[19], 1024, 1024, (bf16*)(ws + WS_WOD), 64 * kb, 32 * nb, 32 * nb, scr, lane); continue; } r -= I_O;
        if (r < I_O) { const int kb = r / 32, nb = r % 32; tr_item(a.in[20], 1024, 1024, (bf16*)(ws + WS_WOM), 64 * kb, 32 * nb, 32 * nb, scr, lane); continue; } r -= I_O;
        if (r < I_O) { const int kb = r / 32, nb = r % 32; tr_item(a.in[21], 1024, 1024, (bf16*)(ws + WS_WOUT), 64 * kb, 32 * nb, 32 * nb, scr, lane); continue; } r -= I_O;
        if (r < I_UP) { const int kb = r / 128, nb = r % 128; tr_item(a.in[23], 1024, 4096, (bf16*)(ws + WS_WUP), 64 * kb, 32 * nb, 32 * nb, scr, lane); continue; } r -= I_UP;
        { const int kb = r / 32, nb = r % 32; tr_item(a.in[24], 4096, 1024, (bf16*)(ws + WS_WDN), 64 * kb, 32 * nb, 32 * nb, scr, lane); }
    }
    const size_t gt = (size_t)gw * 64 + lane, ngt = (size_t)ngw * 64;
    { u32x4* z = (u32x4*)(ws + WS_WIN + (size_t)3616 * 2048); for (size_t i = gt; i < (size_t)224 * 128; i += ngt) z[i] = (u32x4){0u, 0u, 0u, 0u}; }
    unsigned char* cb = ws + WS_PROMPT;
    cvt8(a.in[2], (bf16*)(cb + C_KDC), (size_t)CACHE_ROWS * 128, gt, ngt);
    cvt8(a.in[3], (bf16*)(cb + C_VDC), (size_t)CACHE_ROWS * 128, gt, ngt);
    cvt8(a.in[4], (bf16*)(cb + C_CKVC), (size_t)CACHE_ROWS * 32, gt, ngt);
    cvt8(a.in[5], (bf16*)(cb + C_KRC), (size_t)CACHE_ROWS * 4, gt, ngt);
    float* tab = (float*)(ws + WS_TAB);
    for (size_t i = gt; i < 8 * 192; i += ngt) {
        const int h = (int)i / 192, idx = (int)i % 192, rel = idx - 128, n = rel < 0 ? -rel : rel;
        int bucket = n;
        if (n >= 8) { int j = (31 - __clz(n * n)) - 6; bucket = 8 + j; if (bucket > 15) bucket = 15; }
        if (rel > 0) bucket += 16;
        tab[i] = (a.in[6][bucket * 8 + h] - a.in[6][15 * 8 + h]) * LOG2E;
    }
    if (gt == 0) {
        float d1 = 0.f, d2 = 0.f;
        for (int i = 0; i < 64; ++i) { d1 += a.in[9][i] * a.in[10][i]; d2 += a.in[11][i] * a.in[12][i]; }
        tab[1536] = expf(d1) - expf(d2) + 0.2f;
    }
    float* rope = (float*)(ws + WS_ROPE);
    for (size_t i = gt; i < (size_t)(PAST + ST) * 16; i += ngt) {
        const int pos = (int)(i >> 4), k = (int)(i & 15);
        const float inv = __builtin_amdgcn_exp2f(-(float)k * 0.8304820237218406f);
        const float ang = (float)pos * inv;
        const double rev = (double)ang * 0.15915494309189535;
        const float fr = (float)(rev - __builtin_rint(rev));
        rope[2 * i] = __builtin_amdgcn_cosf(fr); rope[2 * i + 1] = __builtin_amdgcn_sinf(fr);
    }
}

#ifndef ATTMASK
#define ATTMASK 15
#endif
constexpr int AL_TAB = 0, AL_WSF = 6144, AL_TILE = 8192;

__device__ __forceinline__ int crow(int r, int hi) { return (r & 3) + 8 * (r >> 2) + 4 * hi; }
__device__ __forceinline__ float xmax32(float v) { auto rr = __builtin_amdgcn_permlane32_swap(__float_as_uint(v), __float_as_uint(v), false, false); return fmaxf(__uint_as_float(rr[0]), __uint_as_float(rr[1])); }
__device__ __forceinline__ float xsum32(float v) { auto rr = __builtin_amdgcn_permlane32_swap(__float_as_uint(v), __float_as_uint(v), false, false); return __uint_as_float(rr[0]) + __uint_as_float(rr[1]); }
typedef __bf16 bf16x2_t __attribute__((ext_vector_type(2)));
__device__ __forceinline__ unsigned cvtpk(float lo, float hi) { f32x2 v = {lo, hi}; bf16x2_t b = __builtin_convertvector(v, bf16x2_t); return __builtin_bit_cast(unsigned, b); }
__device__ __forceinline__ bf16x8 pack8(float a0, float a1, float a2, float a3, float a4, float a5, float a6, float a7) {
    u32x4 w = {cvtpk(a0, a1), cvtpk(a2, a3), cvtpk(a4, a5), cvtpk(a6, a7)}; return __builtin_bit_cast(bf16x8, w);
}
typedef short v4i16_t __attribute__((ext_vector_type(4)));
__device__ __forceinline__ s16x4 vtr(const LAS unsigned char* p) { return __builtin_bit_cast(s16x4, __builtin_amdgcn_ds_read_tr16_b64_v4i16((LAS v4i16_t*)p)); }

template <int DQK, int DV> struct AttnState { bf16x8 qf[DQK / 16]; f32x16 o[DV / 32]; f32x16 negm; float m, l; };
constexpr float ATT_THR = 8.0f;

template <int DQK, int DV, bool HAS_BIAS>
__device__ __forceinline__ void attn_tile(AttnState<DQK, DV>& st, const LAS unsigned char* Kt, const LAS unsigned char* Vt, int bias_mode, const LAS float* tab, int rel0, int nkeys, bool first, LAS float* wsf, int lane) {
    constexpr int PK = DQK * 2 + 16, PV = DV * 2 + 64, KS = DQK / 16, NDB = DV / 32;
    const int q = lane & 31, hi = lane >> 5;
    f32x16 p0, p1;
    const LAS unsigned char* kp = Kt + q * PK + hi * 16;
    bf16x8 ka[KS], kb[KS];
#pragma unroll
    for (int ks = 0; ks < KS; ++ks) { ka[ks] = *(const LAS bf16x8*)(kp + ks * 32); kb[ks] = *(const LAS bf16x8*)(kp + 32 * PK + ks * 32); }
    if (HAS_BIAS && bias_mode == 2) {
        asm volatile("" ::: "memory");
#pragma unroll
        for (int r = 0; r < 16; ++r) {
            const int k = crow(r, hi);
            const int i0 = min(max(rel0 + k + 128, 0), 191), i1 = min(max(rel0 + k + 160, 0), 191);
            p0[r] = tab[i0] + st.negm[r]; p1[r] = tab[i1] + st.negm[r];
        }
        p0 = __builtin_amdgcn_mfma_f32_32x32x16_bf16(ka[0], st.qf[0], p0, 0, 0, 0);
        p1 = __builtin_amdgcn_mfma_f32_32x32x16_bf16(kb[0], st.qf[0], p1, 0, 0, 0);
    } else {
        p0 = __builtin_amdgcn_mfma_f32_32x32x16_bf16(ka[0], st.qf[0], st.negm, 0, 0, 0);
        p1 = __builtin_amdgcn_mfma_f32_32x32x16_bf16(kb[0], st.qf[0], st.negm, 0, 0, 0);
    }
#pragma unroll
    for (int ks = 1; ks < KS; ++ks) {
        p0 = __builtin_amdgcn_mfma_f32_32x32x16_bf16(ka[ks], st.qf[ks], p0, 0, 0, 0);
        p1 = __builtin_amdgcn_mfma_f32_32x32x16_bf16(kb[ks], st.qf[ks], p1, 0, 0, 0);
    }
    const int q4 = (lane & 15) >> 2, blk = (lane >> 4) & 1, pp = lane & 3;
    const LAS unsigned char* vp = Vt + (4 * hi + q4) * PV + (16 * blk + 4 * pp) * 2;
    s16x4 vlo[2][4], vhi[2][4];
#pragma unroll
    for (int s4 = 0; s4 < 4; ++s4) { vlo[0][s4] = vtr(vp + (16 * s4) * PV); vhi[0][s4] = vtr(vp + (16 * s4 + 8) * PV); }
    __builtin_amdgcn_sched_barrier(0);
    if (nkeys < 64) {
#pragma unroll
        for (int r = 0; r < 16; ++r) { const int k = crow(r, hi); if (k >= nkeys) p0[r] = -1e30f; if (k + 32 >= nkeys) p1[r] = -1e30f; }
    }
    float mxa = __builtin_fmaxf(__builtin_fmaxf(p0[0], p0[1]), p1[0]), mxb = __builtin_fmaxf(__builtin_fmaxf(p0[2], p0[3]), p1[1]);
    mxa = __builtin_fmaxf(__builtin_fmaxf(mxa, p1[2]), p1[3]);
#pragma unroll
    for (int r = 4; r < 16; r += 4) {
        mxa = __builtin_fmaxf(__builtin_fmaxf(mxa, p0[r]), p0[r + 1]); mxb = __builtin_fmaxf(__builtin_fmaxf(mxb, p0[r + 2]), p0[r + 3]);
        mxa = __builtin_fmaxf(__builtin_fmaxf(mxa, p1[r]), p1[r + 1]); mxb = __builtin_fmaxf(__builtin_fmaxf(mxb, p1[r + 2]), p1[r + 3]);
    }
    const float mx = xmax32(__builtin_fmaxf(mxa, mxb));
    if (first || __any(mx > ATT_THR)) {
        const float dl = first ? mx : __builtin_fmaxf(mx, 0.f);
        st.m += dl;
#pragma unroll
        for (int r = 0; r < 16; ++r) { st.negm[r] = -st.m; p0[r] -= dl; p1[r] -= dl; }
        const float f = __builtin_amdgcn_exp2f(-dl);
        st.l *= f;
        if (hi == 0) wsf[q] = f;
#pragma unroll
        for (int r = 0; r < 16; ++r) { const float fr = wsf[crow(r, hi)];
#pragma unroll
            for (int db = 0; db < NDB; ++db) st.o[db][r] *= fr; }
    }
    float sum0 = 0.f, sum1 = 0.f;
#pragma unroll
    for (int r = 0; r < 16; ++r) { p0[r] = __builtin_amdgcn_exp2f(p0[r]); p1[r] = __builtin_amdgcn_exp2f(p1[r]); sum0 += p0[r]; sum1 += p1[r]; }
    st.l += sum0 + sum1;
    bf16x8 pf[4];
    pf[0] = pack8(p0[0], p0[1], p0[2], p0[3], p0[4], p0[5], p0[6], p0[7]);
    pf[1] = pack8(p0[8], p0[9], p0[10], p0[11], p0[12], p0[13], p0[14], p0[15]);
    pf[2] = pack8(p1[0], p1[1], p1[2], p1[3], p1[4], p1[5], p1[6], p1[7]);
    pf[3] = pack8(p1[8], p1[9], p1[10], p1[11], p1[12], p1[13], p1[14], p1[15]);
    __builtin_amdgcn_sched_barrier(0);
#pragma unroll
    for (int db = 0; db < NDB; ++db) {
        if (db + 1 < NDB) {
#pragma unroll
            for (int s4 = 0; s4 < 4; ++s4) { vlo[(db + 1) & 1][s4] = vtr(vp + (16 * s4) * PV + (db + 1) * 64); vhi[(db + 1) & 1][s4] = vtr(vp + (16 * s4 + 8) * PV + (db + 1) * 64); }
        }
#pragma unroll
        for (int s4 = 0; s4 < 4; ++s4) {
            const s16x4 lo = vlo[db & 1][s4], h4 = vhi[db & 1][s4];
            const bf16x8 vb = {lo[0], lo[1], lo[2], lo[3], h4[0], h4[1], h4[2], h4[3]};
            st.o[db] = __builtin_amdgcn_mfma_f32_32x32x16_bf16(pf[s4], vb, st.o[db], 0, 0, 0);
        }
        __builtin_amdgcn_sched_barrier(0);
    }
}

template <int DQK, int DV>
__device__ __forceinline__ void attn_init(AttnState<DQK, DV>& st) {
    st.m = 0.f; st.l = 0.f;
#pragma unroll
    for (int r = 0; r < 16; ++r) st.negm[r] = 0.f;
#pragma unroll
    for (int db = 0; db < DV / 32; ++db)
#pragma unroll
        for (int r = 0; r < 16; ++r) st.o[db][r] = 0.f;
}

template <bool DIFF>
__device__ __forceinline__ void attn_unit_coop(const Grp& G, int b, int h, int qb, int n, LAS unsigned char* lds, const int tid_in) {
    constexpr int DQK = DIFF ? 64 : 96, DV = DIFF ? 128 : 64, PK = DQK * 2 + 16, PV = DV * 2 + 64, KB = 64 * PK, VB = 64 * PV, TB = KB + VB, NDB = DV / 32;
    int tid_ = tid_in; asm volatile("" : "+v"(tid_));
    const int tid = tid_, lane = tid & 63, wid = __builtin_amdgcn_readfirstlane(tid >> 6), q = lane & 31, hi = lane >> 5;
    const size_t seq0 = (size_t)b * TS;
    const int qrow0 = qb * 256 + wid * 32;
    const int NT = 4 * qb + 4, my_nt = 4 * qb + (wid >> 1) + 1;
    const LAS float* tab = (const LAS float*)(lds + AL_TAB) + h * 192;
    LAS float* wsf = (LAS float*)(lds + AL_WSF) + wid * 64;
    LAS unsigned char* tiles = lds + AL_TILE;
    {
        AttnState<DQK, DV> st; attn_init(st);
        if (DIFF) { const bf16* qp = G.QD + (seq0 + qrow0 + q) * 1024 + h * 128 + n * 64 + hi * 8;
#pragma unroll
            for (int ks = 0; ks < 4; ++ks) st.qf[ks] = *(const bf16x8*)(qp + ks * 16);
        } else { const bf16* qn = G.QN + (seq0 + qrow0 + q) * 1024 + h * 64 + hi * 8; const bf16* qr = G.QR + (seq0 + qrow0 + q) * 512 + h * 32 + hi * 8;
#pragma unroll
            for (int ks = 0; ks < 4; ++ks) st.qf[ks] = *(const bf16x8*)(qn + ks * 16);
#pragma unroll
            for (int ks = 0; ks < 2; ++ks) st.qf[4 + ks] = *(const bf16x8*)(qr + ks * 16);
        }
        const bf16* ksrc = (DIFF ? G.KD + h * 128 + n * 64 : G.KN + h * 64) + (seq0 + (tid >> 3)) * 1024 + (tid & 7) * 8;
        const int kdst = (tid >> 3) * PK + (tid & 7) * 16;
        const bf16* k2src = G.KR + (seq0 + ((tid & 255) >> 2)) * 32 + (tid & 3) * 8;
        const int k2dst = ((tid & 255) >> 2) * PK + 128 + (tid & 3) * 16;
        const bf16* vsrc = DIFF ? G.VD + (seq0 + (tid >> 4)) * 1024 + h * 128 + (tid & 15) * 8 : G.VM + (seq0 + (tid >> 3)) * 1024 + h * 64 + (tid & 7) * 8;
        const int vdst = DIFF ? KB + (tid >> 4) * PV + (tid & 15) * 16 : KB + (tid >> 3) * PV + (tid & 7) * 16;
        u32x4 rkA, rk2A = {0u, 0u, 0u, 0u}, rv0A, rv1A = {0u, 0u, 0u, 0u}, rkB = {0u, 0u, 0u, 0u}, rk2B = {0u, 0u, 0u, 0u}, rv0B = {0u, 0u, 0u, 0u}, rv1B = {0u, 0u, 0u, 0u};
#define ATT_LOAD(S, j) do { rk##S = *(const u32x4*)(ksrc + (size_t)(j) * 64 * 1024); if (!DIFF && tid < 256) rk2##S = *(const u32x4*)(k2src + (size_t)(j) * 64 * 32); \
        rv0##S = *(const u32x4*)(vsrc + (size_t)(j) * 64 * 1024); if (DIFF) rv1##S = *(const u32x4*)(vsrc + (size_t)(j) * 64 * 1024 + 32 * 1024); } while (0)
#define ATT_STORE(S, bufp) do { *(LAS u32x4*)((bufp) + kdst) = rk##S; if (!DIFF && tid < 256) *(LAS u32x4*)((bufp) + k2dst) = rk2##S; \
        *(LAS u32x4*)((bufp) + vdst) = rv0##S; if (DIFF) *(LAS u32x4*)((bufp) + vdst + 32 * PV) = rv1##S; } while (0)
#define ATT_COMPUTE(j, bufp) do { if ((j) < my_nt) { const int kb_ = 64 * (j); const int mode_ = DIFF ? ((kb_ + 63 - qrow0 <= -128) ? 1 : 2) : 0; \
        attn_tile<DQK, DV, DIFF>(st, (bufp), (bufp) + KB, mode_, tab, kb_ - (qrow0 + q), 64, (j) == 0, wsf, lane); } } while (0)
        ATT_LOAD(A, 0); ATT_STORE(A, tiles);
        __syncthreads();
        ATT_LOAD(A, 1);
        for (int j = 0; j < NT; j += 2) {
            LAS unsigned char* b0 = tiles + (j & 1) * TB; LAS unsigned char* b1 = tiles + ((j + 1) & 1) * TB;
            if (j + 2 < NT) ATT_LOAD(B, j + 2);
            ATT_COMPUTE(j, b0);
            ATT_STORE(A, b1);
            __syncthreads();
            if (j + 3 < NT) ATT_LOAD(A, j + 3);
            ATT_COMPUTE(j + 1, b1);
            if (j + 2 < NT) ATT_STORE(B, b0);
            __syncthreads();
        }
#undef ATT_LOAD
#undef ATT_STORE
#undef ATT_COMPUTE
        const float lt = xsum32(st.l);
        if (hi == 0) wsf[32 + q] = lt;
        float inv[16];
#pragma unroll
        for (int r = 0; r < 16; ++r) inv[r] = 1.0f / wsf[32 + crow(r, hi)];
        bf16* obase = (DIFF ? (n == 0 ? G.DO : G.XN) + h * 128 : G.MO + h * 64) + (seq0 + qrow0) * 1024 + q;
#pragma unroll
        for (int db = 0; db < NDB; ++db)
#pragma unroll
            for (int r = 0; r < 16; ++r) obase[(size_t)crow(r, hi) * 1024 + db * 32] = (bf16)f2bf(st.o[db][r] * inv[r]);
    }
}

__device__ __forceinline__ void phase_diffmix(const Grp& G, float lam, const float* subln, int gw, int ngw, int lane) {
    const int c = (lane & 7) * 16;
    float g[16];
#pragma unroll
    for (int i = 0; i < 16; ++i) g[i] = subln[c + i] * 0.8f;
    for (int r = gw; r < G.nvalid; r += ngw) {
        bf16* p1 = G.DO + (size_t)r * 1024 + lane * 16; const bf16* p2 = G.XN + (size_t)r * 1024 + lane * 16;
        const u32x4 a0 = ((const u32x4*)p1)[0], a1 = ((const u32x4*)p1)[1], b0 = ((const u32x4*)p2)[0], b1 = ((const u32x4*)p2)[1];
        float v[16];
#pragma unroll
        for (int i = 0; i < 4; ++i) { v[2 * i] = bflo(a0[i]) - lam * bflo(b0[i]); v[2 * i + 1] = bfhi(a0[i]) - lam * bfhi(b0[i]);
                                      v[8 + 2 * i] = bflo(a1[i]) - lam * bflo(b1[i]); v[8 + 2 * i + 1] = bfhi(a1[i]) - lam * bfhi(b1[i]); }
        float s = 0.f;
#pragma unroll
        for (int i = 0; i < 16; ++i) s += v[i] * v[i];
        s += swz_xor<1>(s); s += swz_xor<2>(s); s += swz_xor<4>(s);
        const float rs = 1.0f / sqrtf(s * (1.f / 128.f) + EPSN);
        u32x4 o0, o1;
#pragma unroll
        for (int i = 0; i < 4; ++i) { o0[i] = pk2(v[2 * i] * rs * g[2 * i], v[2 * i + 1] * rs * g[2 * i + 1]); o1[i] = pk2(v[8 + 2 * i] * rs * g[8 + 2 * i], v[8 + 2 * i + 1] * rs * g[8 + 2 * i + 1]); }
        ((u32x4*)p1)[0] = o0; ((u32x4*)p1)[1] = o1;
    }
}

template <bool DIFF>
__device__ __forceinline__ void attn_unit_wave(const Grp& G, const unsigned char* cb, int b, int h, int n, int j0, int j1, int wu, float* PO, float* PM, float* PL,
                                               LAS unsigned char* wt, LAS float* wsf, const LAS float* tab0, int lane_in) {
    int lane = lane_in; asm volatile("" : "+v"(lane)); lane &= 63;
    constexpr int DQK = DIFF ? 64 : 96, DV = DIFF ? 128 : 64, PK = DQK * 2 + 16, PV = DV * 2 + 64, KB = 64 * PK, NDB = DV / 32;
    const int q = lane & 31, hi = lane >> 5;
    const LAS float* tab = tab0 + h * 192;
    AttnState<DQK, DV> st; attn_init(st);
    const size_t qrow = (size_t)b * ST + q;
    if (DIFF) { const bf16* qp = G.QD + qrow * 1024 + h * 128 + n * 64 + hi * 8;
#pragma unroll
        for (int ks = 0; ks < 4; ++ks) st.qf[ks] = *(const bf16x8*)(qp + ks * 16);
    } else { const bf16* qn = G.QN + qrow * 1024 + h * 64 + hi * 8; const bf16* qr = G.QR + qrow * 512 + h * 32 + hi * 8;
#pragma unroll
        for (int ks = 0; ks < 4; ++ks) st.qf[ks] = *(const bf16x8*)(qn + ks * 16);
#pragma unroll
        for (int ks = 0; ks < 2; ++ks) st.qf[4 + ks] = *(const bf16x8*)(qr + ks * 16);
    }
    for (int j = j0; j < j1; ++j) {
        const bf16 *kA, *kB2, *vA; int nkeys;
        if (j < 64) { const size_t r0 = (size_t)b * PAST + 64 * j; nkeys = 64;
            kA = DIFF ? (const bf16*)(cb + C_KDC) + r0 * 1024 + h * 128 + n * 64 : (const bf16*)(cb + C_KNC) + r0 * 1024 + h * 64;
            kB2 = (const bf16*)(cb + C_KRC) + r0 * 32;
            vA = DIFF ? (const bf16*)(cb + C_VDC) + r0 * 1024 + h * 128 : (const bf16*)(cb + C_VMC) + r0 * 1024 + h * 64;
        } else { const size_t r0 = (size_t)b * ST; nkeys = ST;
            kA = DIFF ? G.KD + r0 * 1024 + h * 128 + n * 64 : G.KN + r0 * 1024 + h * 64;
            kB2 = G.KR + r0 * 32;
            vA = DIFF ? G.VD + r0 * 1024 + h * 128 : G.VM + r0 * 1024 + h * 64;
        }
        { u32x4 t[8];
#pragma unroll
            for (int i = 0; i < 8; ++i) { const int idx = lane + 64 * i; t[i] = *(const u32x4*)(kA + (size_t)(idx >> 3) * 1024 + (idx & 7) * 8); }
#pragma unroll
            for (int i = 0; i < 8; ++i) { const int idx = lane + 64 * i; *(LAS u32x4*)(wt + (idx >> 3) * PK + (idx & 7) * 16) = t[i]; } }
        if (!DIFF) { u32x4 t[4];
#pragma unroll
            for (int i = 0; i < 4; ++i) { const int idx = lane + 64 * i; t[i] = *(const u32x4*)(kB2 + (size_t)(idx >> 2) * 32 + (idx & 3) * 8); }
#pragma unroll
            for (int i = 0; i < 4; ++i) { const int idx = lane + 64 * i; *(LAS u32x4*)(wt + (idx >> 2) * PK + 128 + (idx & 3) * 16) = t[i]; } }
        if (DIFF) {
#pragma unroll
            for (int hf = 0; hf < 2; ++hf) { u32x4 t[8];
#pragma unroll
                for (int i = 0; i < 8; ++i) { const int idx = lane + 64 * i + 512 * hf; t[i] = *(const u32x4*)(vA + (size_t)(idx >> 4) * 1024 + (idx & 15) * 8); }
#pragma unroll
                for (int i = 0; i < 8; ++i) { const int idx = lane + 64 * i + 512 * hf; *(LAS u32x4*)(wt + KB + (idx >> 4) * PV + (idx & 15) * 16) = t[i]; } }
        } else { u32x4 t[8];
#pragma unroll
            for (int i = 0; i < 8; ++i) { const int idx = lane + 64 * i; t[i] = *(const u32x4*)(vA + (size_t)(idx >> 3) * 1024 + (idx & 7) * 8); }
#pragma unroll
            for (int i = 0; i < 8; ++i) { const int idx = lane + 64 * i; *(LAS u32x4*)(wt + KB + (idx >> 3) * PV + (idx & 7) * 16) = t[i]; } }
        const int kb = 64 * j;
        const int mode = DIFF ? ((j <= 61) ? 1 : 2) : 0;
        attn_tile<DQK, DV, DIFF>(st, wt, wt + KB, mode, tab, kb - (PAST + q), nkeys, j == j0, wsf, lane);
    }
    const float lt = xsum32(st.l);
    if (hi == 0) { PM[wu * 32 + q] = st.m; PL[wu * 32 + q] = lt; }
#pragma unroll
    for (int db = 0; db < NDB; ++db)
#pragma unroll
        for (int r = 0; r < 16; ++r) PO[((size_t)wu * 32 + crow(r, hi)) * DV + db * 32 + q] = st.o[db][r];
}

__device__ __forceinline__ void phase_combine(const Grp& G, const float* POd, const float* POm, const float* PM, const float* PL, float lam, const float* subln, int gw, int ngw, int lane) {
    for (int it = gw; it < SB * 8 * ST + SB * 16 * ST; it += ngw) {
        if (it < SB * 8 * ST) {
            const int qq = it & 15, h = (it >> 4) & 7, b = it >> 7;
            float val[2] = {0.f, 0.f};
#pragma unroll
            for (int n = 0; n < 2; ++n) {
                const int wu0 = ((b * 8 + h) * 2 + n) * NSPLIT;
                float M = -1e30f;
#pragma unroll
                for (int s = 0; s < NSPLIT; ++s) M = fmaxf(M, PM[(wu0 + s) * 32 + qq]);
                float L = 0.f, a0 = 0.f, a1 = 0.f;
#pragma unroll
                for (int s = 0; s < NSPLIT; ++s) { const float w = __builtin_amdgcn_exp2f(PM[(wu0 + s) * 32 + qq] - M); L += PL[(wu0 + s) * 32 + qq] * w;
                    const float* po = POd + ((size_t)(wu0 + s) * 32 + qq) * 128; a0 += po[lane] * w; a1 += po[lane + 64] * w; }
                const float sc = (n == 0 ? 1.f : -lam) / L;
                val[0] += a0 * sc; val[1] += a1 * sc;
            }
            const float ss = wave_sum(val[0] * val[0] + val[1] * val[1]);
            const float rs = 0.8f / sqrtf(ss * (1.f / 128.f) + EPSN);
            bf16* o = G.DO + (size_t)(b * ST + qq) * 1024 + h * 128;
            o[lane] = (bf16)f2bf(val[0] * rs * subln[lane]); o[lane + 64] = (bf16)f2bf(val[1] * rs * subln[lane + 64]);
        } else {
            const int i2 = it - SB * 8 * ST; const int qq = i2 & 15, h = (i2 >> 4) & 15, b = i2 >> 8;
            const int wu0 = 512 + (b * 16 + h) * NSPLIT;
            float M = -1e30f;
#pragma unroll
            for (int s = 0; s < NSPLIT; ++s) M = fmaxf(M, PM[(wu0 + s) * 32 + qq]);
            float L = 0.f, a0 = 0.f;
#pragma unroll
            for (int s = 0; s < NSPLIT; ++s) { const float w = __builtin_amdgcn_exp2f(PM[(wu0 + s) * 32 + qq] - M); L += PL[(wu0 + s) * 32 + qq] * w;
                a0 += POm[((size_t)(wu0 - 512 + s) * 32 + qq) * 64 + lane] * w; }
            G.MO[(size_t)(b * ST + qq) * 1024 + h * 64 + lane] = (bf16)f2bf(a0 / L);
        }
    }
}

__device__ __forceinline__ void phase_attention(const Args& a, const Grp& G, LAS unsigned char* lds, const int tid_in) {
    int tid_ = tid_in; asm volatile("" : "+v"(tid_));
    const int tid = tid_, lane = tid & 63, wid = __builtin_amdgcn_readfirstlane(tid >> 6);
    const float* tabg = (const float*)(a.ws + WS_TAB);
    for (int i = tid; i < 8 * 192; i += 512) ((LAS float*)(lds + AL_TAB))[i] = tabg[i];
    const float lam = tabg[1536];
    const float* subln = a.in[13];
    __syncthreads();
    if (G.sample) {
        if (wid < 4) {
            constexpr int TBD = 64 * (64 * 2 + 16) + 64 * (128 * 2 + 64);
            LAS unsigned char* wt = lds + AL_TILE + wid * TBD;
            LAS float* wsf = (LAS float*)(lds + AL_WSF) + wid * 64;
            const LAS float* tab0 = (const LAS float*)(lds + AL_TAB);
            const unsigned char* cb = a.ws + WS_PROMPT;
            for (int wu = (int)blockIdx.x * 4 + wid; wu < 1024; wu += (int)gridDim.x * 4) {
                const int s = wu & 3; const int j0 = s == 0 ? 0 : 17 + 16 * (s - 1), j1 = 17 + 16 * s;
                if (wu < 512) {
#if ATTMASK & 1
 const int n = (wu >> 2) & 1, h = (wu >> 3) & 7, b = wu >> 6;
                    attn_unit_wave<true>(G, cb, b, h, n, j0, j1, wu, (float*)(a.ws + WS_PO_D), (float*)(a.ws + WS_PM), (float*)(a.ws + WS_PL), wt, wsf, tab0, tid);
#endif
                } else {
#if ATTMASK & 2
 const int i2 = wu - 512; const int h = (i2 >> 2) & 15, b = i2 >> 6;
                    attn_unit_wave<false>(G, cb, b, h, 0, j0, j1, wu, (float*)(a.ws + WS_PO_M) - (size_t)512 * 32 * 64, (float*)(a.ws + WS_PM), (float*)(a.ws + WS_PL), wt, wsf, tab0, tid);
#endif
                }
            }
        }
    } else {
        const int Gn = (int)gridDim.x, bx = (int)blockIdx.x;
        const int vcu = (Gn % 8 == 0) ? (bx % 8) * (Gn / 8) + bx / 8 : bx;
        for (int v = vcu; v < 256; v += Gn) {
            const int p = v & 3;
#if ATTMASK & 4
            for (int r = 0; r < GBATCH * 8 / 64; ++r) { const int bh = r * 64 + (v >> 2), b = bh >> 3, h = bh & 7;
                for (int n = 0; n < 2; ++n)
                    for (int i = 0; i < 2; ++i) attn_unit_coop<true>(G, b, h, i ? p : 7 - p, n, lds, tid_in); }
#endif
#if ATTMASK & 8
            for (int r = 0; r < GBATCH * 16 / 64; ++r) { const int bh = r * 64 + (v >> 2), b = bh >> 4, h = bh & 15;
                for (int i = 0; i < 2; ++i) attn_unit_coop<false>(G, b, h, i ? p : 7 - p, 0, lds, tid_in); }
#endif
        }
    }
}

constexpr int LDS_BYTES = 147456;
#ifndef PHMASK
#define PHMASK 0xffff
#endif

#define XB_TMO      128
#define XB_XCNT(j)  (256  + 64 * (j))
#define XB_XSUB(j)  (1280 + 64 * (j))
#define XB_XGEN(j)  (2304 + 64 * (j))
#define XB_TOP      3328
#define XB_TOPGEN   3392
#define XCD_BAR_WORDS 3456
#define XB_SPIN_CAP (1u << 18)

__device__ __forceinline__ unsigned xb_ld(unsigned* p)              { return __hip_atomic_load(p, __ATOMIC_RELAXED, __HIP_MEMORY_SCOPE_AGENT); }
__device__ __forceinline__ unsigned xb_add(unsigned* p, unsigned v) { return __hip_atomic_fetch_add(p, v, __ATOMIC_RELAXED, __HIP_MEMORY_SCOPE_AGENT); }
__device__ __forceinline__ unsigned xb_xcc_id() { return (unsigned)__builtin_amdgcn_s_getreg((3 << 11) | 20) & 0xFu; }
#define XB_SPIN(cond, bar) do { unsigned _sp = 0; while (cond) { __builtin_amdgcn_s_sleep(1); \
    if ((++_sp & 255u) == 0u) { if (xb_ld(&(bar)[XB_TMO])) break; if (_sp > XB_SPIN_CAP) { atomicAdd(&(bar)[XB_TMO], 1u); break; } } } } while (0)

struct XcdBarrier {
    unsigned* bar; unsigned x;
    volatile LAS unsigned* st;
};

__device__ __forceinline__ XcdBarrier xcd_barrier_post(unsigned* bar, volatile LAS unsigned* st) {
    XcdBarrier b; b.bar = bar; b.x = xb_xcc_id(); b.st = st;
    if (threadIdx.x == 0) (void)xb_add(&bar[XB_XCNT(b.x)], 1u);
    return b;
}
__device__ __forceinline__ void xcd_barrier_complete(unsigned* bar, unsigned x, unsigned& nloc, unsigned& nx) {
    const unsigned G = gridDim.x * gridDim.y * gridDim.z;
    unsigned sum, cnt, mine, sp = 0u;
    for (;;) {
        sum = 0u; cnt = 0u; mine = 0u;
#pragma unroll
        for (unsigned j = 0; j < 16; ++j) { const unsigned c = xb_ld(&bar[XB_XCNT(j)]); sum += c; cnt += (c > 0u) ? 1u : 0u; mine = (j == x) ? c : mine; }
        if (sum == G) break;
        __builtin_amdgcn_s_sleep(1);
        if ((++sp & 255u) == 0u) { if (xb_ld(&bar[XB_TMO])) break; if (sp > XB_SPIN_CAP) { atomicAdd(&bar[XB_TMO], 1u); break; } }
    }
    nloc = mine > 0u ? mine : 1u; nx = cnt > 0u ? cnt : 1u;
}

__device__ __forceinline__ void xcd_barrier(const XcdBarrier& b, const bool is_t0) {
    asm volatile("s_waitcnt vmcnt(0)" ::: "memory");
    __syncthreads();
    if (is_t0) {
        unsigned* bar = b.bar;
        __builtin_amdgcn_s_waitcnt(0);
        unsigned nloc = b.st[0], nx = b.st[1];
        if (nloc == 0u) { xcd_barrier_complete(bar, b.x, nloc, nx); b.st[0] = nloc; b.st[1] = nx; }
        const unsigned old = xb_add(&bar[XB_XSUB(b.x)], 1u);
        const unsigned gen = old / nloc;
        if (old + 1u == (gen + 1u) * nloc) {
            __builtin_amdgcn_fence(__ATOMIC_RELEASE, "agent");
            asm volatile("s_waitcnt vmcnt(0)" ::: "memory");
            const unsigned og = xb_add(&bar[XB_TOP], 1u);
            const unsigned tg = og / nx;
            if (og + 1u == (tg + 1u) * nx) xb_add(&bar[XB_TOPGEN], 1u);
            else XB_SPIN(xb_ld(&bar[XB_TOPGEN]) == tg, bar);
            __builtin_amdgcn_fence(__ATOMIC_ACQUIRE, "agent");
            xb_add(&bar[XB_XGEN(b.x)], 1u);
            asm volatile("s_waitcnt vmcnt(0)" ::: "memory");
        } else {
            XB_SPIN(xb_ld(&bar[XB_XGEN(b.x)]) == gen, bar);
            __builtin_amdgcn_fence(__ATOMIC_ACQUIRE, "agent");
            asm volatile("s_waitcnt vmcnt(0)" ::: "memory");
        }
    }
    __syncthreads();
}

constexpr size_t WS_BAR = 786432;
constexpr int LDS_BARST = 131072 + 512;
constexpr int LDS_PTAB = 131072;
__device__ __forceinline__ const void* lds_ptr(LAS const unsigned long long* pt, int i) {
    const unsigned long long v = pt[i];
    const unsigned lo = __builtin_amdgcn_readfirstlane((unsigned)v), hi = __builtin_amdgcn_readfirstlane((unsigned)(v >> 32));
    return (const void*)(const __attribute__((address_space(1))) void*)(((unsigned long long)hi << 32) | lo);
}
__device__ __forceinline__ Args load_args(LAS unsigned char* lds) {
    int z = 0; asm volatile("" : "+s"(z));
    LAS const unsigned long long* pt = (LAS const unsigned long long*)(lds + LDS_PTAB + z);
    Args a;
#pragma unroll
    for (int i = 0; i < 26; ++i) a.in[i] = (const float*)lds_ptr(pt, i);
    a.out = (float*)lds_ptr(pt, 26); a.ws = (unsigned char*)lds_ptr(pt, 27); a.pad0 = 0; a.pad1 = 0;
    return a;
}
__global__ void __launch_bounds__(512, 2) fwd_megakernel(Args ka) {
    extern __shared__ __attribute__((aligned(16))) unsigned char lds_raw[];
    LAS unsigned char* lds = (LAS unsigned char*)lds_raw;
    cg::grid_group grid = cg::this_grid();
    if (threadIdx.x == 0) {
        LAS unsigned long long* pt = (LAS unsigned long long*)(lds + LDS_PTAB);
#pragma unroll
        for (int i = 0; i < 26; ++i) pt[i] = (unsigned long long)ka.in[i];
        pt[26] = (unsigned long long)ka.out; pt[27] = (unsigned long long)ka.ws;
    }
    if (threadIdx.x == 0) { ((LAS unsigned*)(lds + LDS_BARST))[0] = 0u; ((LAS unsigned*)(lds + LDS_BARST))[1] = 0u; }
    __syncthreads();
    const int s_wave = __builtin_amdgcn_readfirstlane((int)threadIdx.x >> 6);
    (void)xcd_barrier_post((unsigned*)(ka.ws + WS_BAR), (volatile LAS unsigned*)(lds + LDS_BARST));
#if PHMASK & 1
    { const int tid = threadIdx.x, lane = tid & 63, wave = __builtin_amdgcn_readfirstlane(tid >> 6); const Args a = load_args(lds);
      phase_prologue(a, lds, (int)blockIdx.x * 8 + wave, (int)gridDim.x * 8, lane, wave); }
#endif
    grid.sync();

#define GBAR() do { int z_ = 0; asm volatile("" : "+s"(z_)); XcdBarrier b_; b_.bar = (unsigned*)((unsigned char*)lds_ptr((LAS const unsigned long long*)(lds + LDS_PTAB + z_), 27) + WS_BAR); \
    b_.x = xb_xcc_id(); b_.st = (volatile LAS unsigned*)(lds + LDS_BARST + z_); xcd_barrier(b_, s_wave == 0 && __builtin_amdgcn_mbcnt_hi(~0u, __builtin_amdgcn_mbcnt_lo(~0u, (unsigned)z_)) == 0u); } while (0)
#define PH_BEGIN int w_ = s_wave, g_ = g; asm volatile("" : "+s"(w_), "+s"(g_)); int zz_ = 0; asm volatile("" : "+s"(zz_)); int lane_ = (int)__builtin_amdgcn_mbcnt_hi(~0u, __builtin_amdgcn_mbcnt_lo(~0u, (unsigned)zz_)); asm volatile("" : "+v"(lane_)); const int lane = lane_, wave = w_, tid_ = w_ * 64 + lane; (void)tid_; \
    const int gw = (int)blockIdx.x * 8 + wave, ngw = (int)gridDim.x * 8; const Args a = load_args(lds); unsigned char* ws = a.ws; const float* rope = (const float*)(ws + WS_ROPE); (void)rope; const Grp G = make_grp(a, g_); const int M = G.ntiles * 256; (void)lane; (void)gw; (void)ngw; (void)M;
#pragma unroll 1
    for (int g = 0; g < NGRP; ++g) {
        { PH_BEGIN rms_rows_bf16(G.x, G.XN, a.in[7], G.nvalid, M, gw, ngw, lane); }
        GBAR();
#if PHMASK & 2
        { PH_BEGIN EpiIn E{G.QD, G.KD, G.VD, G.GD, G.GM, G.ZS, G.okd, G.ovd, G.nvalid, 0.125f * LOG2E};
          run_gemm(lds, G.XN, (const bf16*)(ws + WS_WIN), M, NIN, 1024, E, tid_); }
#endif
        GBAR();
        { PH_BEGIN phase_small(G, a.in[14], a.in[16], rope, gw, ngw, lane); }
        GBAR();
#if PHMASK & 4
        { PH_BEGIN EpiQ E{G.QN, G.QR, rope, G.sample, 0.10206207261596575f * LOG2E};
          run_gemm(lds, G.CQ, (const bf16*)(ws + WS_WUQ), M, 1536, 256, E, tid_); }
#endif
#if PHMASK & 8
        { PH_BEGIN EpiKV E{G.KN, G.VM};
          run_gemm(lds, G.CKV, (const bf16*)(ws + WS_WUKV), M, 2048, 256, E, tid_); }
        if (g == 0) { PH_BEGIN EpiKV E{(bf16*)(ws + WS_PROMPT + C_KNC), (bf16*)(ws + WS_PROMPT + C_VMC)};
          run_gemm(lds, (const bf16*)(ws + WS_PROMPT + C_CKVC), (const bf16*)(ws + WS_WUKV), CACHE_ROWS, 2048, 256, E, tid_); }
#endif
        GBAR();
#if PHMASK & 16
        { PH_BEGIN phase_attention(a, G, lds, tid_); }
#endif
        GBAR();
        if (g != 0) {
            { PH_BEGIN phase_diffmix(G, ((const float*)(ws + WS_TAB))[1536], a.in[13], gw, ngw, lane); }
            GBAR();
        }
        if (g == 0) {
            { PH_BEGIN phase_combine(G, (const float*)(ws + WS_PO_D), (const float*)(ws + WS_PO_M), (const float*)(ws + WS_PM), (const float*)(ws + WS_PL), ((const float*)(ws + WS_TAB))[1536], a.in[13], gw, ngw, lane); }
            GBAR();
        }
#if PHMASK & 32
        { PH_BEGIN EpiM1 E{G.GD, G.XN}; run_gemm(lds, G.DO, (const bf16*)(ws + WS_WOD), M, 1024, 1024, E, tid_); }
        { PH_BEGIN EpiM2 E{G.GM, G.XN}; run_gemm(lds, G.MO, (const bf16*)(ws + WS_WOM), M, 1024, 1024, E, tid_); }
#endif
        GBAR();
#if PHMASK & 64
        { PH_BEGIN EpiOut E{G.x, G.y, G.nvalid}; run_gemm(lds, G.XN, (const bf16*)(ws + WS_WOUT), M, 1024, 1024, E, tid_); }
#endif
        GBAR();
        { PH_BEGIN rms_rows_bf16(G.y, G.XN, a.in[22], G.nvalid, M, gw, ngw, lane); }
        GBAR();
#if PHMASK & 128
        { PH_BEGIN EpiUp E{G.U}; run_gemm(lds, G.XN, (const bf16*)(ws + WS_WUP), M, 4096, 1024, E, tid_); }
#endif
        GBAR();
#if PHMASK & 256
        { PH_BEGIN EpiDown E{G.y, G.nvalid}; run_gemm(lds, G.U, (const bf16*)(ws + WS_WDN), M, 1024, 4096, E, tid_); }
#endif
        GBAR();
        { PH_BEGIN rms_rows_f32_inplace(G.y, a.in[25], G.nvalid, gw, ngw, lane); }
    }
}

extern "C" void kernel_launch(void* const* d_in, const int* in_sizes, int n_in, void* d_out, int out_size, void* d_ws, size_t ws_size, hipStream_t stream) {
    static int grid = 0;
    if (grid == 0) {
        if (n_in != 26 || ws_size < WS_NEED) { fprintf(stderr, "kernel_launch: need 26 inputs and %zu bytes of workspace; got %d, %zu\n", (size_t)WS_NEED, n_in, ws_size); grid = -1; return; }
        int dev = 0, cus = 0, per_cu = 0;
        if (hipGetDevice(&dev) != hipSuccess || hipDeviceGetAttribute(&cus, hipDeviceAttributeMultiprocessorCount, dev) != hipSuccess) { grid = -1; return; }
        if (hipFuncSetAttribute((const void*)fwd_megakernel, hipFuncAttributeMaxDynamicSharedMemorySize, LDS_BYTES) != hipSuccess) { fprintf(stderr, "kernel_launch: hipFuncSetAttribute failed\n"); grid = -1; return; }
        if (hipOccupancyMaxActiveBlocksPerMultiprocessor(&per_cu, (const void*)fwd_megakernel, 512, LDS_BYTES) != hipSuccess || per_cu < 1) { fprintf(stderr, "kernel_launch: occupancy query says %d\n", per_cu); per_cu = 1; }
        (void)hipGetLastError();
        grid = cus;
    }
    if (grid < 0) return;
    if (hipMemsetAsync((char*)d_ws + WS_BAR, 0, 16384, stream) != hipSuccess) { fprintf(stderr, "kernel_launch: memset failed\n"); return; }
    Args a{};
    for (int i = 0; i < 26; ++i) a.in[i] = (const float*)d_in[i];
    a.out = (float*)d_out; a.ws = (unsigned char*)d_ws;
    void* args[] = {&a};
    hipError_t e = hipLaunchCooperativeKernel((const void*)fwd_megakernel, dim3(grid), dim3(512), args, LDS_BYTES, stream);
    if (e != hipSuccess) fprintf(stderr, "kernel_launch: cooperative launch failed: %s (grid %d)\n", hipGetErrorString(e), grid);
}
```

```cpp
#include <hip/hip_runtime.h>
#include <hip/hip_cooperative_groups.h>
#include <cstdio>
#include <cstdint>
namespace cg = cooperative_groups;
namespace pg8 {
#define PG8_LAS __attribute__((address_space(3)))
typedef unsigned short bf16_t;
typedef short bf16x8 __attribute__((ext_vector_type(8)));
typedef float f32x4 __attribute__((ext_vector_type(4)));
typedef unsigned u32x4 __attribute__((ext_vector_type(4)));
constexpr int BM = 256, BK = 64, HALF = 128, HTB = HALF * BK * 2  , STAGE_BYTES = 8 * HTB, NXCD = 8, WGM = 8;

__host__ __device__ __forceinline__ int lds_byte(int r, int c) { const int st = (r >> 4) * 2 + (c >> 5), rr = r & 15, cc = c & 31, ob = rr * 64 + cc * 2; return st * 1024 + (ob ^ (((ob >> 9) & 1) << 5)); }
__host__ __device__ __forceinline__ void stage_rc(int b, int& R, int& C) { const int st = b / 1024, sb = b % 1024, swz = sb ^ (((sb >> 9) & 1) << 5); R = (st >> 1) * 16 + swz / 64; C = (st & 1) * 32 + (swz % 64) / 2; }
__host__ __device__ __forceinline__ int perm32(int rho) { const int n = rho >> 4, i = rho & 15; return 8 * (i >> 2) + 4 * n + (i & 3); }

struct Unit { int pm, pn; };
struct Gemm { const bf16_t* A; const bf16_t* Bt; int M, N, K, ld; };

struct StaticOrder {
    int nM, nN, nwg, G, c;
    __host__ __device__ void init(int M, int N, int G_, int c_) { nM = M / BM; nN = N / BM; nwg = nM * nN; G = G_; c = c_; }
    __host__ __device__ bool next(int i, Unit& u) const {
        const long L = (long)i * G + c; if (L >= nwg) return false;
        int wgid = (int)L; { const int q = nwg / NXCD, r = nwg % NXCD, xcd = wgid % NXCD, off = wgid / NXCD; wgid = (xcd < r ? xcd * (q + 1) : r * (q + 1) + (xcd - r) * q) + off; }
        const int nig = WGM * nN, gid = wgid / nig, fm = gid * WGM, gsz = (nM - fm) < WGM ? (nM - fm) : WGM;
        u.pm = fm + ((wgid % nig) % gsz); u.pn = (wgid % nig) / gsz; return true;
    }
    __device__ __forceinline__ void a_ready(const Unit&) const {}
    __device__ __forceinline__ void done(const Unit&) const {}
};

__device__ __forceinline__ unsigned cvt_pk_bf16(float lo, float hi) { unsigned r; asm volatile("v_cvt_pk_bf16_f32 %0, %1, %2" : "=v"(r) : "v"(lo), "v"(hi)); return r; }
typedef float f32x2 __attribute__((ext_vector_type(2)));
template <class Epi, class Sched, bool ALIGN_EPI = false, bool SP2 = false>
__device__ __forceinline__ void gemm_phase(PG8_LAS unsigned char* lds, const Gemm g, const Sched& S, const Epi& E, const int tid_in) {
    int tid_ = tid_in; asm volatile("" : "+v"(tid_));
    const int tid = tid_, wid = __builtin_amdgcn_readfirstlane(tid >> 6), lane = tid & 63, wr = wid >> 2, wc = wid & 3, fr = lane & 15, fq = lane >> 4;
    const int K = g.K, nt = K / BK, LD = g.ld;
    unsigned voffA[2], voffB[2];
#pragma unroll
    for (int i = 0; i < 2; ++i) { int R, C; stage_rc(tid * 16 + i * 8192, R, C); const int Rb = Epi::PERM ? ((R & ~31) + perm32(R & 31)) : R;
        voffA[i] = (unsigned)(R * LD + C) * 2u; voffB[i] = (unsigned)(Rb * LD + C) * 2u; }
    const size_t kstep = (size_t)(BK * 2);
    const size_t hstep = (size_t)HALF * LD * 2;
    const size_t tstep = 2 * hstep;
    const unsigned ldsw = (unsigned)wid * 1024u;
    const int aoff = lds_byte(wr * 64 + fr, fq * 8), boff = lds_byte(wc * 32 + fr, fq * 8);
#define PG8_SA(b, h) (((b) * 2 + (h)) * HTB)
#define PG8_SB(b, h) ((4 + (b) * 2 + (h)) * HTB)
#define PG8_STAGE(bufoff, gbase, voff) do { _Pragma("unroll") for (int _i = 0; _i < 2; ++_i) \
        __builtin_amdgcn_global_load_lds((const unsigned*)((const char*)(gbase) + (voff)[_i]), (PG8_LAS unsigned*)(lds + (bufoff) + ldsw + _i * 8192), 16, 0, 0); } while (0)
#define PG8_LDA(dst, b, h) do { _Pragma("unroll") for (int m = 0; m < 4; ++m) _Pragma("unroll") for (int k = 0; k < 2; ++k) dst[m][k] = *(const PG8_LAS bf16x8*)(lds + PG8_SA(b, h) + aoff + m * 2048 + k * 1024); } while (0)
#define PG8_LDB(dst, b, h) do { _Pragma("unroll") for (int n = 0; n < 2; ++n) _Pragma("unroll") for (int k = 0; k < 2; ++k) dst[n][k] = *(const PG8_LAS bf16x8*)(lds + PG8_SB(b, h) + boff + n * 2048 + k * 1024); } while (0)
#define PG8_MMA(ai, bj, At, Bt) do { __builtin_amdgcn_s_setprio(1); _Pragma("unroll") for (int m = 0; m < 4; ++m) _Pragma("unroll") for (int n = 0; n < 2; ++n) _Pragma("unroll") for (int k = 0; k < 2; ++k) \
        acc[ai][bj][m][n] = __builtin_amdgcn_mfma_f32_16x16x32_bf16(Bt[n][k], At[m][k], acc[ai][bj][m][n], 0, 0, 0); __builtin_amdgcn_s_setprio(0); } while (0)
#define PG8_WAIT_V(n) asm volatile("s_waitcnt vmcnt(" #n ")" ::: "memory")
#define PG8_WAIT_L(n) asm volatile("s_waitcnt lgkmcnt(" #n ")" ::: "memory")
#define PG8_BAR __builtin_amdgcn_s_barrier()
#define PG8_SCHED __builtin_amdgcn_sched_barrier(0)
    Unit cur, nxt; int ui = 0;
    if (!S.next(0, cur)) return;
    f32x4 acc[2][2][4][2];
#pragma unroll
    for (int a = 0; a < 2; ++a)
#pragma unroll
        for (int b = 0; b < 2; ++b)
#pragma unroll
            for (int m = 0; m < 4; ++m)
#pragma unroll
                for (int n = 0; n < 2; ++n) acc[a][b][m][n] = (f32x4){0.f, 0.f, 0.f, 0.f};
    bf16x8 At[4][2], B0[2][2], B1[2][2];
    const char* cA = (const char*)g.A + (size_t)cur.pm * tstep; const char* cB = (const char*)g.Bt + (size_t)cur.pn * tstep;
    S.a_ready(cur);
    if constexpr (SP2) {
        PG8_STAGE(PG8_SB(0, 0), cB, voffB); PG8_STAGE(PG8_SB(0, 1), cB + hstep, voffB); PG8_STAGE(PG8_SA(0, 0), cA, voffA); PG8_STAGE(PG8_SA(0, 1), cA + hstep, voffA);
        if (wr == 1) PG8_BAR;
        PG8_WAIT_V(2); PG8_BAR;
        PG8_STAGE(PG8_SB(1, 0), cB + kstep, voffB); PG8_STAGE(PG8_SA(1, 0), cA + kstep, voffA); PG8_STAGE(PG8_SB(1, 1), cB + hstep + kstep, voffB);
        PG8_WAIT_V(6); PG8_BAR;
    } else {
        PG8_STAGE(PG8_SB(0, 0), cB, voffB); PG8_STAGE(PG8_SA(0, 0), cA, voffA); PG8_STAGE(PG8_SB(0, 1), cB + hstep, voffB); PG8_STAGE(PG8_SA(0, 1), cA + hstep, voffA);
        if (wr == 1) PG8_BAR;
        PG8_WAIT_V(4); PG8_BAR;
        PG8_STAGE(PG8_SB(1, 0), cB + kstep, voffB); PG8_STAGE(PG8_SA(1, 0), cA + kstep, voffA); PG8_STAGE(PG8_SB(1, 1), cB + hstep + kstep, voffB);
        PG8_WAIT_V(6); PG8_BAR;
    }
    for (;;) {
        const bool has_next = S.next(ui + 1, nxt);
        const char* nA = has_next ? (const char*)g.A + (size_t)nxt.pm * tstep : cA; const char* nB = has_next ? (const char*)g.Bt + (size_t)nxt.pn * tstep : cB;
        for (int t = 0; t < nt; t += 2) {
            const bool last = (t == nt - 2);
            const char* a1 = cA + (size_t)(t + 1) * kstep;
            const char* a2 = last ? nA : cA + (size_t)(t + 2) * kstep; const char* b2 = last ? nB : cB + (size_t)(t + 2) * kstep;
            const char* a3 = a2 + kstep; const char* b3 = b2 + kstep;
            if (last && has_next) S.a_ready(nxt);
            if constexpr (SP2) {
            PG8_LDB(B0, 0, 0); PG8_LDB(B1, 0, 1); PG8_SCHED; PG8_LDA(At, 0, 0); PG8_STAGE(PG8_SA(1, 1), a1 + hstep, voffA);
            PG8_WAIT_V(8); PG8_WAIT_L(0); PG8_BAR; PG8_MMA(0, 0, At, B0); PG8_MMA(0, 1, At, B1); PG8_BAR; PG8_SCHED;
            PG8_LDA(At, 0, 1); PG8_STAGE(PG8_SB(0, 0), b2, voffB); PG8_STAGE(PG8_SB(0, 1), b2 + hstep, voffB); PG8_STAGE(PG8_SA(0, 0), a2, voffA);
            PG8_WAIT_V(8); PG8_WAIT_L(0); PG8_BAR; PG8_MMA(1, 0, At, B0); PG8_MMA(1, 1, At, B1); PG8_BAR; PG8_SCHED;
            PG8_LDB(B0, 1, 0); PG8_LDB(B1, 1, 1); PG8_SCHED; PG8_LDA(At, 1, 0); PG8_STAGE(PG8_SA(0, 1), a2 + hstep, voffA);
            PG8_WAIT_V(8); PG8_WAIT_L(0); PG8_BAR; PG8_MMA(0, 0, At, B0); PG8_MMA(0, 1, At, B1); PG8_BAR; PG8_SCHED;
            PG8_LDA(At, 1, 1); PG8_STAGE(PG8_SB(1, 0), b3, voffB); PG8_STAGE(PG8_SB(1, 1), b3 + hstep, voffB); PG8_STAGE(PG8_SA(1, 0), a3, voffA);
            PG8_WAIT_V(8); PG8_WAIT_L(0); PG8_BAR; PG8_MMA(1, 0, At, B0); PG8_MMA(1, 1, At, B1); PG8_BAR; PG8_SCHED;
            } else {
            PG8_LDB(B0, 0, 0); PG8_SCHED; PG8_LDA(At, 0, 0); PG8_STAGE(PG8_SA(1, 1), a1 + hstep, voffA);
            PG8_WAIT_L(8); PG8_BAR; PG8_WAIT_L(0); PG8_MMA(0, 0, At, B0); PG8_BAR; PG8_SCHED;
            PG8_LDB(B1, 0, 1); PG8_STAGE(PG8_SB(0, 0), b2, voffB);
            PG8_BAR; PG8_WAIT_L(0); PG8_MMA(0, 1, At, B1); PG8_BAR;
            PG8_LDA(At, 0, 1); PG8_STAGE(PG8_SA(0, 0), a2, voffA);
            PG8_BAR; PG8_WAIT_L(0); PG8_MMA(1, 0, At, B0); PG8_BAR; PG8_SCHED;
            PG8_STAGE(PG8_SB(0, 1), b2 + hstep, voffB);
            PG8_WAIT_V(6); PG8_BAR; PG8_MMA(1, 1, At, B1); PG8_BAR;
            PG8_LDB(B0, 1, 0); PG8_SCHED; PG8_LDA(At, 1, 0); PG8_STAGE(PG8_SA(0, 1), a2 + hstep, voffA);
            PG8_WAIT_L(8); PG8_BAR; PG8_WAIT_L(0); PG8_MMA(0, 0, At, B0); PG8_BAR; PG8_SCHED;
            PG8_LDB(B1, 1, 1); PG8_STAGE(PG8_SB(1, 0), b3, voffB);
            PG8_BAR; PG8_WAIT_L(0); PG8_MMA(0, 1, At, B1); PG8_BAR;
            PG8_LDA(At, 1, 1); PG8_STAGE(PG8_SA(1, 0), a3, voffA);
            PG8_BAR; PG8_WAIT_L(0); PG8_MMA(1, 0, At, B0); PG8_BAR; PG8_SCHED;
            PG8_STAGE(PG8_SB(1, 1), b3 + hstep, voffB);
            PG8_WAIT_V(6); PG8_BAR; PG8_MMA(1, 1, At, B1); PG8_BAR;
            }
        }
        if constexpr (ALIGN_EPI) { if (wr == 0) PG8_BAR; }
        if constexpr (!Epi::AFTER_DRAIN) { E(acc, cur, wr, wc, fr, fq); S.done(cur); }
        if (!has_next) break;
#pragma unroll
        for (int a = 0; a < 2; ++a)
#pragma unroll
            for (int b = 0; b < 2; ++b)
#pragma unroll
                for (int m = 0; m < 4; ++m)
#pragma unroll
                    for (int n = 0; n < 2; ++n) acc[a][b][m][n] = (f32x4){0.f, 0.f, 0.f, 0.f};
        cur = nxt; cA = nA; cB = nB; ++ui;
        if constexpr (ALIGN_EPI) { if (wr == 1) PG8_BAR; }
    }
    PG8_WAIT_V(0);
    if constexpr (!ALIGN_EPI) { if (wr == 0) PG8_BAR; }
    PG8_BAR;
    if constexpr (Epi::AFTER_DRAIN) { E.fused(acc, cur, wr, wc, fr, fq, lds, wid, lane); S.done(cur); }
#undef PG8_SA
#undef PG8_SB
#undef PG8_STAGE
#undef PG8_LDA
#undef PG8_LDB
#undef PG8_MMA
#undef PG8_WAIT_V
#undef PG8_WAIT_L
#undef PG8_BAR
#undef PG8_SCHED
}
}

#define LAS __attribute__((address_space(3)))
typedef unsigned short bf16;
typedef float f32x4 __attribute__((ext_vector_type(4)));
typedef float f32x2 __attribute__((ext_vector_type(2)));
typedef float f32x16 __attribute__((ext_vector_type(16)));
typedef short bf16x8 __attribute__((ext_vector_type(8)));
typedef short s16x4 __attribute__((ext_vector_type(4)));
typedef unsigned u32x4 __attribute__((ext_vector_type(4)));
typedef unsigned u32x2 __attribute__((ext_vector_type(2)));

constexpr int DM = 1024, NB = 32, TS = 2048, SB = 8, ST = 16, PAST = 4096;
constexpr int NPG = 2;
constexpr int RG = NB * TS / NPG;
constexpr int GBATCH = NB / NPG;
constexpr int NGRP = NPG + 1;
constexpr int NIN = 5888;
constexpr float LOG2E = 1.4426950408889634f;
constexpr float EPSN = 1e-6f;
constexpr int NSPLIT = 4;
constexpr int CACHE_ROWS = SB * PAST;

constexpr size_t O_YP = 0, O_YS = 67108864, O_KDP = 67239936, O_VDP = 134348800, O_CKVP = 201457664, O_KRP = 218234880,
                 O_KDS = 220332032, O_VDS = 220463104, O_CKVS = 220594176, O_KRS = 220626944;
constexpr size_t MiB = 1u << 20;
constexpr size_t WS_TAB = 0;
constexpr size_t WS_ROPE = 8192;
constexpr size_t WS_WIN = 1 * MiB;
constexpr size_t WS_WUQ = WS_WIN + (size_t)NIN * 1024 * 2;
constexpr size_t WS_WUKV = WS_WUQ + 1536 * 256 * 2;
constexpr size_t WS_WOD = WS_WUKV + 2048 * 256 * 2;
constexpr size_t WS_WOM = WS_WOD + 2 * MiB;
constexpr size_t WS_WOUT = WS_WOM + 2 * MiB;
constexpr size_t WS_WUP = WS_WOUT + 2 * MiB;
constexpr size_t WS_WDN = WS_WUP + 8 * MiB;
constexpr size_t WS_WEND = WS_WDN + 8 * MiB;
constexpr size_t WS_SAMP = 37 * MiB;
constexpr size_t WS_PART = 44 * MiB;
constexpr size_t WS_PO_D = WS_PART, WS_PO_M = WS_PART + 8 * MiB, WS_PM = WS_PART + 12 * MiB, WS_PL = WS_PM + 131072;
constexpr size_t WS_PROMPT = 58 * MiB;
constexpr size_t GRP_BYTES_PER_ROW = 27712;
constexpr size_t WS_NEED = WS_PROMPT + (size_t)RG * GRP_BYTES_PER_ROW;
static_assert(WS_WEND <= WS_SAMP && WS_SAMP + 256 * GRP_BYTES_PER_ROW <= WS_PART && WS_PL + 131072 <= WS_PROMPT, "ws map");
constexpr size_t C_KDC = 0, C_VDC = 64 * MiB, C_KNC = 128 * MiB, C_VMC = 192 * MiB, C_CKVC = 256 * MiB, C_KRC = 272 * MiB;

struct Args { const float* in[26]; float* out; unsigned char* ws; int pad0, pad1; };

struct Grp {
    const float* x; float* y; float* okd; float* ovd; float* ockv; float* okr;
    int nvalid, ntiles, sample;
    bf16 *QD, *KD, *VD, *QN, *U, *XN, *QR, *KN, *VM, *GD, *GM, *DO, *MO, *CQ, *CKV, *KR; float* ZS;
};
__device__ __forceinline__ Grp make_grp(const Args& a, int g) {
    Grp G; unsigned char* base; size_t RC;
    if (g == 0) {
        G.x = a.in[1]; G.y = a.out + O_YS; G.okd = a.out + O_KDS; G.ovd = a.out + O_VDS; G.ockv = a.out + O_CKVS; G.okr = a.out + O_KRS;
        G.nvalid = SB * ST; G.ntiles = 1; G.sample = 1; base = a.ws + WS_SAMP; RC = 256;
    } else {
        const size_t r0 = (size_t)(g - 1) * RG;
        G.x = a.in[0] + r0 * 1024; G.y = a.out + O_YP + r0 * 1024; G.okd = a.out + O_KDP + r0 * 1024; G.ovd = a.out + O_VDP + r0 * 1024;
        G.ockv = a.out + O_CKVP + r0 * 256; G.okr = a.out + O_KRP + r0 * 32;
        G.nvalid = RG; G.ntiles = RG / 256; G.sample = 0; base = a.ws + WS_PROMPT; RC = RG;
    }
    G.QD = (bf16*)(base); G.KD = (bf16*)(base + RC * 2048); G.VD = (bf16*)(base + RC * 4096); G.QN = (bf16*)(base + RC * 6144); G.U = (bf16*)base;
    G.XN = (bf16*)(base + RC * 8192); G.QR = (bf16*)(base + RC * 10240); G.KN = (bf16*)(base + RC * 11264); G.VM = (bf16*)(base + RC * 13312);
    G.GD = (bf16*)(base + RC * 15360); G.GM = (bf16*)(base + RC * 17408); G.DO = (bf16*)(base + RC * 19456); G.MO = (bf16*)(base + RC * 21504);
    G.ZS = (float*)(base + RC * 23552); G.CQ = (bf16*)(base + RC * 26624); G.CKV = (bf16*)(base + RC * 27136); G.KR = (bf16*)(base + RC * 27648);
    return G;
}

template <int M> __device__ __forceinline__ float swz_xor(float v) { return __int_as_float(__builtin_amdgcn_ds_swizzle(__float_as_int(v), 0x1F | (M << 10))); }
__device__ __forceinline__ float half_sum32(float v) { v += swz_xor<1>(v); v += swz_xor<2>(v); v += swz_xor<4>(v); v += swz_xor<8>(v); v += swz_xor<16>(v); return v; }
__device__ __forceinline__ float wave_sum(float v) {
    v = half_sum32(v);
    auto rr = __builtin_amdgcn_permlane32_swap(__float_as_uint(v), __float_as_uint(v), false, false);
    return __uint_as_float(rr[0]) + __uint_as_float(rr[1]);
}
typedef __bf16 bf16x2_hw __attribute__((ext_vector_type(2)));
__device__ __forceinline__ unsigned pk2(float lo, float hi) { f32x2 v = {lo, hi}; bf16x2_hw b = __builtin_convertvector(v, bf16x2_hw); return __builtin_bit_cast(unsigned, b); }
__device__ __forceinline__ unsigned f2bf(float f) { return pk2(f, 0.f) & 0xffffu; }
__device__ __forceinline__ float bflo(unsigned w) { return __builtin_bit_cast(float, w << 16); }
__device__ __forceinline__ float bfhi(unsigned w) { return __builtin_bit_cast(float, w & 0xffff0000u); }
__device__ __forceinline__ void st_bf4(bf16* p, f32x4 v) { u32x2 w; w.x = pk2(v[0], v[1]); w.y = pk2(v[2], v[3]); *(u32x2*)p = w; }
__device__ __forceinline__ f32x4 ld_bf4(const bf16* p) { const u32x2 w = *(const u32x2*)p; return (f32x4){bflo(w.x), bfhi(w.x), bflo(w.y), bfhi(w.y)}; }
__device__ __forceinline__ float sigm(float x) { return 1.f / (1.f + __expf(-x)); }

#define EPI_LOOP(BODY) \
    _Pragma("unroll") for (int ai = 0; ai < 2; ++ai) _Pragma("unroll") for (int m = 0; m < 4; ++m) { const int row = u.pm * 256 + ai * 128 + wr * 64 + m * 16 + fr; const size_t rw = (size_t)row; (void)rw; \
    _Pragma("unroll") for (int bj = 0; bj < 2; ++bj) _Pragma("unroll") for (int n = 0; n < 2; ++n) { const int cl = bj * 128 + wc * 32 + n * 16 + 4 * fq; const f32x4 v = acc[ai][bj][m][n]; BODY } asm volatile("" ::: "memory"); }

#define EPI_LOOP_P(...) \
    _Pragma("unroll") for (int ai = 0; ai < 2; ++ai) _Pragma("unroll") for (int m = 0; m < 4; ++m) { const int row = u.pm * 256 + ai * 128 + wr * 64 + m * 16 + fr; const size_t rw = (size_t)row; (void)rw; \
    _Pragma("unroll") for (int bj = 0; bj < 2; ++bj) { const int cl = bj * 128 + wc * 32 + 8 * fq; const f32x4 v0 = acc[ai][bj][m][0], v1 = acc[ai][bj][m][1]; __VA_ARGS__ } asm volatile("" ::: "memory"); }
__device__ __forceinline__ void st_bf8(bf16* p, f32x4 a, f32x4 b) { u32x4 w; w.x = pk2(a[0], a[1]); w.y = pk2(a[2], a[3]); w.z = pk2(b[0], b[1]); w.w = pk2(b[2], b[3]); *(u32x4*)p = w; }
__device__ __forceinline__ void ld_bf8(const bf16* p, f32x4& a, f32x4& b) { const u32x4 w = *(const u32x4*)p; a = (f32x4){bflo(w.x), bfhi(w.x), bflo(w.y), bfhi(w.y)}; b = (f32x4){bflo(w.z), bfhi(w.z), bflo(w.w), bfhi(w.w)}; }
__device__ __forceinline__ f32x4 sigm4(f32x4 v) { return (f32x4){sigm(v[0]), sigm(v[1]), sigm(v[2]), sigm(v[3])}; }
typedef const f32x4 (&AccRef)[2][2][4][2];

struct EpiIn {
    static constexpr bool PERM = true, AFTER_DRAIN = false;
    bf16 *QD, *KD, *VD, *GD, *GM; float *ZS, *okd, *ovd; int nvalid; float qs;
    __device__ __forceinline__ void operator()(AccRef acc, const pg8::Unit& u, int wr, int wc, int fr, int fq) const {
        const int t = u.pn;
        if (t < 4) { const int c0 = t * 256; EPI_LOOP_P( st_bf8(QD + rw * 1024 + c0 + cl, v0 * qs, v1 * qs); ) }
        else if (t < 8) { const int c0 = (t - 4) * 256; EPI_LOOP_P( st_bf8(KD + rw * 1024 + c0 + cl, v0, v1); if (row < nvalid) { float* o = okd + rw * 1024 + c0 + cl; *(f32x4*)o = v0; *(f32x4*)(o + 4) = v1; } ) }
        else if (t < 12) { const int c0 = (t - 8) * 256; EPI_LOOP_P( st_bf8(VD + rw * 1024 + c0 + cl, v0, v1); if (row < nvalid) { float* o = ovd + rw * 1024 + c0 + cl; *(f32x4*)o = v0; *(f32x4*)(o + 4) = v1; } ) }
        else if (t < 15) { const int c0 = (t - 12) * 256; EPI_LOOP_P( float* o = ZS + rw * 768 + c0 + cl; *(f32x4*)o = v0; *(f32x4*)(o + 4) = v1; ) }
        else if (t < 19) { const int c0 = (t - 15) * 256; EPI_LOOP_P( st_bf8(GD + rw * 1024 + c0 + cl, sigm4(v0), sigm4(v1)); ) }
        else { const int c0 = (t - 19) * 256; EPI_LOOP_P( st_bf8(GM + rw * 1024 + c0 + cl, sigm4(v0), sigm4(v1)); ) }
    }
};
struct EpiQ {
    static constexpr bool PERM = false, AFTER_DRAIN = false;
    bf16 *QN, *QR; const float* rope; int sample; float qs;
    __device__ __forceinline__ void operator()(AccRef acc, const pg8::Unit& u, int wr, int wc, int fr, int fq) const {
        const int t = u.pn;
        if (t < 4) { const int c0 = t * 256; EPI_LOOP( st_bf4(QN + rw * 1024 + c0 + cl, v * qs); ) }
        else {
            const int c0 = (t - 4) * 256;
#pragma unroll
            for (int ai = 0; ai < 2; ++ai)
#pragma unroll
                for (int m = 0; m < 4; ++m) {
                    const int row = u.pm * 256 + ai * 128 + wr * 64 + m * 16 + fr;
                    const int pos = sample ? (PAST + (row & (ST - 1))) : (row & (TS - 1));
                    const f32x4 cs0 = *(const f32x4*)(rope + (size_t)pos * 32 + 8 * fq), cs1 = *(const f32x4*)(rope + (size_t)pos * 32 + 8 * fq + 4);
#pragma unroll
                    for (int bj = 0; bj < 2; ++bj) {
                        const f32x4 x1 = acc[ai][bj][m][0], x2 = acc[ai][bj][m][1];
                        f32x4 o1, o2;
                        o1[0] = x1[0] * cs0[0] - x2[0] * cs0[1]; o2[0] = x2[0] * cs0[0] + x1[0] * cs0[1];
                        o1[1] = x1[1] * cs0[2] - x2[1] * cs0[3]; o2[1] = x2[1] * cs0[2] + x1[1] * cs0[3];
                        o1[2] = x1[2] * cs1[0] - x2[2] * cs1[1]; o2[2] = x2[2] * cs1[0] + x1[2] * cs1[1];
                        o1[3] = x1[3] * cs1[2] - x2[3] * cs1[3]; o2[3] = x2[3] * cs1[2] + x1[3] * cs1[3];
                        bf16* p = QR + (size_t)row * 512 + c0 + bj * 128 + wc * 32 + 4 * fq;
                        st_bf4(p, o1 * qs); st_bf4(p + 16, o2 * qs);
                    }
                    asm volatile("" ::: "memory");
                }
        }
    }
};
struct EpiKV {
    static constexpr bool PERM = true, AFTER_DRAIN = false;
    bf16 *KN, *VM;
    __device__ __forceinline__ void operator()(AccRef acc, const pg8::Unit& u, int wr, int wc, int fr, int fq) const {
        const int t = u.pn; bf16* O = t < 4 ? KN : VM; const int c0 = (t & 3) * 256;
        EPI_LOOP_P( st_bf8(O + rw * 1024 + c0 + cl, v0, v1); )
    }
};
struct EpiM1 {
    static constexpr bool PERM = true, AFTER_DRAIN = false;
    const bf16* Gt; bf16* MG;
    __device__ __forceinline__ void operator()(AccRef acc, const pg8::Unit& u, int wr, int wc, int fr, int fq) const {
        const int c0 = u.pn * 256;
        EPI_LOOP_P( f32x4 g0, g1; ld_bf8(Gt + rw * 1024 + c0 + cl, g0, g1); st_bf8(MG + rw * 1024 + c0 + cl, g0 * v0, g1 * v1); )
    }
};
struct EpiM2 {
    static constexpr bool PERM = true, AFTER_DRAIN = false;
    const bf16* Gt; bf16* MG;
    __device__ __forceinline__ void operator()(AccRef acc, const pg8::Unit& u, int wr, int wc, int fr, int fq) const {
        const int c0 = u.pn * 256;
        EPI_LOOP_P( f32x4 g0, g1, o0, o1; ld_bf8(Gt + rw * 1024 + c0 + cl, g0, g1); ld_bf8(MG + rw * 1024 + c0 + cl, o0, o1); st_bf8(MG + rw * 1024 + c0 + cl, o0 + g0 * v0, o1 + g1 * v1); )
    }
};
struct EpiOut {
    static constexpr bool PERM = true, AFTER_DRAIN = false;
    const float* x; float* y; int nvalid;
    __device__ __forceinline__ void operator()(AccRef acc, const pg8::Unit& u, int wr, int wc, int fr, int fq) const {
        const int c0 = u.pn * 256;
        EPI_LOOP_P( if (row < nvalid) { const float* xb = x + rw * 1024 + c0 + cl; float* o = y + rw * 1024 + c0 + cl; const f32x4 b0 = *(const f32x4*)xb, b1 = *(const f32x4*)(xb + 4); *(f32x4*)o = b0 + v0; *(f32x4*)(o + 4) = b1 + v1; } )
    }
};
struct EpiUp {
    static constexpr bool PERM = true, AFTER_DRAIN = false;
    bf16* U;
    __device__ __forceinline__ void operator()(AccRef acc, const pg8::Unit& u, int wr, int wc, int fr, int fq) const {
        const int c0 = u.pn * 256;
        EPI_LOOP_P( f32x4 r0, r1; r0[0] = fmaxf(v0[0], 0.f); r0[1] = fmaxf(v0[1], 0.f); r0[2] = fmaxf(v0[2], 0.f); r0[3] = fmaxf(v0[3], 0.f); r1[0] = fmaxf(v1[0], 0.f); r1[1] = fmaxf(v1[1], 0.f); r1[2] = fmaxf(v1[2], 0.f); r1[3] = fmaxf(v1[3], 0.f);
                    st_bf8(U + rw * 4096 + c0 + cl, r0 * r0, r1 * r1); )
    }
};
struct EpiDown {
    static constexpr bool PERM = true, AFTER_DRAIN = false;
    float* y; int nvalid;
    __device__ __forceinline__ void operator()(AccRef acc, const pg8::Unit& u, int wr, int wc, int fr, int fq) const {
        const int c0 = u.pn * 256;
        EPI_LOOP_P( if (row < nvalid) { float* p = y + rw * 1024 + c0 + cl; const f32x4 b0 = *(const f32x4*)p, b1 = *(const f32x4*)(p + 4); *(f32x4*)p = b0 + v0; *(f32x4*)(p + 4) = b1 + v1; } )
    }
};

struct EpiDownAtomic {
    static constexpr bool PERM = true, AFTER_DRAIN = false;
    float* y; int nvalid;
    __device__ __forceinline__ void operator()(AccRef acc, const pg8::Unit& u, int wr, int wc, int fr, int fq) const {
        const int c0 = u.pn * 256;
        EPI_LOOP_P( if (row < nvalid) { float* p = y + rw * 1024 + c0 + cl;
            _Pragma("unroll") for (int e = 0; e < 4; ++e) { atomicAdd(p + e, v0[e]); atomicAdd(p + 4 + e, v1[e]); } } )
    }
};

template <class Epi>
__device__ __forceinline__ void run_gemm(LAS unsigned char* lds, const bf16* A, const bf16* Bt, int M, int N, int K, const Epi& E, const int tid_in, const int ld = 0, const int cshift = 0) {
    int Kr = K; asm volatile("" : "+s"(Kr));
    const int Gn = (int)gridDim.x; int c = (int)blockIdx.x - cshift; if (c < 0) c += Gn;
    pg8::Gemm g{A, Bt, M, N, Kr, ld ? ld : Kr}; pg8::StaticOrder S; S.init(M, N, Gn, c);
    pg8::gemm_phase<Epi, pg8::StaticOrder, true, true>(lds, g, S, E, tid_in);
}

__device__ __forceinline__ void rms_rows_bf16(const float* src, bf16* dst, const float* gain, int nvalid, int ntotal, int gw, int ngw, int lane) {
    f32x4 g[4];
#pragma unroll
    for (int j = 0; j < 4; ++j) g[j] = ((const f32x4*)gain)[lane + 64 * j];
    for (int r0 = 2 * gw; r0 < ntotal; r0 += 2 * ngw) {
        f32x4 v[2][4];
#pragma unroll
        for (int k = 0; k < 2; ++k) { const int r = r0 + k; const f32x4* xr = (const f32x4*)(src + (size_t)(r < nvalid ? r : 0) * 1024) + lane;
#pragma unroll
            for (int j = 0; j < 4; ++j) v[k][j] = xr[64 * j]; }
#pragma unroll
        for (int k = 0; k < 2; ++k) { const int r = r0 + k; if (r >= ntotal) continue;
            u32x2* o8 = (u32x2*)(dst + (size_t)r * 1024) + lane;
            float s = 0.f;
#pragma unroll
            for (int j = 0; j < 4; ++j) s += (v[k][j][0] * v[k][j][0] + v[k][j][1] * v[k][j][1]) + (v[k][j][2] * v[k][j][2] + v[k][j][3] * v[k][j][3]);
            const float rs = (r < nvalid) ? 1.0f / sqrtf(wave_sum(s) * (1.f / 1024.f) + EPSN) : 0.f;
#pragma unroll
            for (int j = 0; j < 4; ++j) { const f32x4 o = v[k][j] * rs * g[j]; o8[64 * j] = (u32x2){pk2(o[0], o[1]), pk2(o[2], o[3])}; } }
    }
}
__device__ __forceinline__ void rms_rows_f32_inplace(float* y, const float* gain, int nvalid, int gw, int ngw, int lane) {
    f32x4 g[4];
#pragma unroll
    for (int j = 0; j < 4; ++j) g[j] = ((const f32x4*)gain)[lane + 64 * j];
    for (int r0 = 2 * gw; r0 < nvalid; r0 += 2 * ngw) {
        f32x4 v[2][4];
#pragma unroll
        for (int k = 0; k < 2; ++k) { const int r = r0 + k; f32x4* xr = (f32x4*)(y + (size_t)(r < nvalid ? r : r0) * 1024) + lane;
#pragma unroll
            for (int j = 0; j < 4; ++j) v[k][j] = xr[64 * j]; }
#pragma unroll
        for (int k = 0; k < 2; ++k) { const int r = r0 + k; if (r >= nvalid) continue;
            f32x4* xr = (f32x4*)(y + (size_t)r * 1024) + lane;
            float s = 0.f;
#pragma unroll
            for (int j = 0; j < 4; ++j) s += (v[k][j][0] * v[k][j][0] + v[k][j][1] * v[k][j][1]) + (v[k][j][2] * v[k][j][2] + v[k][j][3] * v[k][j][3]);
            const float rs = 1.0f / sqrtf(wave_sum(s) * (1.f / 1024.f) + EPSN);
#pragma unroll
            for (int j = 0; j < 4; ++j) xr[64 * j] = v[k][j] * rs * g[j]; }
    }
}
__device__ __forceinline__ void phase_small(const Grp& G, const float* gq, const float* gkv, const float* rope, int gw, int ngw, int lane) {
    const int ntotal = G.ntiles * 256;
    for (int r = gw; r < ntotal; r += ngw) {
        const float* z = G.ZS + (size_t)r * 768;
        const f32x4 cq = ((const f32x4*)z)[lane], ck = ((const f32x4*)(z + 256))[lane];
        const float s1 = wave_sum((cq[0] * cq[0] + cq[1] * cq[1]) + (cq[2] * cq[2] + cq[3] * cq[3]));
        const float s2 = wave_sum((ck[0] * ck[0] + ck[1] * ck[1]) + (ck[2] * ck[2] + ck[3] * ck[3]));
        const float r1 = 1.0f / sqrtf(s1 * (1.f / 256.f) + EPSN), r2 = 1.0f / sqrtf(s2 * (1.f / 256.f) + EPSN);
        const f32x4 o1 = cq * r1 * ((const f32x4*)gq)[lane], o2 = ck * r2 * ((const f32x4*)gkv)[lane];
        ((u32x2*)(G.CQ + (size_t)r * 256))[lane] = (u32x2){pk2(o1[0], o1[1]), pk2(o1[2], o1[3])};
        ((u32x2*)(G.CKV + (size_t)r * 256))[lane] = (u32x2){pk2(o2[0], o2[1]), pk2(o2[2], o2[3])};
        if (r < G.nvalid) ((f32x4*)(G.ockv + (size_t)r * 256))[lane] = o2;
        if (lane < 16) {
            const int pos = G.sample ? (PAST + (r & (ST - 1))) : (r & (TS - 1));
            const float x1 = z[512 + lane], x2 = z[512 + 16 + lane];
            const f32x2 cs = *(const f32x2*)(rope + (size_t)pos * 32 + 2 * lane);
            const float a = x1 * cs[0] - x2 * cs[1], b = x2 * cs[0] + x1 * cs[1];
            G.KR[(size_t)r * 32 + lane] = (bf16)f2bf(a); G.KR[(size_t)r * 32 + 16 + lane] = (bf16)f2bf(b);
            if (r < G.nvalid) { G.okr[(size_t)r * 32 + lane] = a; G.okr[(size_t)r * 32 + 16 + lane] = b; }
        }
    }
}

__device__ __forceinline__ void tr_item(const float* W, int K, int N, bf16* WT, int k0, int n0, int drow0, LAS float* scr, int lane) {
#pragma unroll 8
    for (int i = 0; i < 32; ++i) { const int kk = 2 * i + (lane >> 5); scr[kk * 33 + (lane & 31)] = W[(size_t)(k0 + kk) * N + n0 + (lane & 31)]; }
    asm volatile("s_waitcnt lgkmcnt(0)" ::: "memory");
    const int c = lane & 7;
#pragma unroll
    for (int j = 0; j < 4; ++j) { const int n = (lane >> 3) + 8 * j; const LAS float* s = scr + (8 * c) * 33 + n;
        u32x4 o; o.x = pk2(s[0 * 33], s[1 * 33]); o.y = pk2(s[2 * 33], s[3 * 33]); o.z = pk2(s[4 * 33], s[5 * 33]); o.w = pk2(s[6 * 33], s[7 * 33]);
        *(u32x4*)(WT + (size_t)(drow0 + n) * K + k0 + 8 * c) = o; }
    asm volatile("s_waitcnt lgkmcnt(0)" ::: "memory");
}
__device__ __forceinline__ int map_in(int n0) {
    if (n0 < 3616) return n0;
    if (n0 < 4640) return n0 - 3616 + 3840;
    return n0 - 4640 + 4864;
}
__device__ __forceinline__ int map_uq(int n0) { const int hh = n0 / 96, d0 = n0 % 96; return d0 < 64 ? hh * 64 + d0 : 1024 + hh * 32 + (d0 - 64); }
__device__ __forceinline__ void cvt8(const float* src, bf16* dst, size_t n8, size_t gt, size_t ngt) {
    for (size_t i = gt; i < n8; i += ngt) { const f32x4 a = ((const f32x4*)src)[2 * i], b = ((const f32x4*)src)[2 * i + 1];
        ((u32x4*)dst)[i] = (u32x4){pk2(a[0], a[1]), pk2(a[2], a[3]), pk2(b[0], b[1]), pk2(b[2], b[3])}; }
}
__device__ __forceinline__ void phase_prologue(const Args& a, LAS unsigned char* lds, int gw, int ngw, int lane, int wave) {
    unsigned char* ws = a.ws;
    LAS float* scr = (LAS float*)(lds + wave * 16384);
    constexpr int I_IN = 16 * 177, I_UQ = 4 * 48, I_UK = 4 * 32, I_UV = 4 * 32, I_O = 16 * 32, I_UP = 16 * 128, I_DN = 64 * 32;
    constexpr int NITEMS = I_IN + I_UQ + I_UK + I_UV + 3 * I_O + I_UP + I_DN;
    for (int it = gw; it < NITEMS; it += ngw) {
        int r = it;
        if (r < I_IN) { const int kb = r / 177, nb = r % 177; tr_item(a.in[8], 1024, 5664, (bf16*)(ws + WS_WIN), 64 * kb, 32 * nb, map_in(32 * nb), scr, lane); continue; } r -= I_IN;
        if (r < I_UQ) { const int kb = r / 48, nb = r % 48; tr_item(a.in[15], 256, 1536, (bf16*)(ws + WS_WUQ), 64 * kb, 32 * nb, map_uq(32 * nb), scr, lane); continue; } r -= I_UQ;
        if (r < I_UK) { const int kb = r / 32, nb = r % 32; tr_item(a.in[17], 256, 1024, (bf16*)(ws + WS_WUKV), 64 * kb, 32 * nb, 32 * nb, scr, lane); continue; } r -= I_UK;
        if (r < I_UV) { const int kb = r / 32, nb = r % 32; tr_item(a.in[18], 256, 1024, (bf16*)(ws + WS_WUKV), 64 * kb, 32 * nb, 1024 + 32 * nb, scr, lane); continue; } r -= I_UV;
        if (r < I_O) { const int kb = r / 32, nb = r % 32; tr_item(a.in[19], 1024, 1024, (bf16*)(ws + WS_WOD), 64 * kb, 32 * nb, 32 * nb, scr, lane); continue; } r -= I_O;
        if (r < I_O) { const int kb = r / 32, nb = r % 32; tr_item(a.in[20], 1024, 1024, (bf16*)(ws + WS_WOM), 64 * kb, 32 * nb, 32 * nb, scr, lane); continue; } r -= I_O;
        if (r < I_O) { const int kb = r / 32, nb = r % 32; tr_item(a.in[21], 1024, 1024, (bf16*)(ws + WS_WOUT), 64 * kb, 32 * nb, 32 * nb, scr, lane); continue; } r -= I_O;
        if (r < I_UP) { const int kb = r / 128, nb = r % 128; tr_item(a.in[23], 1024, 4096, (bf16*)(ws + WS_WUP), 64 * kb, 32 * nb, 32 * nb, scr, lane); continue; } r -= I_UP;
        { const int kb = r / 32, nb = r % 32; tr_item(a.in[24], 4096, 1024, (bf16*)(ws + WS_WDN), 64 * kb, 32 * nb, 32 * nb, scr, lane); }
    }
    const size_t gt = (size_t)gw * 64 + lane, ngt = (size_t)ngw * 64;
    { u32x4* z = (u32x4*)(ws + WS_WIN + (size_t)3616 * 2048); for (size_t i = gt; i < (size_t)224 * 128; i += ngt) z[i] = (u32x4){0u, 0u, 0u, 0u}; }
    unsigned char* cb = ws + WS_PROMPT;
    cvt8(a.in[2], (bf16*)(cb + C_KDC), (size_t)CACHE_ROWS * 128, gt, ngt);
    cvt8(a.in[3], (bf16*)(cb + C_VDC), (size_t)CACHE_ROWS * 128, gt, ngt);
    cvt8(a.in[4], (bf16*)(cb + C_CKVC), (size_t)CACHE_ROWS * 32, gt, ngt);
    cvt8(a.in[5], (bf16*)(cb + C_KRC), (size_t)CACHE_ROWS * 4, gt, ngt);
    float* tab = (float*)(ws + WS_TAB);
    for (size_t i = gt; i < 8 * 192; i += ngt) {
        const int h = (int)i / 192, idx = (int)i % 192, rel = idx - 128, n = rel < 0 ? -rel : rel;
        int bucket = n;
        if (n >= 8) { int j = (31 - __clz(n * n)) - 6; bucket = 8 + j; if (bucket > 15) bucket = 15; }
        if (rel > 0) bucket += 16;
        tab[i] = (a.in[6][bucket * 8 + h] - a.in[6][15 * 8 + h]) * LOG2E;
    }
    if (gt == 0) {
        float d1 = 0.f, d2 = 0.f;
        for (int i = 0; i < 64; ++i) { d1 += a.in[9][i] * a.in[10][i]; d2 += a.in[11][i] * a.in[12][i]; }
        tab[1536] = expf(d1) - expf(d2) + 0.2f;
    }
    float* rope = (float*)(ws + WS_ROPE);
    for (size_t i = gt; i < (size_t)(PAST + ST) * 16; i += ngt) {
        const int pos = (int)(i >> 4), k = (int)(i & 15);
        const float inv = __builtin_amdgcn_exp2f(-(float)k * 0.8304820237218406f);
        const float ang = (float)pos * inv;
        const double rev = (double)ang * 0.15915494309189535;
        const float fr = (float)(rev - __builtin_rint(rev));
        rope[2 * i] = __builtin_amdgcn_cosf(fr); rope[2 * i + 1] = __builtin_amdgcn_sinf(fr);
    }
}

#ifndef ATTMASK
#define ATTMASK 15
#endif
constexpr int AL_TAB = 0, AL_WSF = 6144, AL_TILE = 8192;

__device__ __forceinline__ int crow(int r, int hi) { return (r & 3) + 8 * (r >> 2) + 4 * hi; }
__device__ __forceinline__ float xmax32(float v) { auto rr = __builtin_amdgcn_permlane32_swap(__float_as_uint(v), __float_as_uint(v), false, false); return fmaxf(__uint_as_float(rr[0]), __uint_as_float(rr[1])); }
__device__ __forceinline__ float xsum32(float v) { auto rr = __builtin_amdgcn_permlane32_swap(__float_as_uint(v), __float_as_uint(v), false, false); return __uint_as_float(rr[0]) + __uint_as_float(rr[1]); }
typedef __bf16 bf16x2_t __attribute__((ext_vector_type(2)));
__device__ __forceinline__ unsigned cvtpk(float lo, float hi) { f32x2 v = {lo, hi}; bf16x2_t b = __builtin_convertvector(v, bf16x2_t); return __builtin_bit_cast(unsigned, b); }
__device__ __forceinline__ bf16x8 pack8(float a0, float a1, float a2, float a3, float a4, float a5, float a6, float a7) {
    u32x4 w = {cvtpk(a0, a1), cvtpk(a2, a3), cvtpk(a4, a5), cvtpk(a6, a7)}; return __builtin_bit_cast(bf16x8, w);
}
typedef short v4i16_t __attribute__((ext_vector_type(4)));
__device__ __forceinline__ s16x4 vtr(const LAS unsigned char* p) { return __builtin_bit_cast(s16x4, __builtin_amdgcn_ds_read_tr16_b64_v4i16((LAS v4i16_t*)p)); }

template <int DQK, int DV> struct AttnState { bf16x8 qf[DQK / 16]; f32x16 o[DV / 32]; f32x16 negm; float m, l; };
constexpr float ATT_THR = 8.0f;

template <int DQK, int DV, bool HAS_BIAS>
__device__ __forceinline__ void attn_tile(AttnState<DQK, DV>& st, const LAS unsigned char* Kt, const LAS unsigned char* Vt, int bias_mode, const LAS float* tab, int rel0, int nkeys, bool first, LAS float* wsf, int lane) {
    constexpr int PK = DQK * 2 + 16, PV = DV * 2 + 64, KS = DQK / 16, NDB = DV / 32;
    const int q = lane & 31, hi = lane >> 5;
    f32x16 p0, p1;
    const LAS unsigned char* kp = Kt + q * PK + hi * 16;
    bf16x8 ka[KS], kb[KS];
#pragma unroll
    for (int ks = 0; ks < KS; ++ks) { ka[ks] = *(const LAS bf16x8*)(kp + ks * 32); kb[ks] = *(const LAS bf16x8*)(kp + 32 * PK + ks * 32); }
    if (HAS_BIAS && bias_mode == 2) {
        asm volatile("" ::: "memory");
#pragma unroll
        for (int r = 0; r < 16; ++r) {
            const int k = crow(r, hi);
            const int i0 = min(max(rel0 + k + 128, 0), 191), i1 = min(max(rel0 + k + 160, 0), 191);
            p0[r] = tab[i0] + st.negm[r]; p1[r] = tab[i1] + st.negm[r];
        }
        p0 = __builtin_amdgcn_mfma_f32_32x32x16_bf16(ka[0], st.qf[0], p0, 0, 0, 0);
        p1 = __builtin_amdgcn_mfma_f32_32x32x16_bf16(kb[0], st.qf[0], p1, 0, 0, 0);
    } else {
        p0 = __builtin_amdgcn_mfma_f32_32x32x16_bf16(ka[0], st.qf[0], st.negm, 0, 0, 0);
        p1 = __builtin_amdgcn_mfma_f32_32x32x16_bf16(kb[0], st.qf[0], st.negm, 0, 0, 0);
    }
#pragma unroll
    for (int ks = 1; ks < KS; ++ks) {
        p0 = __builtin_amdgcn_mfma_f32_32x32x16_bf16(ka[ks], st.qf[ks], p0, 0, 0, 0);
        p1 = __builtin_amdgcn_mfma_f32_32x32x16_bf16(kb[ks], st.qf[ks], p1, 0, 0, 0);
    }
    const int q4 = (lane & 15) >> 2, blk = (lane >> 4) & 1, pp = lane & 3;
    const LAS unsigned char* vp = Vt + (4 * hi + q4) * PV + (16 * blk + 4 * pp) * 2;
    s16x4 vlo[2][4], vhi[2][4];
#pragma unroll
    for (int s4 = 0; s4 < 4; ++s4) { vlo[0][s4] = vtr(vp + (16 * s4) * PV); vhi[0][s4] = vtr(vp + (16 * s4 + 8) * PV); }
    __builtin_amdgcn_sched_barrier(0);
    if (nkeys < 64) {
#pragma unroll
        for (int r = 0; r < 16; ++r) { const int k = crow(r, hi); if (k >= nkeys) p0[r] = -1e30f; if (k + 32 >= nkeys) p1[r] = -1e30f; }
    }
    float mxa = __builtin_fmaxf(__builtin_fmaxf(p0[0], p0[1]), p1[0]), mxb = __builtin_fmaxf(__builtin_fmaxf(p0[2], p0[3]), p1[1]);
    mxa = __builtin_fmaxf(__builtin_fmaxf(mxa, p1[2]), p1[3]);
#pragma unroll
    for (int r = 4; r < 16; r += 4) {
        mxa = __builtin_fmaxf(__builtin_fmaxf(mxa, p0[r]), p0[r + 1]); mxb = __builtin_fmaxf(__builtin_fmaxf(mxb, p0[r + 2]), p0[r + 3]);
        mxa = __builtin_fmaxf(__builtin_fmaxf(mxa, p1[r]), p1[r + 1]); mxb = __builtin_fmaxf(__builtin_fmaxf(mxb, p1[r + 2]), p1[r + 3]);
    }
    const float mx = xmax32(__builtin_fmaxf(mxa, mxb));
    if (first || __any(mx > ATT_THR)) {
        const float dl = first ? mx : __builtin_fmaxf(mx, 0.f);
        st.m += dl;
#pragma unroll
        for (int r = 0; r < 16; ++r) { st.negm[r] = -st.m; p0[r] -= dl; p1[r] -= dl; }
        const float f = __builtin_amdgcn_exp2f(-dl);
        st.l *= f;
        if (hi == 0) wsf[q] = f;
#pragma unroll
        for (int r = 0; r < 16; ++r) { const float fr = wsf[crow(r, hi)];
#pragma unroll
            for (int db = 0; db < NDB; ++db) st.o[db][r] *= fr; }
    }
    float sum0 = 0.f, sum1 = 0.f;
#pragma unroll
    for (int r = 0; r < 16; ++r) { p0[r] = __builtin_amdgcn_exp2f(p0[r]); p1[r] = __builtin_amdgcn_exp2f(p1[r]); sum0 += p0[r]; sum1 += p1[r]; }
    st.l += sum0 + sum1;
    bf16x8 pf[4];
    pf[0] = pack8(p0[0], p0[1], p0[2], p0[3], p0[4], p0[5], p0[6], p0[7]);
    pf[1] = pack8(p0[8], p0[9], p0[10], p0[11], p0[12], p0[13], p0[14], p0[15]);
    pf[2] = pack8(p1[0], p1[1], p1[2], p1[3], p1[4], p1[5], p1[6], p1[7]);
    pf[3] = pack8(p1[8], p1[9], p1[10], p1[11], p1[12], p1[13], p1[14], p1[15]);
    __builtin_amdgcn_sched_barrier(0);
#pragma unroll
    for (int db = 0; db < NDB; ++db) {
        if (db + 1 < NDB) {
#pragma unroll
            for (int s4 = 0; s4 < 4; ++s4) { vlo[(db + 1) & 1][s4] = vtr(vp + (16 * s4) * PV + (db + 1) * 64); vhi[(db + 1) & 1][s4] = vtr(vp + (16 * s4 + 8) * PV + (db + 1) * 64); }
        }
#pragma unroll
        for (int s4 = 0; s4 < 4; ++s4) {
            const s16x4 lo = vlo[db & 1][s4], h4 = vhi[db & 1][s4];
            const bf16x8 vb = {lo[0], lo[1], lo[2], lo[3], h4[0], h4[1], h4[2], h4[3]};
            st.o[db] = __builtin_amdgcn_mfma_f32_32x32x16_bf16(pf[s4], vb, st.o[db], 0, 0, 0);
        }
        __builtin_amdgcn_sched_barrier(0);
    }
}

template <int DQK, int DV>
__device__ __forceinline__ void attn_init(AttnState<DQK, DV>& st) {
    st.m = 0.f; st.l = 0.f;
#pragma unroll
    for (int r = 0; r < 16; ++r) st.negm[r] = 0.f;
#pragma unroll
    for (int db = 0; db < DV / 32; ++db)
#pragma unroll
        for (int r = 0; r < 16; ++r) st.o[db][r] = 0.f;
}

template <bool DIFF>
__device__ __forceinline__ void attn_unit_coop(const Grp& G, int b, int h, int qb, int n, LAS unsigned char* lds, const int tid_in) {
    constexpr int DQK = DIFF ? 64 : 96, DV = DIFF ? 128 : 64, PK = DQK * 2 + 16, PV = DV * 2 + 64, KB = 64 * PK, VB = 64 * PV, TB = KB + VB, NDB = DV / 32;
    int tid_ = tid_in; asm volatile("" : "+v"(tid_));
    const int tid = tid_, lane = tid & 63, wid = __builtin_amdgcn_readfirstlane(tid >> 6), q = lane & 31, hi = lane >> 5;
    const size_t seq0 = (size_t)b * TS;
    const int qrow0 = qb * 256 + wid * 32;
    const int NT = 4 * qb + 4, my_nt = 4 * qb + (wid >> 1) + 1;
    const LAS float* tab = (const LAS float*)(lds + AL_TAB) + h * 192;
    LAS float* wsf = (LAS float*)(lds + AL_WSF) + wid * 64;
    LAS unsigned char* tiles = lds + AL_TILE;
    {
        AttnState<DQK, DV> st; attn_init(st);
        if (DIFF) { const bf16* qp = G.QD + (seq0 + qrow0 + q) * 1024 + h * 128 + n * 64 + hi * 8;
#pragma unroll
            for (int ks = 0; ks < 4; ++ks) st.qf[ks] = *(const bf16x8*)(qp + ks * 16);
        } else { const bf16* qn = G.QN + (seq0 + qrow0 + q) * 1024 + h * 64 + hi * 8; const bf16* qr = G.QR + (seq0 + qrow0 + q) * 512 + h * 32 + hi * 8;
#pragma unroll
            for (int ks = 0; ks < 4; ++ks) st.qf[ks] = *(const bf16x8*)(qn + ks * 16);
#pragma unroll
            for (int ks = 0; ks < 2; ++ks) st.qf[4 + ks] = *(const bf16x8*)(qr + ks * 16);
        }
        const bf16* ksrc = (DIFF ? G.KD + h * 128 + n * 64 : G.KN + h * 64) + (seq0 + (tid >> 3)) * 1024 + (tid & 7) * 8;
        const int kdst = (tid >> 3) * PK + (tid & 7) * 16;
        const bf16* k2src = G.KR + (seq0 + ((tid & 255) >> 2)) * 32 + (tid & 3) * 8;
        const int k2dst = ((tid & 255) >> 2) * PK + 128 + (tid & 3) * 16;
        const bf16* vsrc = DIFF ? G.VD + (seq0 + (tid >> 4)) * 1024 + h * 128 + (tid & 15) * 8 : G.VM + (seq0 + (tid >> 3)) * 1024 + h * 64 + (tid & 7) * 8;
        const int vdst = DIFF ? KB + (tid >> 4) * PV + (tid & 15) * 16 : KB + (tid >> 3) * PV + (tid & 7) * 16;
        u32x4 rkA, rk2A = {0u, 0u, 0u, 0u}, rv0A, rv1A = {0u, 0u, 0u, 0u}, rkB = {0u, 0u, 0u, 0u}, rk2B = {0u, 0u, 0u, 0u}, rv0B = {0u, 0u, 0u, 0u}, rv1B = {0u, 0u, 0u, 0u};
#define ATT_LOAD(S, j) do { rk##S = *(const u32x4*)(ksrc + (size_t)(j) * 64 * 1024); if (!DIFF && tid < 256) rk2##S = *(const u32x4*)(k2src + (size_t)(j) * 64 * 32); \
        rv0##S = *(const u32x4*)(vsrc + (size_t)(j) * 64 * 1024); if (DIFF) rv1##S = *(const u32x4*)(vsrc + (size_t)(j) * 64 * 1024 + 32 * 1024); } while (0)
#define ATT_STORE(S, bufp) do { *(LAS u32x4*)((bufp) + kdst) = rk##S; if (!DIFF && tid < 256) *(LAS u32x4*)((bufp) + k2dst) = rk2##S; \
        *(LAS u32x4*)((bufp) + vdst) = rv0##S; if (DIFF) *(LAS u32x4*)((bufp) + vdst + 32 * PV) = rv1##S; } while (0)
#define ATT_COMPUTE(j, bufp) do { if ((j) < my_nt) { const int kb_ = 64 * (j); const int mode_ = DIFF ? ((kb_ + 63 - qrow0 <= -128) ? 1 : 2) : 0; \
        attn_tile<DQK, DV, DIFF>(st, (bufp), (bufp) + KB, mode_, tab, kb_ - (qrow0 + q), 64, (j) == 0, wsf, lane); } } while (0)
        ATT_LOAD(A, 0); ATT_STORE(A, tiles);
        __syncthreads();
        ATT_LOAD(A, 1);
        for (int j = 0; j < NT; j += 2) {
            LAS unsigned char* b0 = tiles + (j & 1) * TB; LAS unsigned char* b1 = tiles + ((j + 1) & 1) * TB;
            if (j + 2 < NT) ATT_LOAD(B, j + 2);
            ATT_COMPUTE(j, b0);
            ATT_STORE(A, b1);
            __syncthreads();
            if (j + 3 < NT) ATT_LOAD(A, j + 3);
            ATT_COMPUTE(j + 1, b1);
            if (j + 2 < NT) ATT_STORE(B, b0);
            __syncthreads();
        }
#undef ATT_LOAD
#undef ATT_STORE
#undef ATT_COMPUTE
        const float lt = xsum32(st.l);
        if (hi == 0) wsf[32 + q] = lt;
        float inv[16];
#pragma unroll
        for (int r = 0; r < 16; ++r) inv[r] = 1.0f / wsf[32 + crow(r, hi)];
        bf16* obase = (DIFF ? (n == 0 ? G.DO : G.XN) + h * 128 : G.MO + h * 64) + (seq0 + qrow0) * 1024 + q;
#pragma unroll
        for (int db = 0; db < NDB; ++db)
#pragma unroll
            for (int r = 0; r < 16; ++r) obase[(size_t)crow(r, hi) * 1024 + db * 32] = (bf16)f2bf(st.o[db][r] * inv[r]);
    }
}

__device__ __forceinline__ void phase_diffmix(const Grp& G, float lam, const float* subln, int gw, int ngw, int lane) {
    const int c = (lane & 7) * 16;
    float g[16];
#pragma unroll
    for (int i = 0; i < 16; ++i) g[i] = subln[c + i] * 0.8f;
    for (int r = gw; r < G.nvalid; r += ngw) {
        bf16* p1 = G.DO + (size_t)r * 1024 + lane * 16; const bf16* p2 = G.XN + (size_t)r * 1024 + lane * 16;
        const u32x4 a0 = ((const u32x4*)p1)[0], a1 = ((const u32x4*)p1)[1], b0 = ((const u32x4*)p2)[0], b1 = ((const u32x4*)p2)[1];
        float v[16];
#pragma unroll
        for (int i = 0; i < 4; ++i) { v[2 * i] = bflo(a0[i]) - lam * bflo(b0[i]); v[2 * i + 1] = bfhi(a0[i]) - lam * bfhi(b0[i]);
                                      v[8 + 2 * i] = bflo(a1[i]) - lam * bflo(b1[i]); v[8 + 2 * i + 1] = bfhi(a1[i]) - lam * bfhi(b1[i]); }
        float s = 0.f;
#pragma unroll
        for (int i = 0; i < 16; ++i) s += v[i] * v[i];
        s += swz_xor<1>(s); s += swz_xor<2>(s); s += swz_xor<4>(s);
        const float rs = 1.0f / sqrtf(s * (1.f / 128.f) + EPSN);
        u32x4 o0, o1;
#pragma unroll
        for (int i = 0; i < 4; ++i) { o0[i] = pk2(v[2 * i] * rs * g[2 * i], v[2 * i + 1] * rs * g[2 * i + 1]); o1[i] = pk2(v[8 + 2 * i] * rs * g[8 + 2 * i], v[8 + 2 * i + 1] * rs * g[8 + 2 * i + 1]); }
        ((u32x4*)p1)[0] = o0; ((u32x4*)p1)[1] = o1;
    }
}

template <bool DIFF>
__device__ __forceinline__ void attn_unit_wave(const Grp& G, const unsigned char* cb, int b, int h, int n, int j0, int j1, int wu, float* PO, float* PM, float* PL,
                                               LAS unsigned char* wt, LAS float* wsf, const LAS float* tab0, int lane_in) {
    int lane = lane_in; asm volatile("" : "+v"(lane)); lane &= 63;
    constexpr int DQK = DIFF ? 64 : 96, DV = DIFF ? 128 : 64, PK = DQK * 2 + 16, PV = DV * 2 + 64, KB = 64 * PK, NDB = DV / 32;
    const int q = lane & 31, hi = lane >> 5;
    const LAS float* tab = tab0 + h * 192;
    AttnState<DQK, DV> st; attn_init(st);
    const size_t qrow = (size_t)b * ST + q;
    if (DIFF) { const bf16* qp = G.QD + qrow * 1024 + h * 128 + n * 64 + hi * 8;
#pragma unroll
        for (int ks = 0; ks < 4; ++ks) st.qf[ks] = *(const bf16x8*)(qp + ks * 16);
    } else { const bf16* qn = G.QN + qrow * 1024 + h * 64 + hi * 8; const bf16* qr = G.QR + qrow * 512 + h * 32 + hi * 8;
#pragma unroll
        for (int ks = 0; ks < 4; ++ks) st.qf[ks] = *(const bf16x8*)(qn + ks * 16);
#pragma unroll
        for (int ks = 0; ks < 2; ++ks) st.qf[4 + ks] = *(const bf16x8*)(qr + ks * 16);
    }
    for (int j = j0; j < j1; ++j) {
        const bf16 *kA, *kB2, *vA; int nkeys;
        if (j < 64) { const size_t r0 = (size_t)b * PAST + 64 * j; nkeys = 64;
            kA = DIFF ? (const bf16*)(cb + C_KDC) + r0 * 1024 + h * 128 + n * 64 : (const bf16*)(cb + C_KNC) + r0 * 1024 + h * 64;
            kB2 = (const bf16*)(cb + C_KRC) + r0 * 32;
            vA = DIFF ? (const bf16*)(cb + C_VDC) + r0 * 1024 + h * 128 : (const bf16*)(cb + C_VMC) + r0 * 1024 + h * 64;
        } else { const size_t r0 = (size_t)b * ST; nkeys = ST;
            kA = DIFF ? G.KD + r0 * 1024 + h * 128 + n * 64 : G.KN + r0 * 1024 + h * 64;
            kB2 = G.KR + r0 * 32;
            vA = DIFF ? G.VD + r0 * 1024 + h * 128 : G.VM + r0 * 1024 + h * 64;
        }
        { u32x4 t[8];
#pragma unroll
            for (int i = 0; i < 8; ++i) { const int idx = lane + 64 * i; t[i] = *(const u32x4*)(kA + (size_t)(idx >> 3) * 1024 + (idx & 7) * 8); }
#pragma unroll
            for (int i = 0; i < 8; ++i) { const int idx = lane + 64 * i; *(LAS u32x4*)(wt + (idx >> 3) * PK + (idx & 7) * 16) = t[i]; } }
        if (!DIFF) { u32x4 t[4];
#pragma unroll
            for (int i = 0; i < 4; ++i) { const int idx = lane + 64 * i; t[i] = *(const u32x4*)(kB2 + (size_t)(idx >> 2) * 32 + (idx & 3) * 8); }
#pragma unroll
            for (int i = 0; i < 4; ++i) { const int idx = lane + 64 * i; *(LAS u32x4*)(wt + (idx >> 2) * PK + 128 + (idx & 3) * 16) = t[i]; } }
        if (DIFF) {
#pragma unroll
            for (int hf = 0; hf < 2; ++hf) { u32x4 t[8];
#pragma unroll
                for (int i = 0; i < 8; ++i) { const int idx = lane + 64 * i + 512 * hf; t[i] = *(const u32x4*)(vA + (size_t)(idx >> 4) * 1024 + (idx & 15) * 8); }
#pragma unroll
                for (int i = 0; i < 8; ++i) { const int idx = lane + 64 * i + 512 * hf; *(LAS u32x4*)(wt + KB + (idx >> 4) * PV + (idx & 15) * 16) = t[i]; } }
        } else { u32x4 t[8];
#pragma unroll
            for (int i = 0; i < 8; ++i) { const int idx = lane + 64 * i; t[i] = *(const u32x4*)(vA + (size_t)(idx >> 3) * 1024 + (idx & 7) * 8); }
#pragma unroll
            for (int i = 0; i < 8; ++i) { const int idx = lane + 64 * i; *(LAS u32x4*)(wt + KB + (idx >> 3) * PV + (idx & 7) * 16) = t[i]; } }
        const int kb = 64 * j;
        const int mode = DIFF ? ((j <= 61) ? 1 : 2) : 0;
        attn_tile<DQK, DV, DIFF>(st, wt, wt + KB, mode, tab, kb - (PAST + q), nkeys, j == j0, wsf, lane);
    }
    const float lt = xsum32(st.l);
    if (hi == 0) { PM[wu * 32 + q] = st.m; PL[wu * 32 + q] = lt; }
#pragma unroll
    for (int db = 0; db < NDB; ++db)
#pragma unroll
        for (int r = 0; r < 16; ++r) PO[((size_t)wu * 32 + crow(r, hi)) * DV + db * 32 + q] = st.o[db][r];
}

__device__ __forceinline__ void phase_combine(const Grp& G, const float* POd, const float* POm, const float* PM, const float* PL, float lam, const float* subln, int gw, int ngw, int lane) {
    for (int it = gw; it < SB * 8 * ST + SB * 16 * ST; it += ngw) {
        if (it < SB * 8 * ST) {
            const int qq = it & 15, h = (it >> 4) & 7, b = it >> 7;
            float val[2] = {0.f, 0.f};
#pragma unroll
            for (int n = 0; n < 2; ++n) {
                const int wu0 = ((b * 8 + h) * 2 + n) * NSPLIT;
                float M = -1e30f;
#pragma unroll
                for (int s = 0; s < NSPLIT; ++s) M = fmaxf(M, PM[(wu0 + s) * 32 + qq]);
                float L = 0.f, a0 = 0.f, a1 = 0.f;
#pragma unroll
                for (int s = 0; s < NSPLIT; ++s) { const float w = __builtin_amdgcn_exp2f(PM[(wu0 + s) * 32 + qq] - M); L += PL[(wu0 + s) * 32 + qq] * w;
                    const float* po = POd + ((size_t)(wu0 + s) * 32 + qq) * 128; a0 += po[lane] * w; a1 += po[lane + 64] * w; }
                const float sc = (n == 0 ? 1.f : -lam) / L;
                val[0] += a0 * sc; val[1] += a1 * sc;
            }
            const float ss = wave_sum(val[0] * val[0] + val[1] * val[1]);
            const float rs = 0.8f / sqrtf(ss * (1.f / 128.f) + EPSN);
            bf16* o = G.DO + (size_t)(b * ST + qq) * 1024 + h * 128;
            o[lane] = (bf16)f2bf(val[0] * rs * subln[lane]); o[lane + 64] = (bf16)f2bf(val[1] * rs * subln[lane + 64]);
        } else {
            const int i2 = it - SB * 8 * ST; const int qq = i2 & 15, h = (i2 >> 4) & 15, b = i2 >> 8;
            const int wu0 = 512 + (b * 16 + h) * NSPLIT;
            float M = -1e30f;
#pragma unroll
            for (int s = 0; s < NSPLIT; ++s) M = fmaxf(M, PM[(wu0 + s) * 32 + qq]);
            float L = 0.f, a0 = 0.f;
#pragma unroll
            for (int s = 0; s < NSPLIT; ++s) { const float w = __builtin_amdgcn_exp2f(PM[(wu0 + s) * 32 + qq] - M); L += PL[(wu0 + s) * 32 + qq] * w;
                a0 += POm[((size_t)(wu0 - 512 + s) * 32 + qq) * 64 + lane] * w; }
            G.MO[(size_t)(b * ST + qq) * 1024 + h * 64 + lane] = (bf16)f2bf(a0 / L);
        }
    }
}

__device__ __forceinline__ void diffmix_block(const Grp& G, int b, int h, int qb, float lam, const float* subln, int tid) {
    const int lane = tid & 63, wid = tid >> 6;
    const float g0 = subln[2 * lane] * 0.8f, g1 = subln[2 * lane + 1] * 0.8f;
    const size_t row0 = (size_t)b * TS + qb * 256 + wid * 32;
#pragma unroll 4
    for (int r = 0; r < 32; ++r) {
        unsigned* p1 = (unsigned*)(G.DO + (row0 + r) * 1024 + h * 128) + lane; const unsigned* p2 = (const unsigned*)(G.XN + (row0 + r) * 1024 + h * 128) + lane;
        const unsigned a = *p1, c = *p2;
        const float v0 = bflo(a) - lam * bflo(c), v1 = bfhi(a) - lam * bfhi(c);
        const float ss = wave_sum(v0 * v0 + v1 * v1);
        const float rs = 1.0f / sqrtf(ss * (1.f / 128.f) + EPSN);
        *p1 = pk2(v0 * rs * g0, v1 * rs * g1);
    }
}

__device__ __forceinline__ void phase_attention(const Args& a, const Grp& G, LAS unsigned char* lds, const int tid_in) {
    int tid_ = tid_in; asm volatile("" : "+v"(tid_));
    const int tid = tid_, lane = tid & 63, wid = __builtin_amdgcn_readfirstlane(tid >> 6);
    const float* tabg = (const float*)(a.ws + WS_TAB);
    for (int i = tid; i < 8 * 192; i += 512) ((LAS float*)(lds + AL_TAB))[i] = tabg[i];
    const float lam = tabg[1536];
    const float* subln = a.in[13];
    __syncthreads();
    if (G.sample) {
        if (wid < 4) {
            constexpr int TBD = 64 * (64 * 2 + 16) + 64 * (128 * 2 + 64);
            LAS unsigned char* wt = lds + AL_TILE + wid * TBD;
            LAS float* wsf = (LAS float*)(lds + AL_WSF) + wid * 64;
            const LAS float* tab0 = (const LAS float*)(lds + AL_TAB);
            const unsigned char* cb = a.ws + WS_PROMPT;
            for (int wu = (int)blockIdx.x * 4 + wid; wu < 1024; wu += (int)gridDim.x * 4) {
                const int s = wu & 3; const int j0 = s == 0 ? 0 : 17 + 16 * (s - 1), j1 = 17 + 16 * s;
                if (wu < 512) {
#if ATTMASK & 1
 const int n = (wu >> 2) & 1, h = (wu >> 3) & 7, b = wu >> 6;
                    attn_unit_wave<true>(G, cb, b, h, n, j0, j1, wu, (float*)(a.ws + WS_PO_D), (float*)(a.ws + WS_PM), (float*)(a.ws + WS_PL), wt, wsf, tab0, tid);
#endif
                } else {
#if ATTMASK & 2
 const int i2 = wu - 512; const int h = (i2 >> 2) & 15, b = i2 >> 6;
                    attn_unit_wave<false>(G, cb, b, h, 0, j0, j1, wu, (float*)(a.ws + WS_PO_M) - (size_t)512 * 32 * 64, (float*)(a.ws + WS_PM), (float*)(a.ws + WS_PL), wt, wsf, tab0, tid);
#endif
                }
            }
        }
    } else {
        const int Gn = (int)gridDim.x, bx = (int)blockIdx.x;
        const int vcu = (Gn % 8 == 0) ? (bx % 8) * (Gn / 8) + bx / 8 : bx;
        for (int v = vcu; v < 256; v += Gn) {
            const int p = v & 3;
#if ATTMASK & 4
            for (int r = 0; r < GBATCH * 8 / 64; ++r) { const int bh = r * 64 + (v >> 2), b = bh >> 3, h = bh & 7;
                for (int n = 0; n < 2; ++n)
                    for (int i = 0; i < 2; ++i) attn_unit_coop<true>(G, b, h, i ? p : 7 - p, n, lds, tid_in);
                asm volatile("s_waitcnt vmcnt(0)" ::: "memory"); __syncthreads();
                int t2 = tid_in; asm volatile("" : "+v"(t2));
                diffmix_block(G, b, h, 7 - p, lam, subln, t2); diffmix_block(G, b, h, p, lam, subln, t2); }
#endif
#if ATTMASK & 8
            for (int r = 0; r < GBATCH * 16 / 64; ++r) { const int bh = r * 64 + (v >> 2), b = bh >> 4, h = bh & 15;
                for (int i = 0; i < 2; ++i) attn_unit_coop<false>(G, b, h, i ? p : 7 - p, 0, lds, tid_in); }
#endif
        }
    }
}

constexpr int LDS_BYTES = 147456;
#ifndef PHMASK
#define PHMASK 0xffff
#endif

#define XB_TMO      128
#define XB_XCNT(j)  (256  + 64 * (j))
#define XB_XSUB(j)  (1280 + 64 * (j))
#define XB_XGEN(j)  (2304 + 64 * (j))
#define XB_TOP      3328
#define XB_TOPGEN   3392
#define XCD_BAR_WORDS 3456
#define XB_SPIN_CAP (1u << 18)

__device__ __forceinline__ unsigned xb_ld(unsigned* p)              { return __hip_atomic_load(p, __ATOMIC_RELAXED, __HIP_MEMORY_SCOPE_AGENT); }
__device__ __forceinline__ unsigned xb_add(unsigned* p, unsigned v) { return __hip_atomic_fetch_add(p, v, __ATOMIC_RELAXED, __HIP_MEMORY_SCOPE_AGENT); }
__device__ __forceinline__ unsigned xb_xcc_id() { return (unsigned)__builtin_amdgcn_s_getreg((3 << 11) | 20) & 0xFu; }
#define XB_SPIN(cond, bar) do { unsigned _sp = 0; while (cond) { __builtin_amdgcn_s_sleep(1); \
    if ((++_sp & 255u) == 0u) { if (xb_ld(&(bar)[XB_TMO])) break; if (_sp > XB_SPIN_CAP) { atomicAdd(&(bar)[XB_TMO], 1u); break; } } } } while (0)

struct XcdBarrier {
    unsigned* bar; unsigned x;
    volatile LAS unsigned* st;
};

__device__ __forceinline__ XcdBarrier xcd_barrier_post(unsigned* bar, volatile LAS unsigned* st) {
    XcdBarrier b; b.bar = bar; b.x = xb_xcc_id(); b.st = st;
    if (threadIdx.x == 0) (void)xb_add(&bar[XB_XCNT(b.x)], 1u);
    return b;
}
__device__ __forceinline__ void xcd_barrier_complete(unsigned* bar, unsigned x, unsigned& nloc, unsigned& nx) {
    const unsigned G = gridDim.x * gridDim.y * gridDim.z;
    unsigned sum, cnt, mine, sp = 0u;
    for (;;) {
        sum = 0u; cnt = 0u; mine = 0u;
#pragma unroll
        for (unsigned j = 0; j < 16; ++j) { const unsigned c = xb_ld(&bar[XB_XCNT(j)]); sum += c; cnt += (c > 0u) ? 1u : 0u; mine = (j == x) ? c : mine; }
        if (sum == G) break;
        __builtin_amdgcn_s_sleep(1);
        if ((++sp & 255u) == 0u) { if (xb_ld(&bar[XB_TMO])) break; if (sp > XB_SPIN_CAP) { atomicAdd(&bar[XB_TMO], 1u); break; } }
    }
    nloc = mine > 0u ? mine : 1u; nx = cnt > 0u ? cnt : 1u;
}

__device__ __forceinline__ void xcd_barrier(const XcdBarrier& b, const bool is_t0) {
    asm volatile("s_waitcnt vmcnt(0)" ::: "memory");
    __syncthreads();
    if (is_t0) {
        unsigned* bar = b.bar;
        __builtin_amdgcn_s_waitcnt(0);
        unsigned nloc = b.st[0], nx = b.st[1];
        if (nloc == 0u) { xcd_barrier_complete(bar, b.x, nloc, nx); b.st[0] = nloc; b.st[1] = nx; }
        const unsigned old = xb_add(&bar[XB_XSUB(b.x)], 1u);
        const unsigned gen = old / nloc;
        if (old + 1u == (gen + 1u) * nloc) {
            __builtin_amdgcn_fence(__ATOMIC_RELEASE, "agent");
            asm volatile("s_waitcnt vmcnt(0)" ::: "memory");
            const unsigned og = xb_add(&bar[XB_TOP], 1u);
            const unsigned tg = og / nx;
            if (og + 1u == (tg + 1u) * nx) xb_add(&bar[XB_TOPGEN], 1u);
            else XB_SPIN(xb_ld(&bar[XB_TOPGEN]) == tg, bar);
            __builtin_amdgcn_fence(__ATOMIC_ACQUIRE, "agent");
            xb_add(&bar[XB_XGEN(b.x)], 1u);
            asm volatile("s_waitcnt vmcnt(0)" ::: "memory");
        } else {
            XB_SPIN(xb_ld(&bar[XB_XGEN(b.x)]) == gen, bar);
            __builtin_amdgcn_fence(__ATOMIC_ACQUIRE, "agent");
            asm volatile("s_waitcnt vmcnt(0)" ::: "memory");
        }
    }
    __syncthreads();
}

constexpr size_t WS_BAR = 786432;
constexpr int LDS_BARST = 131072 + 512;
constexpr int LDS_PTAB = 131072;
__device__ __forceinline__ const void* lds_ptr(LAS const unsigned long long* pt, int i) {
    const unsigned long long v = pt[i];
    const unsigned lo = __builtin_amdgcn_readfirstlane((unsigned)v), hi = __builtin_amdgcn_readfirstlane((unsigned)(v >> 32));
    return (const void*)(const __attribute__((address_space(1))) void*)(((unsigned long long)hi << 32) | lo);
}
__device__ __forceinline__ Args load_args(LAS unsigned char* lds) {
    int z = 0; asm volatile("" : "+s"(z));
    LAS const unsigned long long* pt = (LAS const unsigned long long*)(lds + LDS_PTAB + z);
    Args a;
#pragma unroll
    for (int i = 0; i < 26; ++i) a.in[i] = (const float*)lds_ptr(pt, i);
    a.out = (float*)lds_ptr(pt, 26); a.ws = (unsigned char*)lds_ptr(pt, 27); a.pad0 = 0; a.pad1 = 0;
    return a;
}
#define GBAR() do { int z_ = 0; asm volatile("" : "+s"(z_)); XcdBarrier b_; b_.bar = (unsigned*)((unsigned char*)lds_ptr((LAS const unsigned long long*)(lds + LDS_PTAB + z_), 27) + WS_BAR); \
    b_.x = xb_xcc_id(); b_.st = (volatile LAS unsigned*)(lds + LDS_BARST + z_); xcd_barrier(b_, s_wave == 0 && __builtin_amdgcn_mbcnt_hi(~0u, __builtin_amdgcn_mbcnt_lo(~0u, (unsigned)z_)) == 0u); } while (0)
#define PH_BEGIN int w_ = s_wave, g_ = g; asm volatile("" : "+s"(w_), "+s"(g_)); int zz_ = 0; asm volatile("" : "+s"(zz_)); int lane_ = (int)__builtin_amdgcn_mbcnt_hi(~0u, __builtin_amdgcn_mbcnt_lo(~0u, (unsigned)zz_)); asm volatile("" : "+v"(lane_)); const int lane = lane_, wave = w_, tid_ = w_ * 64 + lane; (void)tid_; \
    const int gw = (int)blockIdx.x * 8 + wave, ngw = (int)gridDim.x * 8; const Args a = load_args(lds); unsigned char* ws = a.ws; const float* rope = (const float*)(ws + WS_ROPE); (void)rope; const Grp G = make_grp(a, g_); const int M = G.ntiles * 256; (void)lane; (void)gw; (void)ngw; (void)M;
__global__ void __launch_bounds__(512, 2) fwd_megakernel(Args ka) {
    extern __shared__ __attribute__((aligned(16))) unsigned char lds_raw[];
    LAS unsigned char* lds = (LAS unsigned char*)lds_raw;
    cg::grid_group grid = cg::this_grid();
    if (threadIdx.x == 0) {
        LAS unsigned long long* pt = (LAS unsigned long long*)(lds + LDS_PTAB);
#pragma unroll
        for (int i = 0; i < 26; ++i) pt[i] = (unsigned long long)ka.in[i];
        pt[26] = (unsigned long long)ka.out; pt[27] = (unsigned long long)ka.ws;
    }
    if (threadIdx.x == 0) { ((LAS unsigned*)(lds + LDS_BARST))[0] = 0u; ((LAS unsigned*)(lds + LDS_BARST))[1] = 0u; }
    __syncthreads();
    const int s_wave = __builtin_amdgcn_readfirstlane((int)threadIdx.x >> 6);
    (void)xcd_barrier_post((unsigned*)(ka.ws + WS_BAR), (volatile LAS unsigned*)(lds + LDS_BARST));
#if PHMASK & 1
    { const int tid = threadIdx.x, lane = tid & 63, wave = __builtin_amdgcn_readfirstlane(tid >> 6); const Args a = load_args(lds);
      phase_prologue(a, lds, (int)blockIdx.x * 8 + wave, (int)gridDim.x * 8, lane, wave); }
#endif
    if (ka.pad0 == 0x5a17) grid.sync();
    { const int g = 0; (void)g; GBAR(); }

#pragma unroll 1
    for (int g = 0; g < NGRP; ++g) {
        { PH_BEGIN rms_rows_bf16(G.x, G.XN, a.in[7], G.nvalid, M, gw, ngw, lane); }
        GBAR();
#if PHMASK & 2
        { PH_BEGIN EpiIn E{G.QD, G.KD, G.VD, G.GD, G.GM, G.ZS, G.okd, G.ovd, G.nvalid, 0.125f * LOG2E};
          run_gemm(lds, G.XN, (const bf16*)(ws + WS_WIN), M, NIN, 1024, E, tid_); }
#endif
        GBAR();
        { PH_BEGIN phase_small(G, a.in[14], a.in[16], rope, gw, ngw, lane); }
        GBAR();
#if PHMASK & 4
        { PH_BEGIN EpiQ E{G.QN, G.QR, rope, G.sample, 0.10206207261596575f * LOG2E};
          run_gemm(lds, G.CQ, (const bf16*)(ws + WS_WUQ), M, 1536, 256, E, tid_); }
#endif
#if PHMASK & 8
        { PH_BEGIN EpiKV E{G.KN, G.VM};
          run_gemm(lds, G.CKV, (const bf16*)(ws + WS_WUKV), M, 2048, 256, E, tid_); }
        if (g == 0) { PH_BEGIN EpiKV E{(bf16*)(ws + WS_PROMPT + C_KNC), (bf16*)(ws + WS_PROMPT + C_VMC)};
          run_gemm(lds, (const bf16*)(ws + WS_PROMPT + C_CKVC), (const bf16*)(ws + WS_WUKV), CACHE_ROWS, 2048, 256, E, tid_); }
#endif
        GBAR();
#if PHMASK & 16
        { PH_BEGIN phase_attention(a, G, lds, tid_); }
#endif
        GBAR();
        if (g == 0) {
            { PH_BEGIN phase_combine(G, (const float*)(ws + WS_PO_D), (const float*)(ws + WS_PO_M), (const float*)(ws + WS_PM), (const float*)(ws + WS_PL), ((const float*)(ws + WS_TAB))[1536], a.in[13], gw, ngw, lane); }
            GBAR();
        }
#if PHMASK & 32
        { PH_BEGIN EpiM1 E{G.GD, G.XN}; run_gemm(lds, G.DO, (const bf16*)(ws + WS_WOD), M, 1024, 1024, E, tid_); }
        { PH_BEGIN EpiM2 E{G.GM, G.XN}; run_gemm(lds, G.MO, (const bf16*)(ws + WS_WOM), M, 1024, 1024, E, tid_); }
#endif
        GBAR();
#if PHMASK & 64
        { PH_BEGIN EpiOut E{G.x, G.y, G.nvalid}; run_gemm(lds, G.XN, (const bf16*)(ws + WS_WOUT), M, 1024, 1024, E, tid_); }
#endif
        GBAR();
        { PH_BEGIN rms_rows_bf16(G.y, G.XN, a.in[22], G.nvalid, M, gw, ngw, lane); }
        GBAR();
#if PHMASK & 128
        { PH_BEGIN EpiUp E{G.U}; run_gemm(lds, G.XN, (const bf16*)(ws + WS_WUP), M, 4096, 1024, E, tid_); }
#endif
        GBAR();
#if PHMASK & 256
        if (g == 0) {
#pragma unroll 1
            for (int sk = 0; sk < 8; ++sk) { PH_BEGIN int s_ = sk; asm volatile("" : "+s"(s_)); EpiDownAtomic E{G.y, G.nvalid};
                run_gemm(lds, G.U + s_ * 512, (const bf16*)(ws + WS_WDN) + s_ * 512, M, 1024, 512, E, tid_, 4096, 4 * s_); }
        } else
        { PH_BEGIN EpiDown E{G.y, G.nvalid}; run_gemm(lds, G.U, (const bf16*)(ws + WS_WDN), M, 1024, 4096, E, tid_); }
#endif
        GBAR();
        { PH_BEGIN rms_rows_f32_inplace(G.y, a.in[25], G.nvalid, gw, ngw, lane); }
    }
}

extern "C" void kernel_launch(void* const* d_in, const int* in_sizes, int n_in, void* d_out, int out_size, void* d_ws, size_t ws_size, hipStream_t stream) {
    static int grid = 0;
    if (grid == 0) {
        if (n_in != 26 || ws_size < WS_NEED) { fprintf(stderr, "kernel_launch: need 26 inputs and %zu bytes of workspace; got %d, %zu\n", (size_t)WS_NEED, n_in, ws_size); grid = -1; return; }
        int dev = 0, cus = 0, per_cu = 0;
        if (hipGetDevice(&dev) != hipSuccess || hipDeviceGetAttribute(&cus, hipDeviceAttributeMultiprocessorCount, dev) != hipSuccess) { grid = -1; return; }
        if (hipFuncSetAttribute((const void*)fwd_megakernel, hipFuncAttributeMaxDynamicSharedMemorySize, LDS_BYTES) != hipSuccess) { fprintf(stderr, "kernel_launch: hipFuncSetAttribute failed\n"); grid = -1; return; }
        if (hipOccupancyMaxActiveBlocksPerMultiprocessor(&per_cu, (const void*)fwd_megakernel, 512, LDS_BYTES) != hipSuccess || per_cu < 1) { fprintf(stderr, "kernel_launch: occupancy query says %d\n", per_cu); per_cu = 1; }
        (void)hipGetLastError();
        grid = cus;
    }
    if (grid < 0) return;
    if (hipMemsetAsync((char*)d_ws + WS_BAR, 0, 16384, stream) != hipSuccess) { fprintf(stderr, "kernel_launch: memset failed\n"); return; }
    Args a{};
    for (int i = 0; i < 26; ++i) a.in[i] = (const float*)d_in[i];
    a.out = (float*)d_out; a.ws = (unsigned char*)d_ws;
    void* args[] = {&a};
    hipError_t e = hipLaunchCooperativeKernel((const void*)fwd_megakernel, dim3(grid), dim3(512), args, LDS_BYTES, stream);
    if (e != hipSuccess) fprintf(stderr, "kernel_launch: cooperative launch failed: %s (grid %d)\n", hipGetErrorString(e), grid);
}
```

```cpp
#include <hip/hip_runtime.h>
#include <hip/hip_cooperative_groups.h>
#include <cstdio>
#include <cstdint>
namespace cg = cooperative_groups;
namespace pg8 {
#define PG8_LAS __attribute__((address_space(3)))
typedef unsigned short bf16_t;
typedef short bf16x8 __attribute__((ext_vector_type(8)));
typedef float f32x4 __attribute__((ext_vector_type(4)));
typedef unsigned u32x4 __attribute__((ext_vector_type(4)));
constexpr int BM = 256, BK = 64, HALF = 128, HTB = HALF * BK * 2  , STAGE_BYTES = 8 * HTB, NXCD = 8, WGM = 8;

__host__ __device__ __forceinline__ int lds_byte(int r, int c) { const int st = (r >> 4) * 2 + (c >> 5), rr = r & 15, cc = c & 31, ob = rr * 64 + cc * 2; return st * 1024 + (ob ^ (((ob >> 9) & 1) << 5)); }
__host__ __device__ __forceinline__ void stage_rc(int b, int& R, int& C) { const int st = b / 1024, sb = b % 1024, swz = sb ^ (((sb >> 9) & 1) << 5); R = (st >> 1) * 16 + swz / 64; C = (st & 1) * 32 + (swz % 64) / 2; }
__host__ __device__ __forceinline__ int perm32(int rho) { const int n = rho >> 4, i = rho & 15; return 8 * (i >> 2) + 4 * n + (i & 3); }

struct Unit { int pm, pn; };
struct Gemm { const bf16_t* A; const bf16_t* Bt; int M, N, K, ld; };

struct StaticOrder {
    int nM, nN, nwg, G, c;
    __host__ __device__ void init(int M, int N, int G_, int c_) { nM = M / BM; nN = N / BM; nwg = nM * nN; G = G_; c = c_; }
    __host__ __device__ bool next(int i, Unit& u) const {
        const long L = (long)i * G + c; if (L >= nwg) return false;
        int wgid = (int)L; { const int q = nwg / NXCD, r = nwg % NXCD, xcd = wgid % NXCD, off = wgid / NXCD; wgid = (xcd < r ? xcd * (q + 1) : r * (q + 1) + (xcd - r) * q) + off; }
        const int nig = WGM * nN, gid = wgid / nig, fm = gid * WGM, gsz = (nM - fm) < WGM ? (nM - fm) : WGM;
        u.pm = fm + ((wgid % nig) % gsz); u.pn = (wgid % nig) / gsz; return true;
    }
    __device__ __forceinline__ void a_ready(const Unit&) const {}
    __device__ __forceinline__ void done(const Unit&) const {}
};

__device__ __forceinline__ unsigned cvt_pk_bf16(float lo, float hi) { unsigned r; asm volatile("v_cvt_pk_bf16_f32 %0, %1, %2" : "=v"(r) : "v"(lo), "v"(hi)); return r; }
typedef float f32x2 __attribute__((ext_vector_type(2)));
template <class Epi, class Sched, bool ALIGN_EPI = false, bool SP2 = false>
__device__ __forceinline__ void gemm_phase(PG8_LAS unsigned char* lds, const Gemm g, const Sched& S, const Epi& E, const int tid_in) {
    int tid_ = tid_in; asm volatile("" : "+v"(tid_));
    const int tid = tid_, wid = __builtin_amdgcn_readfirstlane(tid >> 6), lane = tid & 63, wr = wid >> 2, wc = wid & 3, fr = lane & 15, fq = lane >> 4;
    const int K = g.K, nt = K / BK, LD = g.ld;
    unsigned voffA[2], voffB[2];
#pragma unroll
    for (int i = 0; i < 2; ++i) { int R, C; stage_rc(tid * 16 + i * 8192, R, C); const int Rb = Epi::PERM ? ((R & ~31) + perm32(R & 31)) : R;
        voffA[i] = (unsigned)(R * LD + C) * 2u; voffB[i] = (unsigned)(Rb * LD + C) * 2u; }
    const size_t kstep = (size_t)(BK * 2);
    const size_t hstep = (size_t)HALF * LD * 2;
    const size_t tstep = 2 * hstep;
    const unsigned ldsw = (unsigned)wid * 1024u;
    const int aoff = lds_byte(wr * 64 + fr, fq * 8), boff = lds_byte(wc * 32 + fr, fq * 8);
#define PG8_SA(b, h) (((b) * 2 + (h)) * HTB)
#define PG8_SB(b, h) ((4 + (b) * 2 + (h)) * HTB)
#define PG8_STAGE(bufoff, gbase, voff) do { _Pragma("unroll") for (int _i = 0; _i < 2; ++_i) \
        __builtin_amdgcn_global_load_lds((const unsigned*)((const char*)(gbase) + (voff)[_i]), (PG8_LAS unsigned*)(lds + (bufoff) + ldsw + _i * 8192), 16, 0, 0); } while (0)
#define PG8_LDA(dst, b, h) do { _Pragma("unroll") for (int m = 0; m < 4; ++m) _Pragma("unroll") for (int k = 0; k < 2; ++k) dst[m][k] = *(const PG8_LAS bf16x8*)(lds + PG8_SA(b, h) + aoff + m * 2048 + k * 1024); } while (0)
#define PG8_LDB(dst, b, h) do { _Pragma("unroll") for (int n = 0; n < 2; ++n) _Pragma("unroll") for (int k = 0; k < 2; ++k) dst[n][k] = *(const PG8_LAS bf16x8*)(lds + PG8_SB(b, h) + boff + n * 2048 + k * 1024); } while (0)
#define PG8_MMA(ai, bj, At, Bt) do { __builtin_amdgcn_s_setprio(1); _Pragma("unroll") for (int m = 0; m < 4; ++m) _Pragma("unroll") for (int n = 0; n < 2; ++n) _Pragma("unroll") for (int k = 0; k < 2; ++k) \
        acc[ai][bj][m][n] = __builtin_amdgcn_mfma_f32_16x16x32_bf16(Bt[n][k], At[m][k], acc[ai][bj][m][n], 0, 0, 0); __builtin_amdgcn_s_setprio(0); } while (0)
#define PG8_WAIT_V(n) asm volatile("s_waitcnt vmcnt(" #n ")" ::: "memory")
#define PG8_WAIT_L(n) asm volatile("s_waitcnt lgkmcnt(" #n ")" ::: "memory")
#define PG8_BAR __builtin_amdgcn_s_barrier()
#define PG8_SCHED __builtin_amdgcn_sched_barrier(0)
    Unit cur, nxt; int ui = 0;
    if (!S.next(0, cur)) return;
    f32x4 acc[2][2][4][2];
#pragma unroll
    for (int a = 0; a < 2; ++a)
#pragma unroll
        for (int b = 0; b < 2; ++b)
#pragma unroll
            for (int m = 0; m < 4; ++m)
#pragma unroll
                for (int n = 0; n < 2; ++n) acc[a][b][m][n] = (f32x4){0.f, 0.f, 0.f, 0.f};
    bf16x8 At[4][2], B0[2][2], B1[2][2];
    const char* cA = (const char*)g.A + (size_t)cur.pm * tstep; const char* cB = (const char*)g.Bt + (size_t)cur.pn * tstep;
    S.a_ready(cur);
    if constexpr (SP2) {
        PG8_STAGE(PG8_SB(0, 0), cB, voffB); PG8_STAGE(PG8_SB(0, 1), cB + hstep, voffB); PG8_STAGE(PG8_SA(0, 0), cA, voffA); PG8_STAGE(PG8_SA(0, 1), cA + hstep, voffA);
        if (wr == 1) PG8_BAR;
        PG8_WAIT_V(2); PG8_BAR;
        PG8_STAGE(PG8_SB(1, 0), cB + kstep, voffB); PG8_STAGE(PG8_SA(1, 0), cA + kstep, voffA); PG8_STAGE(PG8_SB(1, 1), cB + hstep + kstep, voffB);
        PG8_WAIT_V(6); PG8_BAR;
    } else {
        PG8_STAGE(PG8_SB(0, 0), cB, voffB); PG8_STAGE(PG8_SA(0, 0), cA, voffA); PG8_STAGE(PG8_SB(0, 1), cB + hstep, voffB); PG8_STAGE(PG8_SA(0, 1), cA + hstep, voffA);
        if (wr == 1) PG8_BAR;
        PG8_WAIT_V(4); PG8_BAR;
        PG8_STAGE(PG8_SB(1, 0), cB + kstep, voffB); PG8_STAGE(PG8_SA(1, 0), cA + kstep, voffA); PG8_STAGE(PG8_SB(1, 1), cB + hstep + kstep, voffB);
        PG8_WAIT_V(6); PG8_BAR;
    }
    for (;;) {
        const bool has_next = S.next(ui + 1, nxt);
        const char* nA = has_next ? (const char*)g.A + (size_t)nxt.pm * tstep : cA; const char* nB = has_next ? (const char*)g.Bt + (size_t)nxt.pn * tstep : cB;
        for (int t = 0; t < nt; t += 2) {
            const bool last = (t == nt - 2);
            const char* a1 = cA + (size_t)(t + 1) * kstep;
            const char* a2 = last ? nA : cA + (size_t)(t + 2) * kstep; const char* b2 = last ? nB : cB + (size_t)(t + 2) * kstep;
            const char* a3 = a2 + kstep; const char* b3 = b2 + kstep;
            if (last && has_next) S.a_ready(nxt);
            if constexpr (SP2) {
            PG8_LDB(B0, 0, 0); PG8_LDB(B1, 0, 1); PG8_SCHED; PG8_LDA(At, 0, 0); PG8_STAGE(PG8_SA(1, 1), a1 + hstep, voffA);
            PG8_WAIT_V(8); PG8_WAIT_L(0); PG8_BAR; PG8_MMA(0, 0, At, B0); PG8_MMA(0, 1, At, B1); PG8_BAR; PG8_SCHED;
            PG8_LDA(At, 0, 1); PG8_STAGE(PG8_SB(0, 0), b2, voffB); PG8_STAGE(PG8_SB(0, 1), b2 + hstep, voffB); PG8_STAGE(PG8_SA(0, 0), a2, voffA);
            PG8_WAIT_V(8); PG8_WAIT_L(0); PG8_BAR; PG8_MMA(1, 0, At, B0); PG8_MMA(1, 1, At, B1); PG8_BAR; PG8_SCHED;
            PG8_LDB(B0, 1, 0); PG8_LDB(B1, 1, 1); PG8_SCHED; PG8_LDA(At, 1, 0); PG8_STAGE(PG8_SA(0, 1), a2 + hstep, voffA);
            PG8_WAIT_V(8); PG8_WAIT_L(0); PG8_BAR; PG8_MMA(0, 0, At, B0); PG8_MMA(0, 1, At, B1); PG8_BAR; PG8_SCHED;
            PG8_LDA(At, 1, 1); PG8_STAGE(PG8_SB(1, 0), b3, voffB); PG8_STAGE(PG8_SB(1, 1), b3 + hstep, voffB); PG8_STAGE(PG8_SA(1, 0), a3, voffA);
            PG8_WAIT_V(8); PG8_WAIT_L(0); PG8_BAR; PG8_MMA(1, 0, At, B0); PG8_MMA(1, 1, At, B1); PG8_BAR; PG8_SCHED;
            } else {
            PG8_LDB(B0, 0, 0); PG8_SCHED; PG8_LDA(At, 0, 0); PG8_STAGE(PG8_SA(1, 1), a1 + hstep, voffA);
            PG8_WAIT_L(8); PG8_BAR; PG8_WAIT_L(0); PG8_MMA(0, 0, At, B0); PG8_BAR; PG8_SCHED;
            PG8_LDB(B1, 0, 1); PG8_STAGE(PG8_SB(0, 0), b2, voffB);
            PG8_BAR; PG8_WAIT_L(0); PG8_MMA(0, 1, At, B1); PG8_BAR;
            PG8_LDA(At, 0, 1); PG8_STAGE(PG8_SA(0, 0), a2, voffA);
            PG8_BAR; PG8_WAIT_L(0); PG8_MMA(1, 0, At, B0); PG8_BAR; PG8_SCHED;
            PG8_STAGE(PG8_SB(0, 1), b2 + hstep, voffB);
            PG8_WAIT_V(6); PG8_BAR; PG8_MMA(1, 1, At, B1); PG8_BAR;
            PG8_LDB(B0, 1, 0); PG8_SCHED; PG8_LDA(At, 1, 0); PG8_STAGE(PG8_SA(0, 1), a2 + hstep, voffA);
            PG8_WAIT_L(8); PG8_BAR; PG8_WAIT_L(0); PG8_MMA(0, 0, At, B0); PG8_BAR; PG8_SCHED;
            PG8_LDB(B1, 1, 1); PG8_STAGE(PG8_SB(1, 0), b3, voffB);
            PG8_BAR; PG8_WAIT_L(0); PG8_MMA(0, 1, At, B1); PG8_BAR;
            PG8_LDA(At, 1, 1); PG8_STAGE(PG8_SA(1, 0), a3, voffA);
            PG8_BAR; PG8_WAIT_L(0); PG8_MMA(1, 0, At, B0); PG8_BAR; PG8_SCHED;
            PG8_STAGE(PG8_SB(1, 1), b3 + hstep, voffB);
            PG8_WAIT_V(6); PG8_BAR; PG8_MMA(1, 1, At, B1); PG8_BAR;
            }
        }
        if constexpr (ALIGN_EPI) { if (wr == 0) PG8_BAR; }
        if constexpr (!Epi::AFTER_DRAIN) { E(acc, cur, wr, wc, fr, fq); S.done(cur); }
        if (!has_next) break;
#pragma unroll
        for (int a = 0; a < 2; ++a)
#pragma unroll
            for (int b = 0; b < 2; ++b)
#pragma unroll
                for (int m = 0; m < 4; ++m)
#pragma unroll
                    for (int n = 0; n < 2; ++n) acc[a][b][m][n] = (f32x4){0.f, 0.f, 0.f, 0.f};
        cur = nxt; cA = nA; cB = nB; ++ui;
        if constexpr (ALIGN_EPI) { if (wr == 1) PG8_BAR; }
    }
    PG8_WAIT_V(0);
    if constexpr (!ALIGN_EPI) { if (wr == 0) PG8_BAR; }
    PG8_BAR;
    if constexpr (Epi::AFTER_DRAIN) { E.fused(acc, cur, wr, wc, fr, fq, lds, wid, lane); S.done(cur); }
#undef PG8_SA
#undef PG8_SB
#undef PG8_STAGE
#undef PG8_LDA
#undef PG8_LDB
#undef PG8_MMA
#undef PG8_WAIT_V
#undef PG8_WAIT_L
#undef PG8_BAR
#undef PG8_SCHED
}
}

#define LAS __attribute__((address_space(3)))
typedef unsigned short bf16;
typedef float f32x4 __attribute__((ext_vector_type(4)));
typedef float f32x2 __attribute__((ext_vector_type(2)));
typedef float f32x16 __attribute__((ext_vector_type(16)));
typedef short bf16x8 __attribute__((ext_vector_type(8)));
typedef short s16x4 __attribute__((ext_vector_type(4)));
typedef unsigned u32x4 __attribute__((ext_vector_type(4)));
typedef unsigned u32x2 __attribute__((ext_vector_type(2)));

constexpr int DM = 1024, NB = 32, TS = 2048, SB = 8, ST = 16, PAST = 4096;
constexpr int NPG = 2;
constexpr int RG = NB * TS / NPG;
constexpr int GBATCH = NB / NPG;
constexpr int NGRP = NPG + 1;
constexpr int NIN = 5888;
constexpr float LOG2E = 1.4426950408889634f;
constexpr float EPSN = 1e-6f;
constexpr int NSPLIT = 4;
constexpr int CACHE_ROWS = SB * PAST;

constexpr size_t O_YP = 0, O_YS = 67108864, O_KDP = 67239936, O_VDP = 134348800, O_CKVP = 201457664, O_KRP = 218234880,
                 O_KDS = 220332032, O_VDS = 220463104, O_CKVS = 220594176, O_KRS = 220626944;
constexpr size_t MiB = 1u << 20;
constexpr size_t WS_TAB = 0;
constexpr size_t WS_ROPE = 8192;
constexpr size_t WS_WIN = 1 * MiB;
constexpr size_t WS_WUQ = WS_WIN + (size_t)NIN * 1024 * 2;
constexpr size_t WS_WUKV = WS_WUQ + 1536 * 256 * 2;
constexpr size_t WS_WOD = WS_WUKV + 2048 * 256 * 2;
constexpr size_t WS_WOM = WS_WOD + 2 * MiB;
constexpr size_t WS_WOUT = WS_WOM + 2 * MiB;
constexpr size_t WS_WUP = WS_WOUT + 2 * MiB;
constexpr size_t WS_WDN = WS_WUP + 8 * MiB;
constexpr size_t WS_WEND = WS_WDN + 8 * MiB;
constexpr size_t WS_SAMP = 37 * MiB;
constexpr size_t WS_PART = 44 * MiB;
constexpr size_t WS_PO_D = WS_PART, WS_PO_M = WS_PART + 8 * MiB, WS_PM = WS_PART + 12 * MiB, WS_PL = WS_PM + 131072;
constexpr size_t WS_PROMPT = 58 * MiB;
constexpr size_t GRP_BYTES_PER_ROW = 27712;
constexpr size_t WS_NEED = WS_PROMPT + (size_t)RG * GRP_BYTES_PER_ROW;
static_assert(WS_WEND <= WS_SAMP && WS_SAMP + 256 * GRP_BYTES_PER_ROW <= WS_PART && WS_PL + 131072 <= WS_PROMPT, "ws map");
constexpr size_t C_KDC = 0, C_VDC = 64 * MiB, C_KNC = 128 * MiB, C_VMC = 192 * MiB, C_CKVC = 256 * MiB, C_KRC = 272 * MiB;

struct Args { const float* in[26]; float* out; unsigned char* ws; int pad0, pad1; };

struct Grp {
    const float* x; float* y; float* okd; float* ovd; float* ockv; float* okr;
    int nvalid, ntiles, sample;
    bf16 *QD, *KD, *VD, *QN, *U, *XN, *QR, *KN, *VM, *GD, *GM, *DO, *MO, *CQ, *CKV, *KR; float* ZS;
};
__device__ __forceinline__ Grp make_grp(const Args& a, int g) {
    Grp G; unsigned char* base; size_t RC;
    if (g == 0) {
        G.x = a.in[1]; G.y = a.out + O_YS; G.okd = a.out + O_KDS; G.ovd = a.out + O_VDS; G.ockv = a.out + O_CKVS; G.okr = a.out + O_KRS;
        G.nvalid = SB * ST; G.ntiles = 1; G.sample = 1; base = a.ws + WS_SAMP; RC = 256;
    } else {
        const size_t r0 = (size_t)(g - 1) * RG;
        G.x = a.in[0] + r0 * 1024; G.y = a.out + O_YP + r0 * 1024; G.okd = a.out + O_KDP + r0 * 1024; G.ovd = a.out + O_VDP + r0 * 1024;
        G.ockv = a.out + O_CKVP + r0 * 256; G.okr = a.out + O_KRP + r0 * 32;
        G.nvalid = RG; G.ntiles = RG / 256; G.sample = 0; base = a.ws + WS_PROMPT; RC = RG;
    }
    G.QD = (bf16*)(base); G.KD = (bf16*)(base + RC * 2048); G.VD = (bf16*)(base + RC * 4096); G.QN = (bf16*)(base + RC * 6144); G.U = (bf16*)base;
    G.XN = (bf16*)(base + RC * 8192); G.QR = (bf16*)(base + RC * 10240); G.KN = (bf16*)(base + RC * 11264); G.VM = (bf16*)(base + RC * 13312);
    G.GD = (bf16*)(base + RC * 15360); G.GM = (bf16*)(base + RC * 17408); G.DO = (bf16*)(base + RC * 19456); G.MO = (bf16*)(base + RC * 21504);
    G.ZS = (float*)(base + RC * 23552); G.CQ = (bf16*)(base + RC * 26624); G.CKV = (bf16*)(base + RC * 27136); G.KR = (bf16*)(base + RC * 27648);
    return G;
}

template <int M> __device__ __forceinline__ float swz_xor(float v) { return __int_as_float(__builtin_amdgcn_ds_swizzle(__float_as_int(v), 0x1F | (M << 10))); }
__device__ __forceinline__ float half_sum32(float v) { v += swz_xor<1>(v); v += swz_xor<2>(v); v += swz_xor<4>(v); v += swz_xor<8>(v); v += swz_xor<16>(v); return v; }
__device__ __forceinline__ float wave_sum(float v) {
    v = half_sum32(v);
    auto rr = __builtin_amdgcn_permlane32_swap(__float_as_uint(v), __float_as_uint(v), false, false);
    return __uint_as_float(rr[0]) + __uint_as_float(rr[1]);
}
typedef __bf16 bf16x2_hw __attribute__((ext_vector_type(2)));
__device__ __forceinline__ unsigned pk2(float lo, float hi) { f32x2 v = {lo, hi}; bf16x2_hw b = __builtin_convertvector(v, bf16x2_hw); return __builtin_bit_cast(unsigned, b); }
__device__ __forceinline__ unsigned f2bf(float f) { return pk2(f, 0.f) & 0xffffu; }
__device__ __forceinline__ float bflo(unsigned w) { return __builtin_bit_cast(float, w << 16); }
__device__ __forceinline__ float bfhi(unsigned w) { return __builtin_bit_cast(float, w & 0xffff0000u); }
__device__ __forceinline__ void st_bf4(bf16* p, f32x4 v) { u32x2 w; w.x = pk2(v[0], v[1]); w.y = pk2(v[2], v[3]); *(u32x2*)p = w; }
__device__ __forceinline__ f32x4 ld_bf4(const bf16* p) { const u32x2 w = *(const u32x2*)p; return (f32x4){bflo(w.x), bfhi(w.x), bflo(w.y), bfhi(w.y)}; }
__device__ __forceinline__ float sigm(float x) { return 1.f / (1.f + __expf(-x)); }

#define EPI_LOOP(BODY) \
    _Pragma("unroll") for (int ai = 0; ai < 2; ++ai) _Pragma("unroll") for (int m = 0; m < 4; ++m) { const int row = u.pm * 256 + ai * 128 + wr * 64 + m * 16 + fr; const size_t rw = (size_t)row; (void)rw; \
    _Pragma("unroll") for (int bj = 0; bj < 2; ++bj) _Pragma("unroll") for (int n = 0; n < 2; ++n) { const int cl = bj * 128 + wc * 32 + n * 16 + 4 * fq; const f32x4 v = acc[ai][bj][m][n]; BODY } asm volatile("" ::: "memory"); }

#define EPI_LOOP_P(...) \
    _Pragma("unroll") for (int ai = 0; ai < 2; ++ai) _Pragma("unroll") for (int m = 0; m < 4; ++m) { const int row = u.pm * 256 + ai * 128 + wr * 64 + m * 16 + fr; const size_t rw = (size_t)row; (void)rw; \
    _Pragma("unroll") for (int bj = 0; bj < 2; ++bj) { const int cl = bj * 128 + wc * 32 + 8 * fq; const f32x4 v0 = acc[ai][bj][m][0], v1 = acc[ai][bj][m][1]; __VA_ARGS__ } asm volatile("" ::: "memory"); }
__device__ __forceinline__ void st_bf8(bf16* p, f32x4 a, f32x4 b) { u32x4 w; w.x = pk2(a[0], a[1]); w.y = pk2(a[2], a[3]); w.z = pk2(b[0], b[1]); w.w = pk2(b[2], b[3]); *(u32x4*)p = w; }
__device__ __forceinline__ void ld_bf8(const bf16* p, f32x4& a, f32x4& b) { const u32x4 w = *(const u32x4*)p; a = (f32x4){bflo(w.x), bfhi(w.x), bflo(w.y), bfhi(w.y)}; b = (f32x4){bflo(w.z), bfhi(w.z), bflo(w.w), bfhi(w.w)}; }
__device__ __forceinline__ f32x4 sigm4(f32x4 v) { return (f32x4){sigm(v[0]), sigm(v[1]), sigm(v[2]), sigm(v[3])}; }
typedef const f32x4 (&AccRef)[2][2][4][2];

struct EpiIn {
    static constexpr bool PERM = true, AFTER_DRAIN = false;
    bf16 *QD, *KD, *VD, *GD, *GM; float *ZS, *okd, *ovd; int nvalid; float qs;
    __device__ __forceinline__ void operator()(AccRef acc, const pg8::Unit& u, int wr, int wc, int fr, int fq) const {
        const int t = u.pn;
        if (t < 4) { const int c0 = t * 256; EPI_LOOP_P( st_bf8(QD + rw * 1024 + c0 + cl, v0 * qs, v1 * qs); ) }
        else if (t < 8) { const int c0 = (t - 4) * 256; EPI_LOOP_P( st_bf8(KD + rw * 1024 + c0 + cl, v0, v1); if (row < nvalid) { float* o = okd + rw * 1024 + c0 + cl; *(f32x4*)o = v0; *(f32x4*)(o + 4) = v1; } ) }
        else if (t < 12) { const int c0 = (t - 8) * 256; EPI_LOOP_P( st_bf8(VD + rw * 1024 + c0 + cl, v0, v1); if (row < nvalid) { float* o = ovd + rw * 1024 + c0 + cl; *(f32x4*)o = v0; *(f32x4*)(o + 4) = v1; } ) }
        else if (t < 15) { const int c0 = (t - 12) * 256; EPI_LOOP_P( float* o = ZS + rw * 768 + c0 + cl; *(f32x4*)o = v0; *(f32x4*)(o + 4) = v1; ) }
        else if (t < 19) { const int c0 = (t - 15) * 256; EPI_LOOP_P( st_bf8(GD + rw * 1024 + c0 + cl, sigm4(v0), sigm4(v1)); ) }
        else { const int c0 = (t - 19) * 256; EPI_LOOP_P( st_bf8(GM + rw * 1024 + c0 + cl, sigm4(v0), sigm4(v1)); ) }
    }
};
struct EpiQ {
    static constexpr bool PERM = false, AFTER_DRAIN = false;
    bf16 *QN, *QR; const float* rope; int sample; float qs;
    __device__ __forceinline__ void operator()(AccRef acc, const pg8::Unit& u, int wr, int wc, int fr, int fq) const {
        const int t = u.pn;
        if (t < 4) { const int c0 = t * 256; EPI_LOOP( st_bf4(QN + rw * 1024 + c0 + cl, v * qs); ) }
        else {
            const int c0 = (t - 4) * 256;
#pragma unroll
            for (int ai = 0; ai < 2; ++ai)
#pragma unroll
                for (int m = 0; m < 4; ++m) {
                    const int row = u.pm * 256 + ai * 128 + wr * 64 + m * 16 + fr;
                    const int pos = sample ? (PAST + (row & (ST - 1))) : (row & (TS - 1));
                    const f32x4 cs0 = *(const f32x4*)(rope + (size_t)pos * 32 + 8 * fq), cs1 = *(const f32x4*)(rope + (size_t)pos * 32 + 8 * fq + 4);
#pragma unroll
                    for (int bj = 0; bj < 2; ++bj) {
                        const f32x4 x1 = acc[ai][bj][m][0], x2 = acc[ai][bj][m][1];
                        f32x4 o1, o2;
                        o1[0] = x1[0] * cs0[0] - x2[0] * cs0[1]; o2[0] = x2[0] * cs0[0] + x1[0] * cs0[1];
                        o1[1] = x1[1] * cs0[2] - x2[1] * cs0[3]; o2[1] = x2[1] * cs0[2] + x1[1] * cs0[3];
                        o1[2] = x1[2] * cs1[0] - x2[2] * cs1[1]; o2[2] = x2[2] * cs1[0] + x1[2] * cs1[1];
                        o1[3] = x1[3] * cs1[2] - x2[3] * cs1[3]; o2[3] = x2[3] * cs1[2] + x1[3] * cs1[3];
                        bf16* p = QR + (size_t)row * 512 + c0 + bj * 128 + wc * 32 + 4 * fq;
                        st_bf4(p, o1 * qs); st_bf4(p + 16, o2 * qs);
                    }
                    asm volatile("" ::: "memory");
                }
        }
    }
};
struct EpiKV {
    static constexpr bool PERM = true, AFTER_DRAIN = false;
    bf16 *KN, *VM;
    __device__ __forceinline__ void operator()(AccRef acc, const pg8::Unit& u, int wr, int wc, int fr, int fq) const {
        const int t = u.pn; bf16* O = t < 4 ? KN : VM; const int c0 = (t & 3) * 256;
        EPI_LOOP_P( st_bf8(O + rw * 1024 + c0 + cl, v0, v1); )
    }
};
struct EpiM1 {
    static constexpr bool PERM = true, AFTER_DRAIN = false;
    const bf16* Gt; bf16* MG;
    __device__ __forceinline__ void operator()(AccRef acc, const pg8::Unit& u, int wr, int wc, int fr, int fq) const {
        const int c0 = u.pn * 256;
        EPI_LOOP_P( f32x4 g0, g1; ld_bf8(Gt + rw * 1024 + c0 + cl, g0, g1); st_bf8(MG + rw * 1024 + c0 + cl, g0 * v0, g1 * v1); )
    }
};
struct EpiM2 {
    static constexpr bool PERM = true, AFTER_DRAIN = false;
    const bf16* Gt; bf16* MG;
    __device__ __forceinline__ void operator()(AccRef acc, const pg8::Unit& u, int wr, int wc, int fr, int fq) const {
        const int c0 = u.pn * 256;
        EPI_LOOP_P( f32x4 g0, g1, o0, o1; ld_bf8(Gt + rw * 1024 + c0 + cl, g0, g1); ld_bf8(MG + rw * 1024 + c0 + cl, o0, o1); st_bf8(MG + rw * 1024 + c0 + cl, o0 + g0 * v0, o1 + g1 * v1); )
    }
};
struct EpiOut {
    static constexpr bool PERM = true, AFTER_DRAIN = false;
    const float* x; float* y; int nvalid;
    __device__ __forceinline__ void operator()(AccRef acc, const pg8::Unit& u, int wr, int wc, int fr, int fq) const {
        const int c0 = u.pn * 256;
        EPI_LOOP_P( if (row < nvalid) { const float* xb = x + rw * 1024 + c0 + cl; float* o = y + rw * 1024 + c0 + cl; const f32x4 b0 = *(const f32x4*)xb, b1 = *(const f32x4*)(xb + 4); *(f32x4*)o = b0 + v0; *(f32x4*)(o + 4) = b1 + v1; } )
    }
};
struct EpiUp {
    static constexpr bool PERM = true, AFTER_DRAIN = false;
    bf16* U;
    __device__ __forceinline__ void operator()(AccRef acc, const pg8::Unit& u, int wr, int wc, int fr, int fq) const {
        const int c0 = u.pn * 256;
        EPI_LOOP_P( f32x4 r0, r1; r0[0] = fmaxf(v0[0], 0.f); r0[1] = fmaxf(v0[1], 0.f); r0[2] = fmaxf(v0[2], 0.f); r0[3] = fmaxf(v0[3], 0.f); r1[0] = fmaxf(v1[0], 0.f); r1[1] = fmaxf(v1[1], 0.f); r1[2] = fmaxf(v1[2], 0.f); r1[3] = fmaxf(v1[3], 0.f);
                    st_bf8(U + rw * 4096 + c0 + cl, r0 * r0, r1 * r1); )
    }
};
struct EpiDown {
    static constexpr bool PERM = true, AFTER_DRAIN = false;
    float* y; int nvalid;
    __device__ __forceinline__ void operator()(AccRef acc, const pg8::Unit& u, int wr, int wc, int fr, int fq) const {
        const int c0 = u.pn * 256;
        EPI_LOOP_P( if (row < nvalid) { float* p = y + rw * 1024 + c0 + cl; const f32x4 b0 = *(const f32x4*)p, b1 = *(const f32x4*)(p + 4); *(f32x4*)p = b0 + v0; *(f32x4*)(p + 4) = b1 + v1; } )
    }
};

struct EpiDownAtomic {
    static constexpr bool PERM = true, AFTER_DRAIN = false;
    float* y; int nvalid;
    __device__ __forceinline__ void operator()(AccRef acc, const pg8::Unit& u, int wr, int wc, int fr, int fq) const {
        const int c0 = u.pn * 256;
        EPI_LOOP_P( if (row < nvalid) { float* p = y + rw * 1024 + c0 + cl;
            _Pragma("unroll") for (int e = 0; e < 4; ++e) { atomicAdd(p + e, v0[e]); atomicAdd(p + 4 + e, v1[e]); } } )
    }
};

template <class Epi>
__device__ __forceinline__ void run_gemm(LAS unsigned char* lds, const bf16* A, const bf16* Bt, int M, int N, int K, const Epi& E, const int tid_in, const int ld = 0, const int cshift = 0) {
    int Kr = K; asm volatile("" : "+s"(Kr));
    const int Gn = (int)gridDim.x; int c = (int)blockIdx.x - cshift; if (c < 0) c += Gn;
    pg8::Gemm g{A, Bt, M, N, Kr, ld ? ld : Kr}; pg8::StaticOrder S; S.init(M, N, Gn, c);
    pg8::gemm_phase<Epi, pg8::StaticOrder, true, true>(lds, g, S, E, tid_in);
}

__device__ __forceinline__ void rms_rows_bf16(const float* src, bf16* dst, const float* gain, int nvalid, int ntotal, int gw, int ngw, int lane) {
    f32x4 g[4];
#pragma unroll
    for (int j = 0; j < 4; ++j) g[j] = ((const f32x4*)gain)[lane + 64 * j];
    for (int r0 = 2 * gw; r0 < ntotal; r0 += 2 * ngw) {
        f32x4 v[2][4];
#pragma unroll
        for (int k = 0; k < 2; ++k) { const int r = r0 + k; const f32x4* xr = (const f32x4*)(src + (size_t)(r < nvalid ? r : 0) * 1024) + lane;
#pragma unroll
            for (int j = 0; j < 4; ++j) v[k][j] = xr[64 * j]; }
#pragma unroll
        for (int k = 0; k < 2; ++k) { const int r = r0 + k; if (r >= ntotal) continue;
            u32x2* o8 = (u32x2*)(dst + (size_t)r * 1024) + lane;
            float s = 0.f;
#pragma unroll
            for (int j = 0; j < 4; ++j) s += (v[k][j][0] * v[k][j][0] + v[k][j][1] * v[k][j][1]) + (v[k][j][2] * v[k][j][2] + v[k][j][3] * v[k][j][3]);
            const float rs = (r < nvalid) ? 1.0f / sqrtf(wave_sum(s) * (1.f / 1024.f) + EPSN) : 0.f;
#pragma unroll
            for (int j = 0; j < 4; ++j) { const f32x4 o = v[k][j] * rs * g[j]; o8[64 * j] = (u32x2){pk2(o[0], o[1]), pk2(o[2], o[3])}; } }
    }
}
__device__ __forceinline__ void rms_rows_f32_inplace(float* y, const float* gain, int nvalid, int gw, int ngw, int lane) {
    f32x4 g[4];
#pragma unroll
    for (int j = 0; j < 4; ++j) g[j] = ((const f32x4*)gain)[lane + 64 * j];
    for (int r0 = 2 * gw; r0 < nvalid; r0 += 2 * ngw) {
        f32x4 v[2][4];
#pragma unroll
        for (int k = 0; k < 2; ++k) { const int r = r0 + k; f32x4* xr = (f32x4*)(y + (size_t)(r < nvalid ? r : r0) * 1024) + lane;
#pragma unroll
            for (int j = 0; j < 4; ++j) v[k][j] = xr[64 * j]; }
#pragma unroll
        for (int k = 0; k < 2; ++k) { const int r = r0 + k; if (r >= nvalid) continue;
            f32x4* xr = (f32x4*)(y + (size_t)r * 1024) + lane;
            float s = 0.f;
#pragma unroll
            for (int j = 0; j < 4; ++j) s += (v[k][j][0] * v[k][j][0] + v[k][j][1] * v[k][j][1]) + (v[k][j][2] * v[k][j][2] + v[k][j][3] * v[k][j][3]);
            const float rs = 1.0f / sqrtf(wave_sum(s) * (1.f / 1024.f) + EPSN);
#pragma unroll
            for (int j = 0; j < 4; ++j) xr[64 * j] = v[k][j] * rs * g[j]; }
    }
}
__device__ __forceinline__ void phase_small(const Grp& G, const float* gq, const float* gkv, const float* rope, int gw, int ngw, int lane) {
    const int ntotal = G.ntiles * 256;
    for (int r = gw; r < ntotal; r += ngw) {
        const float* z = G.ZS + (size_t)r * 768;
        const f32x4 cq = ((const f32x4*)z)[lane], ck = ((const f32x4*)(z + 256))[lane];
        const float s1 = wave_sum((cq[0] * cq[0] + cq[1] * cq[1]) + (cq[2] * cq[2] + cq[3] * cq[3]));
        const float s2 = wave_sum((ck[0] * ck[0] + ck[1] * ck[1]) + (ck[2] * ck[2] + ck[3] * ck[3]));
        const float r1 = 1.0f / sqrtf(s1 * (1.f / 256.f) + EPSN), r2 = 1.0f / sqrtf(s2 * (1.f / 256.f) + EPSN);
        const f32x4 o1 = cq * r1 * ((const f32x4*)gq)[lane], o2 = ck * r2 * ((const f32x4*)gkv)[lane];
        ((u32x2*)(G.CQ + (size_t)r * 256))[lane] = (u32x2){pk2(o1[0], o1[1]), pk2(o1[2], o1[3])};
        ((u32x2*)(G.CKV + (size_t)r * 256))[lane] = (u32x2){pk2(o2[0], o2[1]), pk2(o2[2], o2[3])};
        if (r < G.nvalid) ((f32x4*)(G.ockv + (size_t)r * 256))[lane] = o2;
        if (lane < 16) {
            const int pos = G.sample ? (PAST + (r & (ST - 1))) : (r & (TS - 1));
            const float x1 = z[512 + lane], x2 = z[512 + 16 + lane];
            const f32x2 cs = *(const f32x2*)(rope + (size_t)pos * 32 + 2 * lane);
            const float a = x1 * cs[0] - x2 * cs[1], b = x2 * cs[0] + x1 * cs[1];
            G.KR[(size_t)r * 32 + lane] = (bf16)f2bf(a); G.KR[(size_t)r * 32 + 16 + lane] = (bf16)f2bf(b);
            if (r < G.nvalid) { G.okr[(size_t)r * 32 + lane] = a; G.okr[(size_t)r * 32 + 16 + lane] = b; }
        }
    }
}

__device__ __forceinline__ void tr_item(const float* W, int K, int N, bf16* WT, int k0, int n0, int drow0, LAS float* scr, int lane) {
#pragma unroll 8
    for (int i = 0; i < 32; ++i) { const int kk = 2 * i + (lane >> 5); scr[kk * 33 + (lane & 31)] = W[(size_t)(k0 + kk) * N + n0 + (lane & 31)]; }
    asm volatile("s_waitcnt lgkmcnt(0)" ::: "memory");
    const int c = lane & 7;
#pragma unroll
    for (int j = 0; j < 4; ++j) { const int n = (lane >> 3) + 8 * j; const LAS float* s = scr + (8 * c) * 33 + n;
        u32x4 o; o.x = pk2(s[0 * 33], s[1 * 33]); o.y = pk2(s[2 * 33], s[3 * 33]); o.z = pk2(s[4 * 33], s[5 * 33]); o.w = pk2(s[6 * 33], s[7 * 33]);
        *(u32x4*)(WT + (size_t)(drow0 + n) * K + k0 + 8 * c) = o; }
    asm volatile("s_waitcnt lgkmcnt(0)" ::: "memory");
}
__device__ __forceinline__ int map_in(int n0) {
    if (n0 < 3616) return n0;
    if (n0 < 4640) return n0 - 3616 + 3840;
    return n0 - 4640 + 4864;
}
__device__ __forceinline__ int map_uq(int n0) { const int hh = n0 / 96, d0 = n0 % 96; return d0 < 64 ? hh * 64 + d0 : 1024 + hh * 32 + (d0 - 64); }
__device__ __forceinline__ void cvt8(const float* src, bf16* dst, size_t n8, size_t gt, size_t ngt) {
    for (size_t i = gt; i < n8; i += ngt) { const f32x4 a = ((const f32x4*)src)[2 * i], b = ((const f32x4*)src)[2 * i + 1];
        ((u32x4*)dst)[i] = (u32x4){pk2(a[0], a[1]), pk2(a[2], a[3]), pk2(b[0], b[1]), pk2(b[2], b[3])}; }
}
__device__ __forceinline__ void phase_prologue(const Args& a, LAS unsigned char* lds, int gw, int ngw, int lane, int wave) {
    unsigned char* ws = a.ws;
    LAS float* scr = (LAS float*)(lds + wave * 16384);
    constexpr int I_IN = 16 * 177, I_UQ = 4 * 48, I_UK = 4 * 32, I_UV = 4 * 32, I_O = 16 * 32, I_UP = 16 * 128, I_DN = 64 * 32;
    constexpr int NITEMS = I_IN + I_UQ + I_UK + I_UV + 3 * I_O + I_UP + I_DN;
    for (int it = gw; it < NITEMS; it += ngw) {
        int r = it;
        if (r < I_IN) { const int kb = r / 177, nb = r % 177; tr_item(a.in[8], 1024, 5664, (bf16*)(ws + WS_WIN), 64 * kb, 32 * nb, map_in(32 * nb), scr, lane); continue; } r -= I_IN;
        if (r < I_UQ) { const int kb = r / 48, nb = r % 48; tr_item(a.in[15], 256, 1536, (bf16*)(ws + WS_WUQ), 64 * kb, 32 * nb, map_uq(32 * nb), scr, lane); continue; } r -= I_UQ;
        if (r < I_UK) { const int kb = r / 32, nb = r % 32; tr_item(a.in[17], 256, 1024, (bf16*)(ws + WS_WUKV), 64 * kb, 32 * nb, 32 * nb, scr, lane); continue; } r -= I_UK;
        if (r < I_UV) { const int kb = r / 32, nb = r % 32; tr_item(a.in[18], 256, 1024, (bf16*)(ws + WS_WUKV), 64 * kb, 32 * nb, 1024 + 32 * nb, scr, lane); continue; } r -= I_UV;
        if (r < I_O) { const int kb = r / 32, nb = r % 32; tr_item(a.in[19], 1024, 1024, (bf16*)(ws + WS_WOD), 64 * kb, 32 * nb, 32 * nb, scr, lane); continue; } r -= I_O;
        if (r < I_O) { const int kb = r / 32, nb = r % 32; tr_item(a.in[20], 1024, 1024, (bf16*)(ws + WS_WOM), 64 * kb, 32 * nb, 32 * nb, scr, lane); continue; } r -= I_O;
        if (r < I_O) { const int kb = r / 32, nb = r % 32; tr_item(a.in[21], 1024, 1024, (bf16*)(ws + WS_WOUT), 64 * kb, 32 * nb, 32 * nb, scr, lane); continue; } r -= I_O;
        if (r < I_UP) { const int kb = r / 128, nb = r % 128; tr_item(a.in[23], 1024, 4096, (bf16*)(ws + WS_WUP), 64 * kb, 32 * nb, 32 * nb, scr, lane); continue; } r -= I_UP;
        { const int kb = r / 32, nb = r % 32; tr_item(a.in[24], 4096, 1024, (bf16*)(ws + WS_WDN), 64 * kb, 32 * nb, 32 * nb, scr, lane); }
    }
    const size_t gt = (size_t)gw * 64 + lane, ngt = (size_t)ngw * 64;
    { u32x4* z = (u32x4*)(ws + WS_WIN + (size_t)3616 * 2048); for (size_t i = gt; i < (size_t)224 * 128; i += ngt) z[i] = (u32x4){0u, 0u, 0u, 0u}; }
    unsigned char* cb = ws + WS_PROMPT;
    cvt8(a.in[2], (bf16*)(cb + C_KDC), (size_t)CACHE_ROWS * 128, gt, ngt);
    cvt8(a.in[3], (bf16*)(cb + C_VDC), (size_t)CACHE_ROWS * 128, gt, ngt);
    cvt8(a.in[4], (bf16*)(cb + C_CKVC), (size_t)CACHE_ROWS * 32, gt, ngt);
    cvt8(a.in[5], (bf16*)(cb + C_KRC), (size_t)CACHE_ROWS * 4, gt, ngt);
    float* tab = (float*)(ws + WS_TAB);
    for (size_t i = gt; i < 8 * 192; i += ngt) {
        const int h = (int)i / 192, idx = (int)i % 192, rel = idx - 128, n = rel < 0 ? -rel : rel;
        int bucket = n;
        if (n >= 8) { int j = (31 - __clz(n * n)) - 6; bucket = 8 + j; if (bucket > 15) bucket = 15; }
        if (rel > 0) bucket += 16;
        tab[i] = (a.in[6][bucket * 8 + h] - a.in[6][15 * 8 + h]) * LOG2E;
    }
    if (gt == 0) {
        float d1 = 0.f, d2 = 0.f;
        for (int i = 0; i < 64; ++i) { d1 += a.in[9][i] * a.in[10][i]; d2 += a.in[11][i] * a.in[12][i]; }
        tab[1536] = expf(d1) - expf(d2) + 0.2f;
    }
    float* rope = (float*)(ws + WS_ROPE);
    for (size_t i = gt; i < (size_t)(PAST + ST) * 16; i += ngt) {
        const int pos = (int)(i >> 4), k = (int)(i & 15);
        const float inv = __builtin_amdgcn_exp2f(-(float)k * 0.8304820237218406f);
        const float ang = (float)pos * inv;
        const double rev = (double)ang * 0.15915494309189535;
        const float fr = (float)(rev - __builtin_rint(rev));
        rope[2 * i] = __builtin_amdgcn_cosf(fr); rope[2 * i + 1] = __builtin_amdgcn_sinf(fr);
    }
}

#ifndef ATTMASK
#define ATTMASK 15
#endif
constexpr int AL_TAB = 0, AL_WSF = 6144, AL_TILE = 8192;

__device__ __forceinline__ int crow(int r, int hi) { return (r & 3) + 8 * (r >> 2) + 4 * hi; }
__device__ __forceinline__ float xmax32(float v) { auto rr = __builtin_amdgcn_permlane32_swap(__float_as_uint(v), __float_as_uint(v), false, false); return fmaxf(__uint_as_float(rr[0]), __uint_as_float(rr[1])); }
__device__ __forceinline__ float xsum32(float v) { auto rr = __builtin_amdgcn_permlane32_swap(__float_as_uint(v), __float_as_uint(v), false, false); return __uint_as_float(rr[0]) + __uint_as_float(rr[1]); }
typedef __bf16 bf16x2_t __attribute__((ext_vector_type(2)));
__device__ __forceinline__ unsigned cvtpk(float lo, float hi) { f32x2 v = {lo, hi}; bf16x2_t b = __builtin_convertvector(v, bf16x2_t); return __builtin_bit_cast(unsigned, b); }
__device__ __forceinline__ bf16x8 pack8(float a0, float a1, float a2, float a3, float a4, float a5, float a6, float a7) {
    u32x4 w = {cvtpk(a0, a1), cvtpk(a2, a3), cvtpk(a4, a5), cvtpk(a6, a7)}; return __builtin_bit_cast(bf16x8, w);
}
typedef short v4i16_t __attribute__((ext_vector_type(4)));
__device__ __forceinline__ s16x4 vtr(const LAS unsigned char* p) { return __builtin_bit_cast(s16x4, __builtin_amdgcn_ds_read_tr16_b64_v4i16((LAS v4i16_t*)p)); }

template <int DQK, int DV> struct AttnState { bf16x8 qf[DQK / 16]; f32x16 o[DV / 32]; f32x16 negm; float m, l; };
constexpr float ATT_THR = 8.0f;

template <int DQK, int DV, bool HAS_BIAS>
__device__ __forceinline__ void attn_tile(AttnState<DQK, DV>& st, const LAS unsigned char* Kt, const LAS unsigned char* Vt, int bias_mode, const LAS float* tab, int rel0, int nkeys, bool first, LAS float* wsf, int lane) {
    constexpr int PK = DQK * 2 + 16, PV = DV * 2 + 64, KS = DQK / 16, NDB = DV / 32;
    const int q = lane & 31, hi = lane >> 5;
    f32x16 p0, p1;
    const LAS unsigned char* kp = Kt + q * PK + hi * 16;
    bf16x8 ka[KS], kb[KS];
#pragma unroll
    for (int ks = 0; ks < KS; ++ks) { ka[ks] = *(const LAS bf16x8*)(kp + ks * 32); kb[ks] = *(const LAS bf16x8*)(kp + 32 * PK + ks * 32); }
    if (HAS_BIAS && bias_mode == 2) {
        asm volatile("" ::: "memory");
#pragma unroll
        for (int r = 0; r < 16; ++r) {
            const int k = crow(r, hi);
            const int i0 = min(max(rel0 + k + 128, 0), 191), i1 = min(max(rel0 + k + 160, 0), 191);
            p0[r] = tab[i0] + st.negm[r]; p1[r] = tab[i1] + st.negm[r];
        }
        p0 = __builtin_amdgcn_mfma_f32_32x32x16_bf16(ka[0], st.qf[0], p0, 0, 0, 0);
        p1 = __builtin_amdgcn_mfma_f32_32x32x16_bf16(kb[0], st.qf[0], p1, 0, 0, 0);
    } else {
        p0 = __builtin_amdgcn_mfma_f32_32x32x16_bf16(ka[0], st.qf[0], st.negm, 0, 0, 0);
        p1 = __builtin_amdgcn_mfma_f32_32x32x16_bf16(kb[0], st.qf[0], st.negm, 0, 0, 0);
    }
#pragma unroll
    for (int ks = 1; ks < KS; ++ks) {
        p0 = __builtin_amdgcn_mfma_f32_32x32x16_bf16(ka[ks], st.qf[ks], p0, 0, 0, 0);
        p1 = __builtin_amdgcn_mfma_f32_32x32x16_bf16(kb[ks], st.qf[ks], p1, 0, 0, 0);
    }
    const int q4 = (lane & 15) >> 2, blk = (lane >> 4) & 1, pp = lane & 3;
    const LAS unsigned char* vp = Vt + (4 * hi + q4) * PV + (16 * blk + 4 * pp) * 2;
    s16x4 vlo[2][4], vhi[2][4];
#pragma unroll
    for (int s4 = 0; s4 < 4; ++s4) { vlo[0][s4] = vtr(vp + (16 * s4) * PV); vhi[0][s4] = vtr(vp + (16 * s4 + 8) * PV); }
    __builtin_amdgcn_sched_barrier(0);
    if (nkeys < 64) {
#pragma unroll
        for (int r = 0; r < 16; ++r) { const int k = crow(r, hi); if (k >= nkeys) p0[r] = -1e30f; if (k + 32 >= nkeys) p1[r] = -1e30f; }
    }
    float mxa = __builtin_fmaxf(__builtin_fmaxf(p0[0], p0[1]), p1[0]), mxb = __builtin_fmaxf(__builtin_fmaxf(p0[2], p0[3]), p1[1]);
    mxa = __builtin_fmaxf(__builtin_fmaxf(mxa, p1[2]), p1[3]);
#pragma unroll
    for (int r = 4; r < 16; r += 4) {
        mxa = __builtin_fmaxf(__builtin_fmaxf(mxa, p0[r]), p0[r + 1]); mxb = __builtin_fmaxf(__builtin_fmaxf(mxb, p0[r + 2]), p0[r + 3]);
        mxa = __builtin_fmaxf(__builtin_fmaxf(mxa, p1[r]), p1[r + 1]); mxb = __builtin_fmaxf(__builtin_fmaxf(mxb, p1[r + 2]), p1[r + 3]);
    }
    const float mx = xmax32(__builtin_fmaxf(mxa, mxb));
    if (first || __any(mx > ATT_THR)) {
        const float dl = first ? mx : __builtin_fmaxf(mx, 0.f);
        st.m += dl;
#pragma unroll
        for (int r = 0; r < 16; ++r) { st.negm[r] = -st.m; p0[r] -= dl; p1[r] -= dl; }
        const float f = __builtin_amdgcn_exp2f(-dl);
        st.l *= f;
        if (hi == 0) wsf[q] = f;
#pragma unroll
        for (int r = 0; r < 16; ++r) { const float fr = wsf[crow(r, hi)];
#pragma unroll
            for (int db = 0; db < NDB; ++db) st.o[db][r] *= fr; }
    }
    float sum0 = 0.f, sum1 = 0.f;
#pragma unroll
    for (int r = 0; r < 16; ++r) { p0[r] = __builtin_amdgcn_exp2f(p0[r]); p1[r] = __builtin_amdgcn_exp2f(p1[r]); sum0 += p0[r]; sum1 += p1[r]; }
    st.l += sum0 + sum1;
    bf16x8 pf[4];
    pf[0] = pack8(p0[0], p0[1], p0[2], p0[3], p0[4], p0[5], p0[6], p0[7]);
    pf[1] = pack8(p0[8], p0[9], p0[10], p0[11], p0[12], p0[13], p0[14], p0[15]);
    pf[2] = pack8(p1[0], p1[1], p1[2], p1[3], p1[4], p1[5], p1[6], p1[7]);
    pf[3] = pack8(p1[8], p1[9], p1[10], p1[11], p1[12], p1[13], p1[14], p1[15]);
    __builtin_amdgcn_sched_barrier(0);
#pragma unroll
    for (int db = 0; db < NDB; ++db) {
        if (db + 1 < NDB) {
#pragma unroll
            for (int s4 = 0; s4 < 4; ++s4) { vlo[(db + 1) & 1][s4] = vtr(vp + (16 * s4) * PV + (db + 1) * 64); vhi[(db + 1) & 1][s4] = vtr(vp + (16 * s4 + 8) * PV + (db + 1) * 64); }
        }
#pragma unroll
        for (int s4 = 0; s4 < 4; ++s4) {
            const s16x4 lo = vlo[db & 1][s4], h4 = vhi[db & 1][s4];
            const bf16x8 vb = {lo[0], lo[1], lo[2], lo[3], h4[0], h4[1], h4[2], h4[3]};
            st.o[db] = __builtin_amdgcn_mfma_f32_32x32x16_bf16(pf[s4], vb, st.o[db], 0, 0, 0);
        }
        __builtin_amdgcn_sched_barrier(0);
    }
}

template <int DQK, int DV>
__device__ __forceinline__ void attn_init(AttnState<DQK, DV>& st) {
    st.m = 0.f; st.l = 0.f;
#pragma unroll
    for (int r = 0; r < 16; ++r) st.negm[r] = 0.f;
#pragma unroll
    for (int db = 0; db < DV / 32; ++db)
#pragma unroll
        for (int r = 0; r < 16; ++r) st.o[db][r] = 0.f;
}

template <bool DIFF>
__device__ __forceinline__ void attn_unit_coop(const Grp& G, int b, int h, int qb, int n, LAS unsigned char* lds, const int tid_in) {
    constexpr int DQK = DIFF ? 64 : 96, DV = DIFF ? 128 : 64, PK = DQK * 2 + 16, PV = DV * 2 + 64, KB = 64 * PK, VB = 64 * PV, TB = KB + VB, NDB = DV / 32;
    int tid_ = tid_in; asm volatile("" : "+v"(tid_));
    const int tid = tid_, lane = tid & 63, wid = __builtin_amdgcn_readfirstlane(tid >> 6), q = lane & 31, hi = lane >> 5;
    const size_t seq0 = (size_t)b * TS;
    const int qrow0 = qb * 256 + wid * 32;
    const int NT = 4 * qb + 4, my_nt = 4 * qb + (wid >> 1) + 1;
    const LAS float* tab = (const LAS float*)(lds + AL_TAB) + h * 192;
    LAS float* wsf = (LAS float*)(lds + AL_WSF) + wid * 64;
    LAS unsigned char* tiles = lds + AL_TILE;
    {
        AttnState<DQK, DV> st; attn_init(st);
        if (DIFF) { const bf16* qp = G.QD + (seq0 + qrow0 + q) * 1024 + h * 128 + n * 64 + hi * 8;
#pragma unroll
            for (int ks = 0; ks < 4; ++ks) st.qf[ks] = *(const bf16x8*)(qp + ks * 16);
        } else { const bf16* qn = G.QN + (seq0 + qrow0 + q) * 1024 + h * 64 + hi * 8; const bf16* qr = G.QR + (seq0 + qrow0 + q) * 512 + h * 32 + hi * 8;
#pragma unroll
            for (int ks = 0; ks < 4; ++ks) st.qf[ks] = *(const bf16x8*)(qn + ks * 16);
#pragma unroll
            for (int ks = 0; ks < 2; ++ks) st.qf[4 + ks] = *(const bf16x8*)(qr + ks * 16);
        }
        const bf16* ksrc = (DIFF ? G.KD + h * 128 + n * 64 : G.KN + h * 64) + (seq0 + (tid >> 3)) * 1024 + (tid & 7) * 8;
        const int kdst = (tid >> 3) * PK + (tid & 7) * 16;
        const bf16* k2src = G.KR + (seq0 + ((tid & 255) >> 2)) * 32 + (tid & 3) * 8;
        const int k2dst = ((tid & 255) >> 2) * PK + 128 + (tid & 3) * 16;
        const bf16* vsrc = DIFF ? G.VD + (seq0 + (tid >> 4)) * 1024 + h * 128 + (tid & 15) * 8 : G.VM + (seq0 + (tid >> 3)) * 1024 + h * 64 + (tid & 7) * 8;
        const int vdst = DIFF ? KB + (tid >> 4) * PV + (tid & 15) * 16 : KB + (tid >> 3) * PV + (tid & 7) * 16;
        u32x4 rkA, rk2A = {0u, 0u, 0u, 0u}, rv0A, rv1A = {0u, 0u, 0u, 0u}, rkB = {0u, 0u, 0u, 0u}, rk2B = {0u, 0u, 0u, 0u}, rv0B = {0u, 0u, 0u, 0u}, rv1B = {0u, 0u, 0u, 0u};
#define ATT_LOAD(S, j) do { rk##S = *(const u32x4*)(ksrc + (size_t)(j) * 64 * 1024); if (!DIFF && tid < 256) rk2##S = *(const u32x4*)(k2src + (size_t)(j) * 64 * 32); \
        rv0##S = *(const u32x4*)(vsrc + (size_t)(j) * 64 * 1024); if (DIFF) rv1##S = *(const u32x4*)(vsrc + (size_t)(j) * 64 * 1024 + 32 * 1024); } while (0)
#define ATT_STORE(S, bufp) do { *(LAS u32x4*)((bufp) + kdst) = rk##S; if (!DIFF && tid < 256) *(LAS u32x4*)((bufp) + k2dst) = rk2##S; \
        *(LAS u32x4*)((bufp) + vdst) = rv0##S; if (DIFF) *(LAS u32x4*)((bufp) + vdst + 32 * PV) = rv1##S; } while (0)
#define ATT_COMPUTE(j, bufp) do { if ((j) < my_nt) { const int kb_ = 64 * (j); const int mode_ = DIFF ? ((kb_ + 63 - qrow0 <= -128) ? 1 : 2) : 0; \
        attn_tile<DQK, DV, DIFF>(st, (bufp), (bufp) + KB, mode_, tab, kb_ - (qrow0 + q), 64, (j) == 0, wsf, lane); } } while (0)
        ATT_LOAD(A, 0); ATT_STORE(A, tiles);
        __syncthreads();
        ATT_LOAD(A, 1);
        for (int j = 0; j < NT; j += 2) {
            LAS unsigned char* b0 = tiles + (j & 1) * TB; LAS unsigned char* b1 = tiles + ((j + 1) & 1) * TB;
            if (j + 2 < NT) ATT_LOAD(B, j + 2);
            ATT_COMPUTE(j, b0);
            ATT_STORE(A, b1);
            __syncthreads();
            if (j + 3 < NT) ATT_LOAD(A, j + 3);
            ATT_COMPUTE(j + 1, b1);
            if (j + 2 < NT) ATT_STORE(B, b0);
            __syncthreads();
        }
#undef ATT_LOAD
#undef ATT_STORE
#undef ATT_COMPUTE
        const float lt = xsum32(st.l);
        if (hi == 0) wsf[32 + q] = lt;
        float inv[16];
#pragma unroll
        for (int r = 0; r < 16; ++r) inv[r] = 1.0f / wsf[32 + crow(r, hi)];
        bf16* obase = (DIFF ? (n == 0 ? G.DO : G.XN) + h * 128 : G.MO + h * 64) + (seq0 + qrow0) * 1024 + q;
#pragma unroll
        for (int db = 0; db < NDB; ++db)
#pragma unroll
            for (int r = 0; r < 16; ++r) obase[(size_t)crow(r, hi) * 1024 + db * 32] = (bf16)f2bf(st.o[db][r] * inv[r]);
    }
}

__device__ __forceinline__ void phase_diffmix(const Grp& G, float lam, const float* subln, int gw, int ngw, int lane) {
    const int c = (lane & 7) * 16;
    float g[16];
#pragma unroll
    for (int i = 0; i < 16; ++i) g[i] = subln[c + i] * 0.8f;
    for (int r = gw; r < G.nvalid; r += ngw) {
        bf16* p1 = G.DO + (size_t)r * 1024 + lane * 16; const bf16* p2 = G.XN + (size_t)r * 1024 + lane * 16;
        const u32x4 a0 = ((const u32x4*)p1)[0], a1 = ((const u32x4*)p1)[1], b0 = ((const u32x4*)p2)[0], b1 = ((const u32x4*)p2)[1];
        float v[16];
#pragma unroll
        for (int i = 0; i < 4; ++i) { v[2 * i] = bflo(a0[i]) - lam * bflo(b0[i]); v[2 * i + 1] = bfhi(a0[i]) - lam * bfhi(b0[i]);
                                      v[8 + 2 * i] = bflo(a1[i]) - lam * bflo(b1[i]); v[8 + 2 * i + 1] = bfhi(a1[i]) - lam * bfhi(b1[i]); }
        float s = 0.f;
#pragma unroll
        for (int i = 0; i < 16; ++i) s += v[i] * v[i];
        s += swz_xor<1>(s); s += swz_xor<2>(s); s += swz_xor<4>(s);
        const float rs = 1.0f / sqrtf(s * (1.f / 128.f) + EPSN);
        u32x4 o0, o1;
#pragma unroll
        for (int i = 0; i < 4; ++i) { o0[i] = pk2(v[2 * i] * rs * g[2 * i], v[2 * i + 1] * rs * g[2 * i + 1]); o1[i] = pk2(v[8 + 2 * i] * rs * g[8 + 2 * i], v[8 + 2 * i + 1] * rs * g[8 + 2 * i + 1]); }
        ((u32x4*)p1)[0] = o0; ((u32x4*)p1)[1] = o1;
    }
}

template <bool DIFF>
__device__ __forceinline__ void attn_unit_wave(const Grp& G, const unsigned char* cb, int b, int h, int n, int j0, int j1, int wu, float* PO, float* PM, float* PL,
                                               LAS unsigned char* wt, LAS float* wsf, const LAS float* tab0, int lane_in) {
    int lane = lane_in; asm volatile("" : "+v"(lane)); lane &= 63;
    constexpr int DQK = DIFF ? 64 : 96, DV = DIFF ? 128 : 64, PK = DQK * 2 + 16, PV = DV * 2 + 64, KB = 64 * PK, NDB = DV / 32;
    const int q = lane & 31, hi = lane >> 5;
    const LAS float* tab = tab0 + h * 192;
    AttnState<DQK, DV> st; attn_init(st);
    const size_t qrow = (size_t)b * ST + q;
    if (DIFF) { const bf16* qp = G.QD + qrow * 1024 + h * 128 + n * 64 + hi * 8;
#pragma unroll
        for (int ks = 0; ks < 4; ++ks) st.qf[ks] = *(const bf16x8*)(qp + ks * 16);
    } else { const bf16* qn = G.QN + qrow * 1024 + h * 64 + hi * 8; const bf16* qr = G.QR + qrow * 512 + h * 32 + hi * 8;
#pragma unroll
        for (int ks = 0; ks < 4; ++ks) st.qf[ks] = *(const bf16x8*)(qn + ks * 16);
#pragma unroll
        for (int ks = 0; ks < 2; ++ks) st.qf[4 + ks] = *(const bf16x8*)(qr + ks * 16);
    }
    for (int j = j0; j < j1; ++j) {
        const bf16 *kA, *kB2, *vA; int nkeys;
        if (j < 64) { const size_t r0 = (size_t)b * PAST + 64 * j; nkeys = 64;
            kA = DIFF ? (const bf16*)(cb + C_KDC) + r0 * 1024 + h * 128 + n * 64 : (const bf16*)(cb + C_KNC) + r0 * 1024 + h * 64;
            kB2 = (const bf16*)(cb + C_KRC) + r0 * 32;
            vA = DIFF ? (const bf16*)(cb + C_VDC) + r0 * 1024 + h * 128 : (const bf16*)(cb + C_VMC) + r0 * 1024 + h * 64;
        } else { const size_t r0 = (size_t)b * ST; nkeys = ST;
            kA = DIFF ? G.KD + r0 * 1024 + h * 128 + n * 64 : G.KN + r0 * 1024 + h * 64;
            kB2 = G.KR + r0 * 32;
            vA = DIFF ? G.VD + r0 * 1024 + h * 128 : G.VM + r0 * 1024 + h * 64;
        }
        { u32x4 t[8];
#pragma unroll
            for (int i = 0; i < 8; ++i) { const int idx = lane + 64 * i; t[i] = *(const u32x4*)(kA + (size_t)(idx >> 3) * 1024 + (idx & 7) * 8); }
#pragma unroll
            for (int i = 0; i < 8; ++i) { const int idx = lane + 64 * i; *(LAS u32x4*)(wt + (idx >> 3) * PK + (idx & 7) * 16) = t[i]; } }
        if (!DIFF) { u32x4 t[4];
#pragma unroll
            for (int i = 0; i < 4; ++i) { const int idx = lane + 64 * i; t[i] = *(const u32x4*)(kB2 + (size_t)(idx >> 2) * 32 + (idx & 3) * 8); }
#pragma unroll
            for (int i = 0; i < 4; ++i) { const int idx = lane + 64 * i; *(LAS u32x4*)(wt + (idx >> 2) * PK + 128 + (idx & 3) * 16) = t[i]; } }
        if (DIFF) {
#pragma unroll
            for (int hf = 0; hf < 2; ++hf) { u32x4 t[8];
#pragma unroll
                for (int i = 0; i < 8; ++i) { const int idx = lane + 64 * i + 512 * hf; t[i] = *(const u32x4*)(vA + (size_t)(idx >> 4) * 1024 + (idx & 15) * 8); }
#pragma unroll
                for (int i = 0; i < 8; ++i) { const int idx = lane + 64 * i + 512 * hf; *(LAS u32x4*)(wt + KB + (idx >> 4) * PV + (idx & 15) * 16) = t[i]; } }
        } else { u32x4 t[8];
#pragma unroll
            for (int i = 0; i < 8; ++i) { const int idx = lane + 64 * i; t[i] = *(const u32x4*)(vA + (size_t)(idx >> 3) * 1024 + (idx & 7) * 8); }
#pragma unroll
            for (int i = 0; i < 8; ++i) { const int idx = lane + 64 * i; *(LAS u32x4*)(wt + KB + (idx >> 3) * PV + (idx & 7) * 16) = t[i]; } }
        const int kb = 64 * j;
        const int mode = DIFF ? ((j <= 61) ? 1 : 2) : 0;
        attn_tile<DQK, DV, DIFF>(st, wt, wt + KB, mode, tab, kb - (PAST + q), nkeys, j == j0, wsf, lane);
    }
    const float lt = xsum32(st.l);
    if (hi == 0) { PM[wu * 32 + q] = st.m; PL[wu * 32 + q] = lt; }
#pragma unroll
    for (int db = 0; db < NDB; ++db)
#pragma unroll
        for (int r = 0; r < 16; ++r) PO[((size_t)wu * 32 + crow(r, hi)) * DV + db * 32 + q] = st.o[db][r];
}

__device__ __forceinline__ void phase_combine(const Grp& G, const float* POd, const float* POm, const float* PM, const float* PL, float lam, const float* subln, int gw, int ngw, int lane) {
    for (int it = gw; it < SB * 8 * ST + SB * 16 * ST; it += ngw) {
        if (it < SB * 8 * ST) {
            const int qq = it & 15, h = (it >> 4) & 7, b = it >> 7;
            float val[2] = {0.f, 0.f};
#pragma unroll
            for (int n = 0; n < 2; ++n) {
                const int wu0 = ((b * 8 + h) * 2 + n) * NSPLIT;
                float M = -1e30f;
#pragma unroll
                for (int s = 0; s < NSPLIT; ++s) M = fmaxf(M, PM[(wu0 + s) * 32 + qq]);
                float L = 0.f, a0 = 0.f, a1 = 0.f;
#pragma unroll
                for (int s = 0; s < NSPLIT; ++s) { const float w = __builtin_amdgcn_exp2f(PM[(wu0 + s) * 32 + qq] - M); L += PL[(wu0 + s) * 32 + qq] * w;
                    const float* po = POd + ((size_t)(wu0 + s) * 32 + qq) * 128; a0 += po[lane] * w; a1 += po[lane + 64] * w; }
                const float sc = (n == 0 ? 1.f : -lam) / L;
                val[0] += a0 * sc; val[1] += a1 * sc;
            }
            const float ss = wave_sum(val[0] * val[0] + val[1] * val[1]);
            const float rs = 0.8f / sqrtf(ss * (1.f / 128.f) + EPSN);
            bf16* o = G.DO + (size_t)(b * ST + qq) * 1024 + h * 128;
            o[lane] = (bf16)f2bf(val[0] * rs * subln[lane]); o[lane + 64] = (bf16)f2bf(val[1] * rs * subln[lane + 64]);
        } else {
            const int i2 = it - SB * 8 * ST; const int qq = i2 & 15, h = (i2 >> 4) & 15, b = i2 >> 8;
            const int wu0 = 512 + (b * 16 + h) * NSPLIT;
            float M = -1e30f;
#pragma unroll
            for (int s = 0; s < NSPLIT; ++s) M = fmaxf(M, PM[(wu0 + s) * 32 + qq]);
            float L = 0.f, a0 = 0.f;
#pragma unroll
            for (int s = 0; s < NSPLIT; ++s) { const float w = __builtin_amdgcn_exp2f(PM[(wu0 + s) * 32 + qq] - M); L += PL[(wu0 + s) * 32 + qq] * w;
                a0 += POm[((size_t)(wu0 - 512 + s) * 32 + qq) * 64 + lane] * w; }
            G.MO[(size_t)(b * ST + qq) * 1024 + h * 64 + lane] = (bf16)f2bf(a0 / L);
        }
    }
}

__device__ __forceinline__ void diffmix_block(const Grp& G, int b, int h, int qb, float lam, const float* subln, int tid) {
    const int lane = tid & 63, wid = tid >> 6;
    const float g0 = subln[2 * lane] * 0.8f, g1 = subln[2 * lane + 1] * 0.8f;
    const size_t row0 = (size_t)b * TS + qb * 256 + wid * 32;
#pragma unroll 1
    for (int rb = 0; rb < 32; rb += 16) {
        unsigned a[16], c[16];
#pragma unroll
        for (int r = 0; r < 16; ++r) { a[r] = *((const unsigned*)(G.DO + (row0 + rb + r) * 1024 + h * 128) + lane); c[r] = *((const unsigned*)(G.XN + (row0 + rb + r) * 1024 + h * 128) + lane); }
#pragma unroll
        for (int r = 0; r < 16; ++r) {
            const float v0 = bflo(a[r]) - lam * bflo(c[r]), v1 = bfhi(a[r]) - lam * bfhi(c[r]);
            const float ss = wave_sum(v0 * v0 + v1 * v1);
            const float rs = 1.0f / sqrtf(ss * (1.f / 128.f) + EPSN);
            *((unsigned*)(G.DO + (row0 + rb + r) * 1024 + h * 128) + lane) = pk2(v0 * rs * g0, v1 * rs * g1);
        }
    }
}

__device__ __forceinline__ void phase_attention(const Args& a, const Grp& G, LAS unsigned char* lds, const int tid_in) {
    int tid_ = tid_in; asm volatile("" : "+v"(tid_));
    const int tid = tid_, lane = tid & 63, wid = __builtin_amdgcn_readfirstlane(tid >> 6);
    const float* tabg = (const float*)(a.ws + WS_TAB);
    for (int i = tid; i < 8 * 192; i += 512) ((LAS float*)(lds + AL_TAB))[i] = tabg[i];
    const float lam = tabg[1536];
    const float* subln = a.in[13];
    __syncthreads();
    if (G.sample) {
        if (wid < 4) {
            constexpr int TBD = 64 * (64 * 2 + 16) + 64 * (128 * 2 + 64);
            LAS unsigned char* wt = lds + AL_TILE + wid * TBD;
            LAS float* wsf = (LAS float*)(lds + AL_WSF) + wid * 64;
            const LAS float* tab0 = (const LAS float*)(lds + AL_TAB);
            const unsigned char* cb = a.ws + WS_PROMPT;
            for (int wu = (int)blockIdx.x * 4 + wid; wu < 1024; wu += (int)gridDim.x * 4) {
                const int s = wu & 3; const int j0 = s == 0 ? 0 : 17 + 16 * (s - 1), j1 = 17 + 16 * s;
                if (wu < 512) {
#if ATTMASK & 1
 const int n = (wu >> 2) & 1, h = (wu >> 3) & 7, b = wu >> 6;
                    attn_unit_wave<true>(G, cb, b, h, n, j0, j1, wu, (float*)(a.ws + WS_PO_D), (float*)(a.ws + WS_PM), (float*)(a.ws + WS_PL), wt, wsf, tab0, tid);
#endif
                } else {
#if ATTMASK & 2
 const int i2 = wu - 512; const int h = (i2 >> 2) & 15, b = i2 >> 6;
                    attn_unit_wave<false>(G, cb, b, h, 0, j0, j1, wu, (float*)(a.ws + WS_PO_M) - (size_t)512 * 32 * 64, (float*)(a.ws + WS_PM), (float*)(a.ws + WS_PL), wt, wsf, tab0, tid);
#endif
                }
            }
        }
    } else {
        const int Gn = (int)gridDim.x, bx = (int)blockIdx.x;
        const int vcu = (Gn % 8 == 0) ? (bx % 8) * (Gn / 8) + bx / 8 : bx;
        for (int v = vcu; v < 256; v += Gn) {
            const int p = v & 3;
#if ATTMASK & 4
            for (int r = 0; r < GBATCH * 8 / 64; ++r) { const int bh = r * 64 + (v >> 2), b = bh >> 3, h = bh & 7;
                for (int n = 0; n < 2; ++n)
                    for (int i = 0; i < 2; ++i) attn_unit_coop<true>(G, b, h, i ? p : 7 - p, n, lds, tid_in);
                asm volatile("s_waitcnt vmcnt(0)" ::: "memory"); __syncthreads();
                int t2 = tid_in; asm volatile("" : "+v"(t2));
                diffmix_block(G, b, h, 7 - p, lam, subln, t2); diffmix_block(G, b, h, p, lam, subln, t2); }
#endif
#if ATTMASK & 8
            for (int r = 0; r < GBATCH * 16 / 64; ++r) { const int bh = r * 64 + (v >> 2), b = bh >> 4, h = bh & 15;
                for (int i = 0; i < 2; ++i) attn_unit_coop<false>(G, b, h, i ? p : 7 - p, 0, lds, tid_in); }
#endif
        }
    }
}

constexpr int LDS_BYTES = 147456;
#ifndef PHMASK
#define PHMASK 0xffff
#endif

#define XB_TMO      128
#define XB_XCNT(j)  (256  + 64 * (j))
#define XB_XSUB(j)  (1280 + 64 * (j))
#define XB_XGEN(j)  (2304 + 64 * (j))
#define XB_TOP      3328
#define XB_TOPGEN   3392
#define XCD_BAR_WORDS 3456
#define XB_SPIN_CAP (1u << 18)

__device__ __forceinline__ unsigned xb_ld(unsigned* p)              { return __hip_atomic_load(p, __ATOMIC_RELAXED, __HIP_MEMORY_SCOPE_AGENT); }
__device__ __forceinline__ unsigned xb_add(unsigned* p, unsigned v) { return __hip_atomic_fetch_add(p, v, __ATOMIC_RELAXED, __HIP_MEMORY_SCOPE_AGENT); }
__device__ __forceinline__ unsigned xb_xcc_id() { return (unsigned)__builtin_amdgcn_s_getreg((3 << 11) | 20) & 0xFu; }
#define XB_SPIN(cond, bar) do { unsigned _sp = 0; while (cond) { __builtin_amdgcn_s_sleep(1); \
    if ((++_sp & 255u) == 0u) { if (xb_ld(&(bar)[XB_TMO])) break; if (_sp > XB_SPIN_CAP) { atomicAdd(&(bar)[XB_TMO], 1u); break; } } } } while (0)

struct XcdBarrier {
    unsigned* bar; unsigned x;
    volatile LAS unsigned* st;
};

__device__ __forceinline__ XcdBarrier xcd_barrier_post(unsigned* bar, volatile LAS unsigned* st) {
    XcdBarrier b; b.bar = bar; b.x = xb_xcc_id(); b.st = st;
    if (threadIdx.x == 0) (void)xb_add(&bar[XB_XCNT(b.x)], 1u);
    return b;
}
__device__ __forceinline__ void xcd_barrier_complete(unsigned* bar, unsigned x, unsigned& nloc, unsigned& nx) {
    const unsigned G = gridDim.x * gridDim.y * gridDim.z;
    unsigned sum, cnt, mine, sp = 0u;
    for (;;) {
        sum = 0u; cnt = 0u; mine = 0u;
#pragma unroll
        for (unsigned j = 0; j < 16; ++j) { const unsigned c = xb_ld(&bar[XB_XCNT(j)]); sum += c; cnt += (c > 0u) ? 1u : 0u; mine = (j == x) ? c : mine; }
        if (sum == G) break;
        __builtin_amdgcn_s_sleep(1);
        if ((++sp & 255u) == 0u) { if (xb_ld(&bar[XB_TMO])) break; if (sp > XB_SPIN_CAP) { atomicAdd(&bar[XB_TMO], 1u); break; } }
    }
    nloc = mine > 0u ? mine : 1u; nx = cnt > 0u ? cnt : 1u;
}

__device__ __forceinline__ void xcd_barrier(const XcdBarrier& b, const bool is_t0) {
    asm volatile("s_waitcnt vmcnt(0)" ::: "memory");
    __syncthreads();
    if (is_t0) {
        unsigned* bar = b.bar;
        __builtin_amdgcn_s_waitcnt(0);
        unsigned nloc = b.st[0], nx = b.st[1];
        if (nloc == 0u) { xcd_barrier_complete(bar, b.x, nloc, nx); b.st[0] = nloc; b.st[1] = nx; }
        const unsigned old = xb_add(&bar[XB_XSUB(b.x)], 1u);
        const unsigned gen = old / nloc;
        if (old + 1u == (gen + 1u) * nloc) {
            __builtin_amdgcn_fence(__ATOMIC_RELEASE, "agent");
            asm volatile("s_waitcnt vmcnt(0)" ::: "memory");
            const unsigned og = xb_add(&bar[XB_TOP], 1u);
            const unsigned tg = og / nx;
            if (og + 1u == (tg + 1u) * nx) xb_add(&bar[XB_TOPGEN], 1u);
            else XB_SPIN(xb_ld(&bar[XB_TOPGEN]) == tg, bar);
            __builtin_amdgcn_fence(__ATOMIC_ACQUIRE, "agent");
            xb_add(&bar[XB_XGEN(b.x)], 1u);
            asm volatile("s_waitcnt vmcnt(0)" ::: "memory");
        } else {
            XB_SPIN(xb_ld(&bar[XB_XGEN(b.x)]) == gen, bar);
            __builtin_amdgcn_fence(__ATOMIC_ACQUIRE, "agent");
            asm volatile("s_waitcnt vmcnt(0)" ::: "memory");
        }
    }
    __syncthreads();
}

constexpr size_t WS_BAR = 786432;
constexpr int LDS_BARST = 131072 + 512;
constexpr int LDS_PTAB = 131072;
__device__ __forceinline__ const void* lds_ptr(LAS const unsigned long long* pt, int i) {
    const unsigned long long v = pt[i];
    const unsigned lo = __builtin_amdgcn_readfirstlane((unsigned)v), hi = __builtin_amdgcn_readfirstlane((unsigned)(v >> 32));
    return (const void*)(const __attribute__((address_space(1))) void*)(((unsigned long long)hi << 32) | lo);
}
__device__ __forceinline__ Args load_args(LAS unsigned char* lds) {
    int z = 0; asm volatile("" : "+s"(z));
    LAS const unsigned long long* pt = (LAS const unsigned long long*)(lds + LDS_PTAB + z);
    Args a;
#pragma unroll
    for (int i = 0; i < 26; ++i) a.in[i] = (const float*)lds_ptr(pt, i);
    a.out = (float*)lds_ptr(pt, 26); a.ws = (unsigned char*)lds_ptr(pt, 27); a.pad0 = 0; a.pad1 = 0;
    return a;
}
#define GBAR() do { int z_ = 0; asm volatile("" : "+s"(z_)); XcdBarrier b_; b_.bar = (unsigned*)((unsigned char*)lds_ptr((LAS const unsigned long long*)(lds + LDS_PTAB + z_), 27) + WS_BAR); \
    b_.x = xb_xcc_id(); b_.st = (volatile LAS unsigned*)(lds + LDS_BARST + z_); xcd_barrier(b_, s_wave == 0 && __builtin_amdgcn_mbcnt_hi(~0u, __builtin_amdgcn_mbcnt_lo(~0u, (unsigned)z_)) == 0u); } while (0)
#define PH_BEGIN int w_ = s_wave, g_ = g; asm volatile("" : "+s"(w_), "+s"(g_)); int zz_ = 0; asm volatile("" : "+s"(zz_)); int lane_ = (int)__builtin_amdgcn_mbcnt_hi(~0u, __builtin_amdgcn_mbcnt_lo(~0u, (unsigned)zz_)); asm volatile("" : "+v"(lane_)); const int lane = lane_, wave = w_, tid_ = w_ * 64 + lane; (void)tid_; \
    const int gw = (int)blockIdx.x * 8 + wave, ngw = (int)gridDim.x * 8; const Args a = load_args(lds); unsigned char* ws = a.ws; const float* rope = (const float*)(ws + WS_ROPE); (void)rope; const Grp G = make_grp(a, g_); const int M = G.ntiles * 256; (void)lane; (void)gw; (void)ngw; (void)M;
__global__ void __launch_bounds__(512, 2) fwd_megakernel(Args ka) {
    extern __shared__ __attribute__((aligned(16))) unsigned char lds_raw[];
    LAS unsigned char* lds = (LAS unsigned char*)lds_raw;
    cg::grid_group grid = cg::this_grid();
    if (threadIdx.x == 0) {
        LAS unsigned long long* pt = (LAS unsigned long long*)(lds + LDS_PTAB);
#pragma unroll
        for (int i = 0; i < 26; ++i) pt[i] = (unsigned long long)ka.in[i];
        pt[26] = (unsigned long long)ka.out; pt[27] = (unsigned long long)ka.ws;
    }
    if (threadIdx.x == 0) { ((LAS unsigned*)(lds + LDS_BARST))[0] = 0u; ((LAS unsigned*)(lds + LDS_BARST))[1] = 0u; }
    __syncthreads();
    const int s_wave = __builtin_amdgcn_readfirstlane((int)threadIdx.x >> 6);
    (void)xcd_barrier_post((unsigned*)(ka.ws + WS_BAR), (volatile LAS unsigned*)(lds + LDS_BARST));
#if PHMASK & 1
    { const int tid = threadIdx.x, lane = tid & 63, wave = __builtin_amdgcn_readfirstlane(tid >> 6); const Args a = load_args(lds);
      phase_prologue(a, lds, (int)blockIdx.x * 8 + wave, (int)gridDim.x * 8, lane, wave); }
#endif
    if (ka.pad0 == 0x5a17) grid.sync();
    { const int g = 0; (void)g; GBAR(); }

#pragma unroll 1
    for (int g = 0; g < NGRP; ++g) {
        { PH_BEGIN rms_rows_bf16(G.x, G.XN, a.in[7], G.nvalid, M, gw, ngw, lane); }
        GBAR();
#if PHMASK & 2
        { PH_BEGIN EpiIn E{G.QD, G.KD, G.VD, G.GD, G.GM, G.ZS, G.okd, G.ovd, G.nvalid, 0.125f * LOG2E};
          run_gemm(lds, G.XN, (const bf16*)(ws + WS_WIN), M, NIN, 1024, E, tid_); }
#endif
        GBAR();
        { PH_BEGIN phase_small(G, a.in[14], a.in[16], rope, gw, ngw, lane); }
        GBAR();
#if PHMASK & 4
        { PH_BEGIN EpiQ E{G.QN, G.QR, rope, G.sample, 0.10206207261596575f * LOG2E};
          run_gemm(lds, G.CQ, (const bf16*)(ws + WS_WUQ), M, 1536, 256, E, tid_); }
#endif
#if PHMASK & 8
        { PH_BEGIN EpiKV E{G.KN, G.VM};
          run_gemm(lds, G.CKV, (const bf16*)(ws + WS_WUKV), M, 2048, 256, E, tid_); }
        if (g == 0) { PH_BEGIN EpiKV E{(bf16*)(ws + WS_PROMPT + C_KNC), (bf16*)(ws + WS_PROMPT + C_VMC)};
          run_gemm(lds, (const bf16*)(ws + WS_PROMPT + C_CKVC), (const bf16*)(ws + WS_WUKV), CACHE_ROWS, 2048, 256, E, tid_); }
#endif
        GBAR();
#if PHMASK & 16
        { PH_BEGIN phase_attention(a, G, lds, tid_); }
#endif
        GBAR();
        if (g == 0) {
            { PH_BEGIN phase_combine(G, (const float*)(ws + WS_PO_D), (const float*)(ws + WS_PO_M), (const float*)(ws + WS_PM), (const float*)(ws + WS_PL), ((const float*)(ws + WS_TAB))[1536], a.in[13], gw, ngw, lane); }
            GBAR();
        }
#if PHMASK & 32
        { PH_BEGIN EpiM1 E{G.GD, G.XN}; run_gemm(lds, G.DO, (const bf16*)(ws + WS_WOD), M, 1024, 1024, E, tid_); }
        { PH_BEGIN EpiM2 E{G.GM, G.XN}; run_gemm(lds, G.MO, (const bf16*)(ws + WS_WOM), M, 1024, 1024, E, tid_); }
#endif
        GBAR();
#if PHMASK & 64
        { PH_BEGIN EpiOut E{G.x, G.y, G.nvalid}; run_gemm(lds, G.XN, (const bf16*)(ws + WS_WOUT), M, 1024, 1024, E, tid_); }
#endif
        GBAR();
        { PH_BEGIN rms_rows_bf16(G.y, G.XN, a.in[22], G.nvalid, M, gw, ngw, lane); }
        GBAR();
#if PHMASK & 128
        { PH_BEGIN EpiUp E{G.U}; run_gemm(lds, G.XN, (const bf16*)(ws + WS_WUP), M, 4096, 1024, E, tid_); }
#endif
        GBAR();
#if PHMASK & 256
        if (g == 0) {
#pragma unroll 1
            for (int sk = 0; sk < 8; ++sk) { PH_BEGIN int s_ = sk; asm volatile("" : "+s"(s_)); EpiDownAtomic E{G.y, G.nvalid};
                run_gemm(lds, G.U + s_ * 512, (const bf16*)(ws + WS_WDN) + s_ * 512, M, 1024, 512, E, tid_, 4096, 4 * s_); }
        } else
        { PH_BEGIN EpiDown E{G.y, G.nvalid}; run_gemm(lds, G.U, (const bf16*)(ws + WS_WDN), M, 1024, 4096, E, tid_); }
#endif
        GBAR();
        { PH_BEGIN rms_rows_f32_inplace(G.y, a.in[25], G.nvalid, gw, ngw, lane); }
    }
}

extern "C" void kernel_launch(void* const* d_in, const int* in_sizes, int n_in, void* d_out, int out_size, void* d_ws, size_t ws_size, hipStream_t stream) {
    static int grid = 0;
    if (grid == 0) {
        if (n_in != 26 || ws_size < WS_NEED) { fprintf(stderr, "kernel_launch: need 26 inputs and %zu bytes of workspace; got %d, %zu\n", (size_t)WS_NEED, n_in, ws_size); grid = -1; return; }
        int dev = 0, cus = 0, per_cu = 0;
        if (hipGetDevice(&dev) != hipSuccess || hipDeviceGetAttribute(&cus, hipDeviceAttributeMultiprocessorCount, dev) != hipSuccess) { grid = -1; return; }
        if (hipFuncSetAttribute((const void*)fwd_megakernel, hipFuncAttributeMaxDynamicSharedMemorySize, LDS_BYTES) != hipSuccess) { fprintf(stderr, "kernel_launch: hipFuncSetAttribute failed\n"); grid = -1; return; }
        if (hipOccupancyMaxActiveBlocksPerMultiprocessor(&per_cu, (const void*)fwd_megakernel, 512, LDS_BYTES) != hipSuccess || per_cu < 1) { fprintf(stderr, "kernel_launch: occupancy query says %d\n", per_cu); per_cu = 1; }
        (void)hipGetLastError();
        grid = cus;
    }
    if (grid < 0) return;
    if (hipMemsetAsync((char*)d_ws + WS_BAR, 0, 16384, stream) != hipSuccess) { fprintf(stderr, "kernel_launch: memset failed\n"); return; }
    Args a{};
    for (int i = 0; i < 26; ++i) a.in[i] = (const float*)d_in[i];
    a.out = (float*)d_out; a.ws = (unsigned char*)d_ws;
    void* args[] = {&a};
    hipError_t e = hipLaunchCooperativeKernel((const void*)fwd_megakernel, dim3(grid), dim3(512), args, LDS_BYTES, stream);
    if (e != hipSuccess) fprintf(stderr, "kernel_launch: cooperative launch failed: %s (grid %d)\n", hipGetErrorString(e), grid);
}
```

```cpp
#include <hip/hip_runtime.h>
#include <hip/hip_cooperative_groups.h>
#include <cstdio>
#include <cstdint>
namespace cg = cooperative_groups;
namespace pg8 {
#define PG8_LAS __attribute__((address_space(3)))
typedef unsigned short bf16_t;
typedef short bf16x8 __attribute__((ext_vector_type(8)));
typedef float f32x4 __attribute__((ext_vector_type(4)));
typedef unsigned u32x4 __attribute__((ext_vector_type(4)));
constexpr int BM = 256, BK = 64, HALF = 128, HTB = HALF * BK * 2  , STAGE_BYTES = 8 * HTB, NXCD = 8, WGM = 8;

__host__ __device__ __forceinline__ int lds_byte(int r, int c) { const int st = (r >> 4) * 2 + (c >> 5), rr = r & 15, cc = c & 31, ob = rr * 64 + cc * 2; return st * 1024 + (ob ^ (((ob >> 9) & 1) << 5)); }
__host__ __device__ __forceinline__ void stage_rc(int b, int& R, int& C) { const int st = b / 1024, sb = b % 1024, swz = sb ^ (((sb >> 9) & 1) << 5); R = (st >> 1) * 16 + swz / 64; C = (st & 1) * 32 + (swz % 64) / 2; }
__host__ __device__ __forceinline__ int perm32(int rho) { const int n = rho >> 4, i = rho & 15; return 8 * (i >> 2) + 4 * n + (i & 3); }

struct Unit { int pm, pn; };
struct Gemm { const bf16_t* A; const bf16_t* Bt; int M, N, K, ld; };

struct StaticOrder {
    int nM, nN, nwg, G, c;
    __host__ __device__ void init(int M, int N, int G_, int c_) { nM = M / BM; nN = N / BM; nwg = nM * nN; G = G_; c = c_; }
    __host__ __device__ bool next(int i, Unit& u) const {
        const long L = (long)i * G + c; if (L >= nwg) return false;
        int wgid = (int)L; { const int q = nwg / NXCD, r = nwg % NXCD, xcd = wgid % NXCD, off = wgid / NXCD; wgid = (xcd < r ? xcd * (q + 1) : r * (q + 1) + (xcd - r) * q) + off; }
        const int nig = WGM * nN, gid = wgid / nig, fm = gid * WGM, gsz = (nM - fm) < WGM ? (nM - fm) : WGM;
        u.pm = fm + ((wgid % nig) % gsz); u.pn = (wgid % nig) / gsz; return true;
    }
    __device__ __forceinline__ void a_ready(const Unit&) const {}
    __device__ __forceinline__ void done(const Unit&) const {}
};

__device__ __forceinline__ unsigned cvt_pk_bf16(float lo, float hi) { unsigned r; asm volatile("v_cvt_pk_bf16_f32 %0, %1, %2" : "=v"(r) : "v"(lo), "v"(hi)); return r; }
typedef float f32x2 __attribute__((ext_vector_type(2)));
template <class Epi, class Sched, bool ALIGN_EPI = false, bool SP2 = false>
__device__ __forceinline__ void gemm_phase(PG8_LAS unsigned char* lds, const Gemm g, const Sched& S, const Epi& E, const int tid_in) {
    int tid_ = tid_in; asm volatile("" : "+v"(tid_));
    const int tid = tid_, wid = __builtin_amdgcn_readfirstlane(tid >> 6), lane = tid & 63, wr = wid >> 2, wc = wid & 3, fr = lane & 15, fq = lane >> 4;
    const int K = g.K, nt = K / BK, LD = g.ld;
    unsigned voffA[2], voffB[2];
#pragma unroll
    for (int i = 0; i < 2; ++i) { int R, C; stage_rc(tid * 16 + i * 8192, R, C); const int Rb = Epi::PERM ? ((R & ~31) + perm32(R & 31)) : R;
        voffA[i] = (unsigned)(R * LD + C) * 2u; voffB[i] = (unsigned)(Rb * LD + C) * 2u; }
    const size_t kstep = (size_t)(BK * 2);
    const size_t hstep = (size_t)HALF * LD * 2;
    const size_t tstep = 2 * hstep;
    const unsigned ldsw = (unsigned)wid * 1024u;
    const int aoff = lds_byte(wr * 64 + fr, fq * 8), boff = lds_byte(wc * 32 + fr, fq * 8);
#define PG8_SA(b, h) (((b) * 2 + (h)) * HTB)
#define PG8_SB(b, h) ((4 + (b) * 2 + (h)) * HTB)
#define PG8_STAGE(bufoff, gbase, voff) do { _Pragma("unroll") for (int _i = 0; _i < 2; ++_i) \
        __builtin_amdgcn_global_load_lds((const unsigned*)((const char*)(gbase) + (voff)[_i]), (PG8_LAS unsigned*)(lds + (bufoff) + ldsw + _i * 8192), 16, 0, 0); } while (0)
#define PG8_LDA(dst, b, h) do { _Pragma("unroll") for (int m = 0; m < 4; ++m) _Pragma("unroll") for (int k = 0; k < 2; ++k) dst[m][k] = *(const PG8_LAS bf16x8*)(lds + PG8_SA(b, h) + aoff + m * 2048 + k * 1024); } while (0)
#define PG8_LDB(dst, b, h) do { _Pragma("unroll") for (int n = 0; n < 2; ++n) _Pragma("unroll") for (int k = 0; k < 2; ++k) dst[n][k] = *(const PG8_LAS bf16x8*)(lds + PG8_SB(b, h) + boff + n * 2048 + k * 1024); } while (0)
#define PG8_MMA(ai, bj, At, Bt) do { __builtin_amdgcn_s_setprio(1); _Pragma("unroll") for (int m = 0; m < 4; ++m) _Pragma("unroll") for (int n = 0; n < 2; ++n) _Pragma("unroll") for (int k = 0; k < 2; ++k) \
        acc[ai][bj][m][n] = __builtin_amdgcn_mfma_f32_16x16x32_bf16(Bt[n][k], At[m][k], acc[ai][bj][m][n], 0, 0, 0); __builtin_amdgcn_s_setprio(0); } while (0)
#define PG8_WAIT_V(n) asm volatile("s_waitcnt vmcnt(" #n ")" ::: "memory")
#define PG8_WAIT_L(n) asm volatile("s_waitcnt lgkmcnt(" #n ")" ::: "memory")
#define PG8_BAR __builtin_amdgcn_s_barrier()
#define PG8_SCHED __builtin_amdgcn_sched_barrier(0)
    Unit cur, nxt; int ui = 0;
    if (!S.next(0, cur)) return;
    f32x4 acc[2][2][4][2];
#pragma unroll
    for (int a = 0; a < 2; ++a)
#pragma unroll
        for (int b = 0; b < 2; ++b)
#pragma unroll
            for (int m = 0; m < 4; ++m)
#pragma unroll
                for (int n = 0; n < 2; ++n) acc[a][b][m][n] = (f32x4){0.f, 0.f, 0.f, 0.f};
    bf16x8 At[4][2], B0[2][2], B1[2][2];
    const char* cA = (const char*)g.A + (size_t)cur.pm * tstep; const char* cB = (const char*)g.Bt + (size_t)cur.pn * tstep;
    S.a_ready(cur);
    if constexpr (SP2) {
        PG8_STAGE(PG8_SB(0, 0), cB, voffB); PG8_STAGE(PG8_SB(0, 1), cB + hstep, voffB); PG8_STAGE(PG8_SA(0, 0), cA, voffA); PG8_STAGE(PG8_SA(0, 1), cA + hstep, voffA);
        if (wr == 1) PG8_BAR;
        PG8_WAIT_V(2); PG8_BAR;
        PG8_STAGE(PG8_SB(1, 0), cB + kstep, voffB); PG8_STAGE(PG8_SA(1, 0), cA + kstep, voffA); PG8_STAGE(PG8_SB(1, 1), cB + hstep + kstep, voffB);
        PG8_WAIT_V(6); PG8_BAR;
    } else {
        PG8_STAGE(PG8_SB(0, 0), cB, voffB); PG8_STAGE(PG8_SA(0, 0), cA, voffA); PG8_STAGE(PG8_SB(0, 1), cB + hstep, voffB); PG8_STAGE(PG8_SA(0, 1), cA + hstep, voffA);
        if (wr == 1) PG8_BAR;
        PG8_WAIT_V(4); PG8_BAR;
        PG8_STAGE(PG8_SB(1, 0), cB + kstep, voffB); PG8_STAGE(PG8_SA(1, 0), cA + kstep, voffA); PG8_STAGE(PG8_SB(1, 1), cB + hstep + kstep, voffB);
        PG8_WAIT_V(6); PG8_BAR;
    }
    for (;;) {
        const bool has_next = S.next(ui + 1, nxt);
        const char* nA = has_next ? (const char*)g.A + (size_t)nxt.pm * tstep : cA; const char* nB = has_next ? (const char*)g.Bt + (size_t)nxt.pn * tstep : cB;
        for (int t = 0; t < nt; t += 2) {
            const bool last = (t == nt - 2);
            const char* a1 = cA + (size_t)(t + 1) * kstep;
            const char* a2 = last ? nA : cA + (size_t)(t + 2) * kstep; const char* b2 = last ? nB : cB + (size_t)(t + 2) * kstep;
            const char* a3 = a2 + kstep; const char* b3 = b2 + kstep;
            if (last && has_next) S.a_ready(nxt);
            if constexpr (SP2) {
            PG8_LDB(B0, 0, 0); PG8_LDB(B1, 0, 1); PG8_SCHED; PG8_LDA(At, 0, 0); PG8_STAGE(PG8_SA(1, 1), a1 + hstep, voffA);
            PG8_WAIT_V(8); PG8_WAIT_L(0); PG8_BAR; PG8_MMA(0, 0, At, B0); PG8_MMA(0, 1, At, B1); PG8_BAR; PG8_SCHED;
            PG8_LDA(At, 0, 1); PG8_STAGE(PG8_SB(0, 0), b2, voffB); PG8_STAGE(PG8_SB(0, 1), b2 + hstep, voffB); PG8_STAGE(PG8_SA(0, 0), a2, voffA);
            PG8_WAIT_V(8); PG8_WAIT_L(0); PG8_BAR; PG8_MMA(1, 0, At, B0); PG8_MMA(1, 1, At, B1); PG8_BAR; PG8_SCHED;
            PG8_LDB(B0, 1, 0); PG8_LDB(B1, 1, 1); PG8_SCHED; PG8_LDA(At, 1, 0); PG8_STAGE(PG8_SA(0, 1), a2 + hstep, voffA);
            PG8_WAIT_V(8); PG8_WAIT_L(0); PG8_BAR; PG8_MMA(0, 0, At, B0); PG8_MMA(0, 1, At, B1); PG8_BAR; PG8_SCHED;
            PG8_LDA(At, 1, 1); PG8_STAGE(PG8_SB(1, 0), b3, voffB); PG8_STAGE(PG8_SB(1, 1), b3 + hstep, voffB); PG8_STAGE(PG8_SA(1, 0), a3, voffA);
            PG8_WAIT_V(8); PG8_WAIT_L(0); PG8_BAR; PG8_MMA(1, 0, At, B0); PG8_MMA(1, 1, At, B1); PG8_BAR; PG8_SCHED;
            } else {
            PG8_LDB(B0, 0, 0); PG8_SCHED; PG8_LDA(At, 0, 0); PG8_STAGE(PG8_SA(1, 1), a1 + hstep, voffA);
            PG8_WAIT_L(8); PG8_BAR; PG8_WAIT_L(0); PG8_MMA(0, 0, At, B0); PG8_BAR; PG8_SCHED;
            PG8_LDB(B1, 0, 1); PG8_STAGE(PG8_SB(0, 0), b2, voffB);
            PG8_BAR; PG8_WAIT_L(0); PG8_MMA(0, 1, At, B1); PG8_BAR;
            PG8_LDA(At, 0, 1); PG8_STAGE(PG8_SA(0, 0), a2, voffA);
            PG8_BAR; PG8_WAIT_L(0); PG8_MMA(1, 0, At, B0); PG8_BAR; PG8_SCHED;
            PG8_STAGE(PG8_SB(0, 1), b2 + hstep, voffB);
            PG8_WAIT_V(6); PG8_BAR; PG8_MMA(1, 1, At, B1); PG8_BAR;
            PG8_LDB(B0, 1, 0); PG8_SCHED; PG8_LDA(At, 1, 0); PG8_STAGE(PG8_SA(0, 1), a2 + hstep, voffA);
            PG8_WAIT_L(8); PG8_BAR; PG8_WAIT_L(0); PG8_MMA(0, 0, At, B0); PG8_BAR; PG8_SCHED;
            PG8_LDB(B1, 1, 1); PG8_STAGE(PG8_SB(1, 0), b3, voffB);
            PG8_BAR; PG8_WAIT_L(0); PG8_MMA(0, 1, At, B1); PG8_BAR;
            PG8_LDA(At, 1, 1); PG8_STAGE(PG8_SA(1, 0), a3, voffA);
            PG8_BAR; PG8_WAIT_L(0); PG8_MMA(1, 0, At, B0); PG8_BAR; PG8_SCHED;
            PG8_STAGE(PG8_SB(1, 1), b3 + hstep, voffB);
            PG8_WAIT_V(6); PG8_BAR; PG8_MMA(1, 1, At, B1); PG8_BAR;
            }
        }
        if constexpr (ALIGN_EPI) { if (wr == 0) PG8_BAR; }
        if constexpr (!Epi::AFTER_DRAIN) { E(acc, cur, wr, wc, fr, fq); S.done(cur); }
        if (!has_next) break;
#pragma unroll
        for (int a = 0; a < 2; ++a)
#pragma unroll
            for (int b = 0; b < 2; ++b)
#pragma unroll
                for (int m = 0; m < 4; ++m)
#pragma unroll
                    for (int n = 0; n < 2; ++n) acc[a][b][m][n] = (f32x4){0.f, 0.f, 0.f, 0.f};
        cur = nxt; cA = nA; cB = nB; ++ui;
        if constexpr (ALIGN_EPI) { if (wr == 1) PG8_BAR; }
    }
    PG8_WAIT_V(0);
    if constexpr (!ALIGN_EPI) { if (wr == 0) PG8_BAR; }
    PG8_BAR;
    if constexpr (Epi::AFTER_DRAIN) { E.fused(acc, cur, wr, wc, fr, fq, lds, wid, lane); S.done(cur); }
#undef PG8_SA
#undef PG8_SB
#undef PG8_STAGE
#undef PG8_LDA
#undef PG8_LDB
#undef PG8_MMA
#undef PG8_WAIT_V
#undef PG8_WAIT_L
#undef PG8_BAR
#undef PG8_SCHED
}
}

#define LAS __attribute__((address_space(3)))
typedef unsigned short bf16;
typedef float f32x4 __attribute__((ext_vector_type(4)));
typedef float f32x2 __attribute__((ext_vector_type(2)));
typedef float f32x16 __attribute__((ext_vector_type(16)));
typedef short bf16x8 __attribute__((ext_vector_type(8)));
typedef short s16x4 __attribute__((ext_vector_type(4)));
typedef unsigned u32x4 __attribute__((ext_vector_type(4)));
typedef unsigned u32x2 __attribute__((ext_vector_type(2)));

constexpr int DM = 1024, NB = 32, TS = 2048, SB = 8, ST = 16, PAST = 4096;
constexpr int NPG = 2;
constexpr int RG = NB * TS / NPG;
constexpr int GBATCH = NB / NPG;
constexpr int NGRP = NPG + 1;
constexpr int NIN = 5888;
constexpr float LOG2E = 1.4426950408889634f;
constexpr float EPSN = 1e-6f;
constexpr int NSPLIT = 4;
constexpr int CACHE_ROWS = SB * PAST;

constexpr size_t O_YP = 0, O_YS = 67108864, O_KDP = 67239936, O_VDP = 134348800, O_CKVP = 201457664, O_KRP = 218234880,
                 O_KDS = 220332032, O_VDS = 220463104, O_CKVS = 220594176, O_KRS = 220626944;
constexpr size_t MiB = 1u << 20;
constexpr size_t WS_TAB = 0;
constexpr size_t WS_ROPE = 8192;
constexpr size_t WS_WIN = 1 * MiB;
constexpr size_t WS_WUQ = WS_WIN + (size_t)NIN * 1024 * 2;
constexpr size_t WS_WUKV = WS_WUQ + 1536 * 256 * 2;
constexpr size_t WS_WOD = WS_WUKV + 2048 * 256 * 2;
constexpr size_t WS_WOM = WS_WOD + 2 * MiB;
constexpr size_t WS_WOUT = WS_WOM + 2 * MiB;
constexpr size_t WS_WUP = WS_WOUT + 2 * MiB;
constexpr size_t WS_WDN = WS_WUP + 8 * MiB;
constexpr size_t WS_WEND = WS_WDN + 8 * MiB;
constexpr size_t WS_SAMP = 37 * MiB;
constexpr size_t WS_PART = 44 * MiB;
constexpr size_t WS_PO_D = WS_PART, WS_PO_M = WS_PART + 8 * MiB, WS_PM = WS_PART + 12 * MiB, WS_PL = WS_PM + 131072;
constexpr size_t WS_PROMPT = 58 * MiB;
constexpr size_t GRP_BYTES_PER_ROW = 27720;
constexpr size_t WS_NEED = WS_PROMPT + (size_t)RG * GRP_BYTES_PER_ROW;
static_assert(WS_WEND <= WS_SAMP && WS_SAMP + 256 * GRP_BYTES_PER_ROW <= WS_PART && WS_PL + 131072 <= WS_PROMPT, "ws map");
constexpr size_t C_KDC = 0, C_VDC = 64 * MiB, C_KNC = 128 * MiB, C_VMC = 192 * MiB, C_CKVC = 256 * MiB, C_KRC = 272 * MiB;

struct Args { const float* in[26]; float* out; unsigned char* ws; int pad0, pad1; };

struct Grp {
    const float* x; float* y; float* okd; float* ovd; float* ockv; float* okr;
    int nvalid, ntiles, sample;
    bf16 *QD, *KD, *VD, *QN, *U, *XN, *QR, *KN, *VM, *GD, *GM, *DO, *MO, *CQ, *CKV, *KR; float* ZS; float* SSQ;
};
__device__ __forceinline__ Grp make_grp(const Args& a, int g) {
    Grp G; unsigned char* base; size_t RC;
    if (g == 0) {
        G.x = a.in[1]; G.y = a.out + O_YS; G.okd = a.out + O_KDS; G.ovd = a.out + O_VDS; G.ockv = a.out + O_CKVS; G.okr = a.out + O_KRS;
        G.nvalid = SB * ST; G.ntiles = 1; G.sample = 1; base = a.ws + WS_SAMP; RC = 256;
    } else {
        const size_t r0 = (size_t)(g - 1) * RG;
        G.x = a.in[0] + r0 * 1024; G.y = a.out + O_YP + r0 * 1024; G.okd = a.out + O_KDP + r0 * 1024; G.ovd = a.out + O_VDP + r0 * 1024;
        G.ockv = a.out + O_CKVP + r0 * 256; G.okr = a.out + O_KRP + r0 * 32;
        G.nvalid = RG; G.ntiles = RG / 256; G.sample = 0; base = a.ws + WS_PROMPT; RC = RG;
    }
    G.QD = (bf16*)(base); G.KD = (bf16*)(base + RC * 2048); G.VD = (bf16*)(base + RC * 4096); G.QN = (bf16*)(base + RC * 6144); G.U = (bf16*)base;
    G.XN = (bf16*)(base + RC * 8192); G.QR = (bf16*)(base + RC * 10240); G.KN = (bf16*)(base + RC * 11264); G.VM = (bf16*)(base + RC * 13312);
    G.GD = (bf16*)(base + RC * 15360); G.GM = (bf16*)(base + RC * 17408); G.DO = (bf16*)(base + RC * 19456); G.MO = (bf16*)(base + RC * 21504);
    G.ZS = (float*)(base + RC * 23552); G.CQ = (bf16*)(base + RC * 26624); G.CKV = (bf16*)(base + RC * 27136); G.KR = (bf16*)(base + RC * 27648); G.SSQ = (float*)(base + RC * 27712);
    return G;
}

template <int M> __device__ __forceinline__ float swz_xor(float v) { return __int_as_float(__builtin_amdgcn_ds_swizzle(__float_as_int(v), 0x1F | (M << 10))); }
__device__ __forceinline__ float half_sum32(float v) { v += swz_xor<1>(v); v += swz_xor<2>(v); v += swz_xor<4>(v); v += swz_xor<8>(v); v += swz_xor<16>(v); return v; }
__device__ __forceinline__ float wave_sum(float v) {
    v = half_sum32(v);
    auto rr = __builtin_amdgcn_permlane32_swap(__float_as_uint(v), __float_as_uint(v), false, false);
    return __uint_as_float(rr[0]) + __uint_as_float(rr[1]);
}
typedef __bf16 bf16x2_hw __attribute__((ext_vector_type(2)));
__device__ __forceinline__ unsigned pk2(float lo, float hi) { f32x2 v = {lo, hi}; bf16x2_hw b = __builtin_convertvector(v, bf16x2_hw); return __builtin_bit_cast(unsigned, b); }
__device__ __forceinline__ unsigned f2bf(float f) { return pk2(f, 0.f) & 0xffffu; }
__device__ __forceinline__ float bflo(unsigned w) { return __builtin_bit_cast(float, w << 16); }
__device__ __forceinline__ float bfhi(unsigned w) { return __builtin_bit_cast(float, w & 0xffff0000u); }
__device__ __forceinline__ void st_bf4(bf16* p, f32x4 v) { u32x2 w; w.x = pk2(v[0], v[1]); w.y = pk2(v[2], v[3]); *(u32x2*)p = w; }
__device__ __forceinline__ f32x4 ld_bf4(const bf16* p) { const u32x2 w = *(const u32x2*)p; return (f32x4){bflo(w.x), bfhi(w.x), bflo(w.y), bfhi(w.y)}; }
__device__ __forceinline__ float sigm(float x) { return 1.f / (1.f + __expf(-x)); }

#define EPI_LOOP(BODY) \
    _Pragma("unroll") for (int ai = 0; ai < 2; ++ai) _Pragma("unroll") for (int m = 0; m < 4; ++m) { const int row = u.pm * 256 + ai * 128 + wr * 64 + m * 16 + fr; const size_t rw = (size_t)row; (void)rw; \
    _Pragma("unroll") for (int bj = 0; bj < 2; ++bj) _Pragma("unroll") for (int n = 0; n < 2; ++n) { const int cl = bj * 128 + wc * 32 + n * 16 + 4 * fq; const f32x4 v = acc[ai][bj][m][n]; BODY } asm volatile("" ::: "memory"); }

#define EPI_LOOP_P(...) \
    _Pragma("unroll") for (int ai = 0; ai < 2; ++ai) _Pragma("unroll") for (int m = 0; m < 4; ++m) { const int row = u.pm * 256 + ai * 128 + wr * 64 + m * 16 + fr; const size_t rw = (size_t)row; (void)rw; \
    _Pragma("unroll") for (int bj = 0; bj < 2; ++bj) { const int cl = bj * 128 + wc * 32 + 8 * fq; const f32x4 v0 = acc[ai][bj][m][0], v1 = acc[ai][bj][m][1]; __VA_ARGS__ } asm volatile("" ::: "memory"); }
__device__ __forceinline__ void st_bf8(bf16* p, f32x4 a, f32x4 b) { u32x4 w; w.x = pk2(a[0], a[1]); w.y = pk2(a[2], a[3]); w.z = pk2(b[0], b[1]); w.w = pk2(b[2], b[3]); *(u32x4*)p = w; }
__device__ __forceinline__ void ld_bf8(const bf16* p, f32x4& a, f32x4& b) { const u32x4 w = *(const u32x4*)p; a = (f32x4){bflo(w.x), bfhi(w.x), bflo(w.y), bfhi(w.y)}; b = (f32x4){bflo(w.z), bfhi(w.z), bflo(w.w), bfhi(w.w)}; }
__device__ __forceinline__ f32x4 sigm4(f32x4 v) { return (f32x4){sigm(v[0]), sigm(v[1]), sigm(v[2]), sigm(v[3])}; }
typedef const f32x4 (&AccRef)[2][2][4][2];

struct EpiIn {
    static constexpr bool PERM = true, AFTER_DRAIN = false;
    bf16 *QD, *KD, *VD, *GD, *GM; float *ZS, *okd, *ovd; int nvalid; float qs;
    __device__ __forceinline__ void operator()(AccRef acc, const pg8::Unit& u, int wr, int wc, int fr, int fq) const {
        const int t = u.pn;
        if (t < 4) { const int c0 = t * 256; EPI_LOOP_P( st_bf8(QD + rw * 1024 + c0 + cl, v0 * qs, v1 * qs); ) }
        else if (t < 8) { const int c0 = (t - 4) * 256; EPI_LOOP_P( st_bf8(KD + rw * 1024 + c0 + cl, v0, v1); if (row < nvalid) { float* o = okd + rw * 1024 + c0 + cl; *(f32x4*)o = v0; *(f32x4*)(o + 4) = v1; } ) }
        else if (t < 12) { const int c0 = (t - 8) * 256; EPI_LOOP_P( st_bf8(VD + rw * 1024 + c0 + cl, v0, v1); if (row < nvalid) { float* o = ovd + rw * 1024 + c0 + cl; *(f32x4*)o = v0; *(f32x4*)(o + 4) = v1; } ) }
        else if (t < 15) { const int c0 = (t - 12) * 256; EPI_LOOP_P( float* o = ZS + rw * 768 + c0 + cl; *(f32x4*)o = v0; *(f32x4*)(o + 4) = v1; ) }
        else if (t < 19) { const int c0 = (t - 15) * 256; EPI_LOOP_P( st_bf8(GD + rw * 1024 + c0 + cl, sigm4(v0), sigm4(v1)); ) }
        else { const int c0 = (t - 19) * 256; EPI_LOOP_P( st_bf8(GM + rw * 1024 + c0 + cl, sigm4(v0), sigm4(v1)); ) }
    }
};
struct EpiQ {
    static constexpr bool PERM = false, AFTER_DRAIN = false;
    bf16 *QN, *QR; const float* rope; int sample; float qs;
    __device__ __forceinline__ void operator()(AccRef acc, const pg8::Unit& u, int wr, int wc, int fr, int fq) const {
        const int t = u.pn;
        if (t < 4) { const int c0 = t * 256; EPI_LOOP( st_bf4(QN + rw * 1024 + c0 + cl, v * qs); ) }
        else {
            const int c0 = (t - 4) * 256;
#pragma unroll
            for (int ai = 0; ai < 2; ++ai)
#pragma unroll
                for (int m = 0; m < 4; ++m) {
                    const int row = u.pm * 256 + ai * 128 + wr * 64 + m * 16 + fr;
                    const int pos = sample ? (PAST + (row & (ST - 1))) : (row & (TS - 1));
                    const f32x4 cs0 = *(const f32x4*)(rope + (size_t)pos * 32 + 8 * fq), cs1 = *(const f32x4*)(rope + (size_t)pos * 32 + 8 * fq + 4);
#pragma unroll
                    for (int bj = 0; bj < 2; ++bj) {
                        const f32x4 x1 = acc[ai][bj][m][0], x2 = acc[ai][bj][m][1];
                        f32x4 o1, o2;
                        o1[0] = x1[0] * cs0[0] - x2[0] * cs0[1]; o2[0] = x2[0] * cs0[0] + x1[0] * cs0[1];
                        o1[1] = x1[1] * cs0[2] - x2[1] * cs0[3]; o2[1] = x2[1] * cs0[2] + x1[1] * cs0[3];
                        o1[2] = x1[2] * cs1[0] - x2[2] * cs1[1]; o2[2] = x2[2] * cs1[0] + x1[2] * cs1[1];
                        o1[3] = x1[3] * cs1[2] - x2[3] * cs1[3]; o2[3] = x2[3] * cs1[2] + x1[3] * cs1[3];
                        bf16* p = QR + (size_t)row * 512 + c0 + bj * 128 + wc * 32 + 4 * fq;
                        st_bf4(p, o1 * qs); st_bf4(p + 16, o2 * qs);
                    }
                    asm volatile("" ::: "memory");
                }
        }
    }
};
struct EpiKV {
    static constexpr bool PERM = true, AFTER_DRAIN = false;
    bf16 *KN, *VM;
    __device__ __forceinline__ void operator()(AccRef acc, const pg8::Unit& u, int wr, int wc, int fr, int fq) const {
        const int t = u.pn; bf16* O = t < 4 ? KN : VM; const int c0 = (t & 3) * 256;
        EPI_LOOP_P( st_bf8(O + rw * 1024 + c0 + cl, v0, v1); )
    }
};
struct EpiM1 {
    static constexpr bool PERM = true, AFTER_DRAIN = false;
    const bf16* Gt; bf16* MG;
    __device__ __forceinline__ void operator()(AccRef acc, const pg8::Unit& u, int wr, int wc, int fr, int fq) const {
        const int c0 = u.pn * 256;
        EPI_LOOP_P( f32x4 g0, g1; ld_bf8(Gt + rw * 1024 + c0 + cl, g0, g1); st_bf8(MG + rw * 1024 + c0 + cl, g0 * v0, g1 * v1); )
    }
};
struct EpiM2 {
    static constexpr bool PERM = true, AFTER_DRAIN = false;
    const bf16* Gt; bf16* MG;
    __device__ __forceinline__ void operator()(AccRef acc, const pg8::Unit& u, int wr, int wc, int fr, int fq) const {
        const int c0 = u.pn * 256;
        EPI_LOOP_P( f32x4 g0, g1, o0, o1; ld_bf8(Gt + rw * 1024 + c0 + cl, g0, g1); ld_bf8(MG + rw * 1024 + c0 + cl, o0, o1); st_bf8(MG + rw * 1024 + c0 + cl, o0 + g0 * v0, o1 + g1 * v1); )
    }
};
struct EpiOut {
    static constexpr bool PERM = true, AFTER_DRAIN = false;
    const float* x; bf16* XB; float* SSQ; int nvalid;
    __device__ __forceinline__ void operator()(AccRef acc, const pg8::Unit& u, int wr, int wc, int fr, int fq) const {
        const int c0 = u.pn * 256;
#pragma unroll
        for (int ai = 0; ai < 2; ++ai)
#pragma unroll
            for (int m = 0; m < 4; ++m) {
                const int row = u.pm * 256 + ai * 128 + wr * 64 + m * 16 + fr; const size_t rw = (size_t)row; const bool ok = row < nvalid;
                float s = 0.f;
#pragma unroll
                for (int bj = 0; bj < 2; ++bj) {
                    const int cl = bj * 128 + wc * 32 + 8 * fq;
                    f32x4 v0 = {0.f, 0.f, 0.f, 0.f}, v1 = {0.f, 0.f, 0.f, 0.f};
                    if (ok) { const float* xb = x + rw * 1024 + c0 + cl; v0 = *(const f32x4*)xb + acc[ai][bj][m][0]; v1 = *(const f32x4*)(xb + 4) + acc[ai][bj][m][1]; }
                    st_bf8(XB + rw * 1024 + c0 + cl, v0, v1);
                    s += (v0[0] * v0[0] + v0[1] * v0[1]) + (v0[2] * v0[2] + v0[3] * v0[3]) + (v1[0] * v1[0] + v1[1] * v1[1]) + (v1[2] * v1[2] + v1[3] * v1[3]);
                }
                s += swz_xor<16>(s);
                { auto rr = __builtin_amdgcn_permlane32_swap(__float_as_uint(s), __float_as_uint(s), false, false); s = __uint_as_float(rr[0]) + __uint_as_float(rr[1]); }
                if (ok && fq == 0) atomicAdd(SSQ + row, s);
                asm volatile("" ::: "memory");
            }
    }
};
struct EpiUp {
    static constexpr bool PERM = true, AFTER_DRAIN = false;
    bf16* U; const float* SSQ;
    __device__ __forceinline__ void operator()(AccRef acc, const pg8::Unit& u, int wr, int wc, int fr, int fq) const {
        const int c0 = u.pn * 256;
#pragma unroll
        for (int ai = 0; ai < 2; ++ai)
#pragma unroll
            for (int m = 0; m < 4; ++m) {
                const int row = u.pm * 256 + ai * 128 + wr * 64 + m * 16 + fr; const size_t rw = (size_t)row;
                const float rs2 = 1.0f / (SSQ[row] * (1.f / 1024.f) + EPSN);
#pragma unroll
                for (int bj = 0; bj < 2; ++bj) {
                    const int cl = bj * 128 + wc * 32 + 8 * fq; const f32x4 v0 = acc[ai][bj][m][0], v1 = acc[ai][bj][m][1];
                    f32x4 r0, r1; r0[0] = fmaxf(v0[0], 0.f); r0[1] = fmaxf(v0[1], 0.f); r0[2] = fmaxf(v0[2], 0.f); r0[3] = fmaxf(v0[3], 0.f); r1[0] = fmaxf(v1[0], 0.f); r1[1] = fmaxf(v1[1], 0.f); r1[2] = fmaxf(v1[2], 0.f); r1[3] = fmaxf(v1[3], 0.f);
                    st_bf8(U + rw * 4096 + c0 + cl, r0 * r0 * rs2, r1 * r1 * rs2);
                }
                asm volatile("" ::: "memory");
            }
    }
};
struct EpiDown {
    static constexpr bool PERM = true, AFTER_DRAIN = false;
    const bf16* XB; float* y; int nvalid;
    __device__ __forceinline__ void operator()(AccRef acc, const pg8::Unit& u, int wr, int wc, int fr, int fq) const {
        const int c0 = u.pn * 256;
        EPI_LOOP_P( if (row < nvalid) { f32x4 b0, b1; ld_bf8(XB + rw * 1024 + c0 + cl, b0, b1); float* p = y + rw * 1024 + c0 + cl; *(f32x4*)p = b0 + v0; *(f32x4*)(p + 4) = b1 + v1; } )
    }
};
struct EpiDownAtomic {
    static constexpr bool PERM = true, AFTER_DRAIN = false;
    float* y; int nvalid;
    __device__ __forceinline__ void operator()(AccRef acc, const pg8::Unit& u, int wr, int wc, int fr, int fq) const {
        const int c0 = u.pn * 256;
        EPI_LOOP_P( if (row < nvalid) { float* p = y + rw * 1024 + c0 + cl;
            _Pragma("unroll") for (int e = 0; e < 4; ++e) { atomicAdd(p + e, v0[e]); atomicAdd(p + 4 + e, v1[e]); } } )
    }
};

template <class Epi>
__device__ __forceinline__ void run_gemm(LAS unsigned char* lds, const bf16* A, const bf16* Bt, int M, int N, int K, const Epi& E, const int tid_in, const int ld = 0, const int cshift = 0) {
    int Kr = K; asm volatile("" : "+s"(Kr));
    const int Gn = (int)gridDim.x; int c = (int)blockIdx.x - cshift; if (c < 0) c += Gn;
    pg8::Gemm g{A, Bt, M, N, Kr, ld ? ld : Kr}; pg8::StaticOrder S; S.init(M, N, Gn, c);
    pg8::gemm_phase<Epi, pg8::StaticOrder, true, true>(lds, g, S, E, tid_in);
}

__device__ __forceinline__ void rms_rows_bf16(const float* src, bf16* dst, const float* gain, int nvalid, int ntotal, int gw, int ngw, int lane, float* ssq_zero) {
    f32x4 g[4];
#pragma unroll
    for (int j = 0; j < 4; ++j) g[j] = ((const f32x4*)gain)[lane + 64 * j];
    for (int r0 = 2 * gw; r0 < ntotal; r0 += 2 * ngw) {
        f32x4 v[2][4];
#pragma unroll
        for (int k = 0; k < 2; ++k) { const int r = r0 + k; const f32x4* xr = (const f32x4*)(src + (size_t)(r < nvalid ? r : 0) * 1024) + lane;
#pragma unroll
            for (int j = 0; j < 4; ++j) v[k][j] = xr[64 * j]; }
#pragma unroll
        for (int k = 0; k < 2; ++k) { const int r = r0 + k; if (r >= ntotal) continue;
            if (lane == 0) ssq_zero[r] = 0.f;
            u32x2* o8 = (u32x2*)(dst + (size_t)r * 1024) + lane;
            float s = 0.f;
#pragma unroll
            for (int j = 0; j < 4; ++j) s += (v[k][j][0] * v[k][j][0] + v[k][j][1] * v[k][j][1]) + (v[k][j][2] * v[k][j][2] + v[k][j][3] * v[k][j][3]);
            const float rs = (r < nvalid) ? 1.0f / sqrtf(wave_sum(s) * (1.f / 1024.f) + EPSN) : 0.f;
#pragma unroll
            for (int j = 0; j < 4; ++j) { const f32x4 o = v[k][j] * rs * g[j]; o8[64 * j] = (u32x2){pk2(o[0], o[1]), pk2(o[2], o[3])}; } }
    }
}
__device__ __forceinline__ void rms_rows_f32_inplace(float* y, const float* gain, int nvalid, int gw, int ngw, int lane) {
    f32x4 g[4];
#pragma unroll
    for (int j = 0; j < 4; ++j) g[j] = ((const f32x4*)gain)[lane + 64 * j];
    for (int r0 = 2 * gw; r0 < nvalid; r0 += 2 * ngw) {
        f32x4 v[2][4];
#pragma unroll
        for (int k = 0; k < 2; ++k) { const int r = r0 + k; f32x4* xr = (f32x4*)(y + (size_t)(r < nvalid ? r : r0) * 1024) + lane;
#pragma unroll
            for (int j = 0; j < 4; ++j) v[k][j] = xr[64 * j]; }
#pragma unroll
        for (int k = 0; k < 2; ++k) { const int r = r0 + k; if (r >= nvalid) continue;
            f32x4* xr = (f32x4*)(y + (size_t)r * 1024) + lane;
            float s = 0.f;
#pragma unroll
            for (int j = 0; j < 4; ++j) s += (v[k][j][0] * v[k][j][0] + v[k][j][1] * v[k][j][1]) + (v[k][j][2] * v[k][j][2] + v[k][j][3] * v[k][j][3]);
            const float rs = 1.0f / sqrtf(wave_sum(s) * (1.f / 1024.f) + EPSN);
#pragma unroll
            for (int j = 0; j < 4; ++j) xr[64 * j] = v[k][j] * rs * g[j]; }
    }
}
__device__ __forceinline__ void phase_small(const Grp& G, const float* gq, const float* gkv, const float* rope, int gw, int ngw, int lane) {
    const int ntotal = G.ntiles * 256;
    for (int r = gw; r < ntotal; r += ngw) {
        const float* z = G.ZS + (size_t)r * 768;
        const f32x4 cq = ((const f32x4*)z)[lane], ck = ((const f32x4*)(z + 256))[lane];
        const float s1 = wave_sum((cq[0] * cq[0] + cq[1] * cq[1]) + (cq[2] * cq[2] + cq[3] * cq[3]));
        const float s2 = wave_sum((ck[0] * ck[0] + ck[1] * ck[1]) + (ck[2] * ck[2] + ck[3] * ck[3]));
        const float r1 = 1.0f / sqrtf(s1 * (1.f / 256.f) + EPSN), r2 = 1.0f / sqrtf(s2 * (1.f / 256.f) + EPSN);
        const f32x4 o1 = cq * r1 * ((const f32x4*)gq)[lane], o2 = ck * r2 * ((const f32x4*)gkv)[lane];
        ((u32x2*)(G.CQ + (size_t)r * 256))[lane] = (u32x2){pk2(o1[0], o1[1]), pk2(o1[2], o1[3])};
        ((u32x2*)(G.CKV + (size_t)r * 256))[lane] = (u32x2){pk2(o2[0], o2[1]), pk2(o2[2], o2[3])};
        if (r < G.nvalid) ((f32x4*)(G.ockv + (size_t)r * 256))[lane] = o2;
        if (lane < 16) {
            const int pos = G.sample ? (PAST + (r & (ST - 1))) : (r & (TS - 1));
            const float x1 = z[512 + lane], x2 = z[512 + 16 + lane];
            const f32x2 cs = *(const f32x2*)(rope + (size_t)pos * 32 + 2 * lane);
            const float a = x1 * cs[0] - x2 * cs[1], b = x2 * cs[0] + x1 * cs[1];
            G.KR[(size_t)r * 32 + lane] = (bf16)f2bf(a); G.KR[(size_t)r * 32 + 16 + lane] = (bf16)f2bf(b);
            if (r < G.nvalid) { G.okr[(size_t)r * 32 + lane] = a; G.okr[(size_t)r * 32 + 16 + lane] = b; }
        }
    }
}

__device__ __forceinline__ void tr_item(const float* W, int K, int N, bf16* WT, int k0, int n0, int drow0, LAS float* scr, int lane, const float* kgain = nullptr) {
#pragma unroll 8
    for (int i = 0; i < 32; ++i) { const int kk = 2 * i + (lane >> 5); const float gk = kgain ? kgain[k0 + kk] : 1.f; scr[kk * 33 + (lane & 31)] = W[(size_t)(k0 + kk) * N + n0 + (lane & 31)] * gk; }
    asm volatile("s_waitcnt lgkmcnt(0)" ::: "memory");
    const int c = lane & 7;
#pragma unroll
    for (int j = 0; j < 4; ++j) { const int n = (lane >> 3) + 8 * j; const LAS float* s = scr + (8 * c) * 33 + n;
        u32x4 o; o.x = pk2(s[0 * 33], s[1 * 33]); o.y = pk2(s[2 * 33], s[3 * 33]); o.z = pk2(s[4 * 33], s[5 * 33]); o.w = pk2(s[6 * 33], s[7 * 33]);
        *(u32x4*)(WT + (size_t)(drow0 + n) * K + k0 + 8 * c) = o; }
    asm volatile("s_waitcnt lgkmcnt(0)" ::: "memory");
}
__device__ __forceinline__ int map_in(int n0) {
    if (n0 < 3616) return n0;
    if (n0 < 4640) return n0 - 3616 + 3840;
    return n0 - 4640 + 4864;
}
__device__ __forceinline__ int map_uq(int n0) { const int hh = n0 / 96, d0 = n0 % 96; return d0 < 64 ? hh * 64 + d0 : 1024 + hh * 32 + (d0 - 64); }
__device__ __forceinline__ void cvt8(const float* src, bf16* dst, size_t n8, size_t gt, size_t ngt) {
    for (size_t i = gt; i < n8; i += ngt) { const f32x4 a = ((const f32x4*)src)[2 * i], b = ((const f32x4*)src)[2 * i + 1];
        ((u32x4*)dst)[i] = (u32x4){pk2(a[0], a[1]), pk2(a[2], a[3]), pk2(b[0], b[1]), pk2(b[2], b[3])}; }
}
__device__ __forceinline__ void phase_prologue(const Args& a, LAS unsigned char* lds, int gw, int ngw, int lane, int wave) {
    unsigned char* ws = a.ws;
    LAS float* scr = (LAS float*)(lds + wave * 16384);
    constexpr int I_IN = 16 * 177, I_UQ = 4 * 48, I_UK = 4 * 32, I_UV = 4 * 32, I_O = 16 * 32, I_UP = 16 * 128, I_DN = 64 * 32;
    constexpr int NITEMS = I_IN + I_UQ + I_UK + I_UV + 3 * I_O + I_UP + I_DN;
    for (int it = gw; it < NITEMS; it += ngw) {
        int r = it;
        if (r < I_IN) { const int kb = r / 177, nb = r % 177; tr_item(a.in[8], 1024, 5664, (bf16*)(ws + WS_WIN), 64 * kb, 32 * nb, map_in(32 * nb), scr, lane); continue; } r -= I_IN;
        if (r < I_UQ) { const int kb = r / 48, nb = r % 48; tr_item(a.in[15], 256, 1536, (bf16*)(ws + WS_WUQ), 64 * kb, 32 * nb, map_uq(32 * nb), scr, lane); continue; } r -= I_UQ;
        if (r < I_UK) { const int kb = r / 32, nb = r % 32; tr_item(a.in[17], 256, 1024, (bf16*)(ws + WS_WUKV), 64 * kb, 32 * nb, 32 * nb, scr, lane); continue; } r -= I_UK;
        if (r < I_UV) { const int kb = r / 32, nb = r % 32; tr_item(a.in[18], 256, 1024, (bf16*)(ws + WS_WUKV), 64 * kb, 32 * nb, 1024 + 32 * nb, scr, lane); continue; } r -= I_UV;
        if (r < I_O) { const int kb = r / 32, nb = r % 32; tr_item(a.in[19], 1024, 1024, (bf16*)(ws + WS_WOD), 64 * kb, 32 * nb, 32 * nb, scr, lane); continue; } r -= I_O;
        if (r < I_O) { const int kb = r / 32, nb = r % 32; tr_item(a.in[20], 1024, 1024, (bf16*)(ws + WS_WOM), 64 * kb, 32 * nb, 32 * nb, scr, lane); continue; } r -= I_O;
        if (r < I_O) { const int kb = r / 32, nb = r % 32; tr_item(a.in[21], 1024, 1024, (bf16*)(ws + WS_WOUT), 64 * kb, 32 * nb, 32 * nb, scr, lane); continue; } r -= I_O;
        if (r < I_UP) { const int kb = r / 128, nb = r % 128; tr_item(a.in[23], 1024, 4096, (bf16*)(ws + WS_WUP), 64 * kb, 32 * nb, 32 * nb, scr, lane, a.in[22]); continue; } r -= I_UP;
        { const int kb = r / 32, nb = r % 32; tr_item(a.in[24], 4096, 1024, (bf16*)(ws + WS_WDN), 64 * kb, 32 * nb, 32 * nb, scr, lane); }
    }
    const size_t gt = (size_t)gw * 64 + lane, ngt = (size_t)ngw * 64;
    { u32x4* z = (u32x4*)(ws + WS_WIN + (size_t)3616 * 2048); for (size_t i = gt; i < (size_t)224 * 128; i += ngt) z[i] = (u32x4){0u, 0u, 0u, 0u}; }
    unsigned char* cb = ws + WS_PROMPT;
    cvt8(a.in[2], (bf16*)(cb + C_KDC), (size_t)CACHE_ROWS * 128, gt, ngt);
    cvt8(a.in[3], (bf16*)(cb + C_VDC), (size_t)CACHE_ROWS * 128, gt, ngt);
    cvt8(a.in[4], (bf16*)(cb + C_CKVC), (size_t)CACHE_ROWS * 32, gt, ngt);
    cvt8(a.in[5], (bf16*)(cb + C_KRC), (size_t)CACHE_ROWS * 4, gt, ngt);
    float* tab = (float*)(ws + WS_TAB);
    for (size_t i = gt; i < 8 * 192; i += ngt) {
        const int h = (int)i / 192, idx = (int)i % 192, rel = idx - 128, n = rel < 0 ? -rel : rel;
        int bucket = n;
        if (n >= 8) { int j = (31 - __clz(n * n)) - 6; bucket = 8 + j; if (bucket > 15) bucket = 15; }
        if (rel > 0) bucket += 16;
        tab[i] = (a.in[6][bucket * 8 + h] - a.in[6][15 * 8 + h]) * LOG2E;
    }
    if (gt == 0) {
        float d1 = 0.f, d2 = 0.f;
        for (int i = 0; i < 64; ++i) { d1 += a.in[9][i] * a.in[10][i]; d2 += a.in[11][i] * a.in[12][i]; }
        tab[1536] = expf(d1) - expf(d2) + 0.2f;
    }
    float* rope = (float*)(ws + WS_ROPE);
    for (size_t i = gt; i < (size_t)(PAST + ST) * 16; i += ngt) {
        const int pos = (int)(i >> 4), k = (int)(i & 15);
        const float inv = __builtin_amdgcn_exp2f(-(float)k * 0.8304820237218406f);
        const float ang = (float)pos * inv;
        const double rev = (double)ang * 0.15915494309189535;
        const float fr = (float)(rev - __builtin_rint(rev));
        rope[2 * i] = __builtin_amdgcn_cosf(fr); rope[2 * i + 1] = __builtin_amdgcn_sinf(fr);
    }
}

#ifndef ATTMASK
#define ATTMASK 15
#endif
constexpr int AL_TAB = 0, AL_WSF = 6144, AL_TILE = 8192;

__device__ __forceinline__ int crow(int r, int hi) { return (r & 3) + 8 * (r >> 2) + 4 * hi; }
__device__ __forceinline__ float xmax32(float v) { auto rr = __builtin_amdgcn_permlane32_swap(__float_as_uint(v), __float_as_uint(v), false, false); return fmaxf(__uint_as_float(rr[0]), __uint_as_float(rr[1])); }
__device__ __forceinline__ float xsum32(float v) { auto rr = __builtin_amdgcn_permlane32_swap(__float_as_uint(v), __float_as_uint(v), false, false); return __uint_as_float(rr[0]) + __uint_as_float(rr[1]); }
typedef __bf16 bf16x2_t __attribute__((ext_vector_type(2)));
__device__ __forceinline__ unsigned cvtpk(float lo, float hi) { f32x2 v = {lo, hi}; bf16x2_t b = __builtin_convertvector(v, bf16x2_t); return __builtin_bit_cast(unsigned, b); }
__device__ __forceinline__ bf16x8 pack8(float a0, float a1, float a2, float a3, float a4, float a5, float a6, float a7) {
    u32x4 w = {cvtpk(a0, a1), cvtpk(a2, a3), cvtpk(a4, a5), cvtpk(a6, a7)}; return __builtin_bit_cast(bf16x8, w);
}
typedef short v4i16_t __attribute__((ext_vector_type(4)));
__device__ __forceinline__ s16x4 vtr(const LAS unsigned char* p) { return __builtin_bit_cast(s16x4, __builtin_amdgcn_ds_read_tr16_b64_v4i16((LAS v4i16_t*)p)); }

template <int DQK, int DV> struct AttnState { bf16x8 qf[DQK / 16]; f32x16 o[DV / 32]; f32x16 negm; float m, l; };
constexpr float ATT_THR = 8.0f;

template <int DQK, int DV, bool HAS_BIAS>
__device__ __forceinline__ void attn_tile(AttnState<DQK, DV>& st, const LAS unsigned char* Kt, const LAS unsigned char* Vt, int bias_mode, const LAS float* tab, int rel0, int nkeys, bool first, LAS float* wsf, int lane) {
    constexpr int PK = DQK * 2 + 16, PV = DV * 2 + 64, KS = DQK / 16, NDB = DV / 32;
    const int q = lane & 31, hi = lane >> 5;
    f32x16 p0, p1;
    const LAS unsigned char* kp = Kt + q * PK + hi * 16;
    bf16x8 ka[KS], kb[KS];
#pragma unroll
    for (int ks = 0; ks < KS; ++ks) { ka[ks] = *(const LAS bf16x8*)(kp + ks * 32); kb[ks] = *(const LAS bf16x8*)(kp + 32 * PK + ks * 32); }
    if (HAS_BIAS && bias_mode == 2) {
        asm volatile("" ::: "memory");
#pragma unroll
        for (int r = 0; r < 16; ++r) {
            const int k = crow(r, hi);
            const int i0 = min(max(rel0 + k + 128, 0), 191), i1 = min(max(rel0 + k + 160, 0), 191);
            p0[r] = tab[i0] + st.negm[r]; p1[r] = tab[i1] + st.negm[r];
        }
        p0 = __builtin_amdgcn_mfma_f32_32x32x16_bf16(ka[0], st.qf[0], p0, 0, 0, 0);
        p1 = __builtin_amdgcn_mfma_f32_32x32x16_bf16(kb[0], st.qf[0], p1, 0, 0, 0);
    } else {
        p0 = __builtin_amdgcn_mfma_f32_32x32x16_bf16(ka[0], st.qf[0], st.negm, 0, 0, 0);
        p1 = __builtin_amdgcn_mfma_f32_32x32x16_bf16(kb[0], st.qf[0], st.negm, 0, 0, 0);
    }
#pragma unroll
    for (int ks = 1; ks < KS; ++ks) {
        p0 = __builtin_amdgcn_mfma_f32_32x32x16_bf16(ka[ks], st.qf[ks], p0, 0, 0, 0);
        p1 = __builtin_amdgcn_mfma_f32_32x32x16_bf16(kb[ks], st.qf[ks], p1, 0, 0, 0);
    }
    const int q4 = (lane & 15) >> 2, blk = (lane >> 4) & 1, pp = lane & 3;
    const LAS unsigned char* vp = Vt + (4 * hi + q4) * PV + (16 * blk + 4 * pp) * 2;
    s16x4 vlo[2][4], vhi[2][4];
#pragma unroll
    for (int s4 = 0; s4 < 4; ++s4) { vlo[0][s4] = vtr(vp + (16 * s4) * PV); vhi[0][s4] = vtr(vp + (16 * s4 + 8) * PV); }
    __builtin_amdgcn_sched_barrier(0);
    if (nkeys < 64) {
#pragma unroll
        for (int r = 0; r < 16; ++r) { const int k = crow(r, hi); if (k >= nkeys) p0[r] = -1e30f; if (k + 32 >= nkeys) p1[r] = -1e30f; }
    }
    float mxa = __builtin_fmaxf(__builtin_fmaxf(p0[0], p0[1]), p1[0]), mxb = __builtin_fmaxf(__builtin_fmaxf(p0[2], p0[3]), p1[1]);
    mxa = __builtin_fmaxf(__builtin_fmaxf(mxa, p1[2]), p1[3]);
#pragma unroll
    for (int r = 4; r < 16; r += 4) {
        mxa = __builtin_fmaxf(__builtin_fmaxf(mxa, p0[r]), p0[r + 1]); mxb = __builtin_fmaxf(__builtin_fmaxf(mxb, p0[r + 2]), p0[r + 3]);
        mxa = __builtin_fmaxf(__builtin_fmaxf(mxa, p1[r]), p1[r + 1]); mxb = __builtin_fmaxf(__builtin_fmaxf(mxb, p1[r + 2]), p1[r + 3]);
    }
    const float mx = xmax32(__builtin_fmaxf(mxa, mxb));
    if (first || __any(mx > ATT_THR)) {
        const float dl = first ? mx : __builtin_fmaxf(mx, 0.f);
        st.m += dl;
#pragma unroll
        for (int r = 0; r < 16; ++r) { st.negm[r] = -st.m; p0[r] -= dl; p1[r] -= dl; }
        const float f = __builtin_amdgcn_exp2f(-dl);
        st.l *= f;
        if (hi == 0) wsf[q] = f;
#pragma unroll
        for (int r = 0; r < 16; ++r) { const float fr = wsf[crow(r, hi)];
#pragma unroll
            for (int db = 0; db < NDB; ++db) st.o[db][r] *= fr; }
    }
    float sum0 = 0.f, sum1 = 0.f;
#pragma unroll
    for (int r = 0; r < 16; ++r) { p0[r] = __builtin_amdgcn_exp2f(p0[r]); p1[r] = __builtin_amdgcn_exp2f(p1[r]); sum0 += p0[r]; sum1 += p1[r]; }
    st.l += sum0 + sum1;
    bf16x8 pf[4];
    pf[0] = pack8(p0[0], p0[1], p0[2], p0[3], p0[4], p0[5], p0[6], p0[7]);
    pf[1] = pack8(p0[8], p0[9], p0[10], p0[11], p0[12], p0[13], p0[14], p0[15]);
    pf[2] = pack8(p1[0], p1[1], p1[2], p1[3], p1[4], p1[5], p1[6], p1[7]);
    pf[3] = pack8(p1[8], p1[9], p1[10], p1[11], p1[12], p1[13], p1[14], p1[15]);
    __builtin_amdgcn_sched_barrier(0);
#pragma unroll
    for (int db = 0; db < NDB; ++db) {
        if (db + 1 < NDB) {
#pragma unroll
            for (int s4 = 0; s4 < 4; ++s4) { vlo[(db + 1) & 1][s4] = vtr(vp + (16 * s4) * PV + (db + 1) * 64); vhi[(db + 1) & 1][s4] = vtr(vp + (16 * s4 + 8) * PV + (db + 1) * 64); }
        }
#pragma unroll
        for (int s4 = 0; s4 < 4; ++s4) {
            const s16x4 lo = vlo[db & 1][s4], h4 = vhi[db & 1][s4];
            const bf16x8 vb = {lo[0], lo[1], lo[2], lo[3], h4[0], h4[1], h4[2], h4[3]};
            st.o[db] = __builtin_amdgcn_mfma_f32_32x32x16_bf16(pf[s4], vb, st.o[db], 0, 0, 0);
        }
        __builtin_amdgcn_sched_barrier(0);
    }
}

template <int DQK, int DV>
__device__ __forceinline__ void attn_init(AttnState<DQK, DV>& st) {
    st.m = 0.f; st.l = 0.f;
#pragma unroll
    for (int r = 0; r < 16; ++r) st.negm[r] = 0.f;
#pragma unroll
    for (int db = 0; db < DV / 32; ++db)
#pragma unroll
        for (int r = 0; r < 16; ++r) st.o[db][r] = 0.f;
}

template <bool DIFF>
__device__ __forceinline__ void attn_unit_coop(const Grp& G, int b, int h, int qb, int n, LAS unsigned char* lds, const int tid_in) {
    constexpr int DQK = DIFF ? 64 : 96, DV = DIFF ? 128 : 64, PK = DQK * 2 + 16, PV = DV * 2 + 64, KB = 64 * PK, VB = 64 * PV, TB = KB + VB, NDB = DV / 32;
    int tid_ = tid_in; asm volatile("" : "+v"(tid_));
    const int tid = tid_, lane = tid & 63, wid = __builtin_amdgcn_readfirstlane(tid >> 6), q = lane & 31, hi = lane >> 5;
    const size_t seq0 = (size_t)b * TS;
    const int qrow0 = qb * 256 + wid * 32;
    const int NT = 4 * qb + 4, my_nt = 4 * qb + (wid >> 1) + 1;
    const LAS float* tab = (const LAS float*)(lds + AL_TAB) + h * 192;
    LAS float* wsf = (LAS float*)(lds + AL_WSF) + wid * 64;
    LAS unsigned char* tiles = lds + AL_TILE;
    {
        AttnState<DQK, DV> st; attn_init(st);
        if (DIFF) { const bf16* qp = G.QD + (seq0 + qrow0 + q) * 1024 + h * 128 + n * 64 + hi * 8;
#pragma unroll
            for (int ks = 0; ks < 4; ++ks) st.qf[ks] = *(const bf16x8*)(qp + ks * 16);
        } else { const bf16* qn = G.QN + (seq0 + qrow0 + q) * 1024 + h * 64 + hi * 8; const bf16* qr = G.QR + (seq0 + qrow0 + q) * 512 + h * 32 + hi * 8;
#pragma unroll
            for (int ks = 0; ks < 4; ++ks) st.qf[ks] = *(const bf16x8*)(qn + ks * 16);
#pragma unroll
            for (int ks = 0; ks < 2; ++ks) st.qf[4 + ks] = *(const bf16x8*)(qr + ks * 16);
        }
        const bf16* ksrc = (DIFF ? G.KD + h * 128 + n * 64 : G.KN + h * 64) + (seq0 + (tid >> 3)) * 1024 + (tid & 7) * 8;
        const int kdst = (tid >> 3) * PK + (tid & 7) * 16;
        const bf16* k2src = G.KR + (seq0 + ((tid & 255) >> 2)) * 32 + (tid & 3) * 8;
        const int k2dst = ((tid & 255) >> 2) * PK + 128 + (tid & 3) * 16;
        const bf16* vsrc = DIFF ? G.VD + (seq0 + (tid >> 4)) * 1024 + h * 128 + (tid & 15) * 8 : G.VM + (seq0 + (tid >> 3)) * 1024 + h * 64 + (tid & 7) * 8;
        const int vdst = DIFF ? KB + (tid >> 4) * PV + (tid & 15) * 16 : KB + (tid >> 3) * PV + (tid & 7) * 16;
        u32x4 rkA, rk2A = {0u, 0u, 0u, 0u}, rv0A, rv1A = {0u, 0u, 0u, 0u}, rkB = {0u, 0u, 0u, 0u}, rk2B = {0u, 0u, 0u, 0u}, rv0B = {0u, 0u, 0u, 0u}, rv1B = {0u, 0u, 0u, 0u};
#define ATT_LOAD(S, j) do { rk##S = *(const u32x4*)(ksrc + (size_t)(j) * 64 * 1024); if (!DIFF && tid < 256) rk2##S = *(const u32x4*)(k2src + (size_t)(j) * 64 * 32); \
        rv0##S = *(const u32x4*)(vsrc + (size_t)(j) * 64 * 1024); if (DIFF) rv1##S = *(const u32x4*)(vsrc + (size_t)(j) * 64 * 1024 + 32 * 1024); } while (0)
#define ATT_STORE(S, bufp) do { *(LAS u32x4*)((bufp) + kdst) = rk##S; if (!DIFF && tid < 256) *(LAS u32x4*)((bufp) + k2dst) = rk2##S; \
        *(LAS u32x4*)((bufp) + vdst) = rv0##S; if (DIFF) *(LAS u32x4*)((bufp) + vdst + 32 * PV) = rv1##S; } while (0)
#define ATT_COMPUTE(j, bufp) do { if ((j) < my_nt) { const int kb_ = 64 * (j); const int mode_ = DIFF ? ((kb_ + 63 - qrow0 <= -128) ? 1 : 2) : 0; \
        attn_tile<DQK, DV, DIFF>(st, (bufp), (bufp) + KB, mode_, tab, kb_ - (qrow0 + q), 64, (j) == 0, wsf, lane); } } while (0)
        ATT_LOAD(A, 0); ATT_STORE(A, tiles);
        __syncthreads();
        ATT_LOAD(A, 1);
        for (int j = 0; j < NT; j += 2) {
            LAS unsigned char* b0 = tiles + (j & 1) * TB; LAS unsigned char* b1 = tiles + ((j + 1) & 1) * TB;
            if (j + 2 < NT) ATT_LOAD(B, j + 2);
            ATT_COMPUTE(j, b0);
            ATT_STORE(A, b1);
            __syncthreads();
            if (j + 3 < NT) ATT_LOAD(A, j + 3);
            ATT_COMPUTE(j + 1, b1);
            if (j + 2 < NT) ATT_STORE(B, b0);
            __syncthreads();
        }
#undef ATT_LOAD
#undef ATT_STORE
#undef ATT_COMPUTE
        const float lt = xsum32(st.l);
        if (hi == 0) wsf[32 + q] = lt;
        float inv[16];
#pragma unroll
        for (int r = 0; r < 16; ++r) inv[r] = 1.0f / wsf[32 + crow(r, hi)];
        bf16* obase = (DIFF ? (n == 0 ? G.DO : G.XN) + h * 128 : G.MO + h * 64) + (seq0 + qrow0) * 1024 + q;
#pragma unroll
        for (int db = 0; db < NDB; ++db)
#pragma unroll
            for (int r = 0; r < 16; ++r) obase[(size_t)crow(r, hi) * 1024 + db * 32] = (bf16)f2bf(st.o[db][r] * inv[r]);
    }
}

__device__ __forceinline__ void phase_diffmix(const Grp& G, float lam, const float* subln, int gw, int ngw, int lane) {
    const int c = (lane & 7) * 16;
    float g[16];
#pragma unroll
    for (int i = 0; i < 16; ++i) g[i] = subln[c + i] * 0.8f;
    for (int r = gw; r < G.nvalid; r += ngw) {
        bf16* p1 = G.DO + (size_t)r * 1024 + lane * 16; const bf16* p2 = G.XN + (size_t)r * 1024 + lane * 16;
        const u32x4 a0 = ((const u32x4*)p1)[0], a1 = ((const u32x4*)p1)[1], b0 = ((const u32x4*)p2)[0], b1 = ((const u32x4*)p2)[1];
        float v[16];
#pragma unroll
        for (int i = 0; i < 4; ++i) { v[2 * i] = bflo(a0[i]) - lam * bflo(b0[i]); v[2 * i + 1] = bfhi(a0[i]) - lam * bfhi(b0[i]);
                                      v[8 + 2 * i] = bflo(a1[i]) - lam * bflo(b1[i]); v[8 + 2 * i + 1] = bfhi(a1[i]) - lam * bfhi(b1[i]); }
        float s = 0.f;
#pragma unroll
        for (int i = 0; i < 16; ++i) s += v[i] * v[i];
        s += swz_xor<1>(s); s += swz_xor<2>(s); s += swz_xor<4>(s);
        const float rs = 1.0f / sqrtf(s * (1.f / 128.f) + EPSN);
        u32x4 o0, o1;
#pragma unroll
        for (int i = 0; i < 4; ++i) { o0[i] = pk2(v[2 * i] * rs * g[2 * i], v[2 * i + 1] * rs * g[2 * i + 1]); o1[i] = pk2(v[8 + 2 * i] * rs * g[8 + 2 * i], v[8 + 2 * i + 1] * rs * g[8 + 2 * i + 1]); }
        ((u32x4*)p1)[0] = o0; ((u32x4*)p1)[1] = o1;
    }
}

template <bool DIFF>
__device__ __forceinline__ void attn_unit_wave(const Grp& G, const unsigned char* cb, int b, int h, int n, int j0, int j1, int wu, float* PO, float* PM, float* PL,
                                               LAS unsigned char* wt, LAS float* wsf, const LAS float* tab0, int lane_in) {
    int lane = lane_in; asm volatile("" : "+v"(lane)); lane &= 63;
    constexpr int DQK = DIFF ? 64 : 96, DV = DIFF ? 128 : 64, PK = DQK * 2 + 16, PV = DV * 2 + 64, KB = 64 * PK, NDB = DV / 32;
    const int q = lane & 31, hi = lane >> 5;
    const LAS float* tab = tab0 + h * 192;
    AttnState<DQK, DV> st; attn_init(st);
    const size_t qrow = (size_t)b * ST + q;
    if (DIFF) { const bf16* qp = G.QD + qrow * 1024 + h * 128 + n * 64 + hi * 8;
#pragma unroll
        for (int ks = 0; ks < 4; ++ks) st.qf[ks] = *(const bf16x8*)(qp + ks * 16);
    } else { const bf16* qn = G.QN + qrow * 1024 + h * 64 + hi * 8; const bf16* qr = G.QR + qrow * 512 + h * 32 + hi * 8;
#pragma unroll
        for (int ks = 0; ks < 4; ++ks) st.qf[ks] = *(const bf16x8*)(qn + ks * 16);
#pragma unroll
        for (int ks = 0; ks < 2; ++ks) st.qf[4 + ks] = *(const bf16x8*)(qr + ks * 16);
    }
    for (int j = j0; j < j1; ++j) {
        const bf16 *kA, *kB2, *vA; int nkeys;
        if (j < 64) { const size_t r0 = (size_t)b * PAST + 64 * j; nkeys = 64;
            kA = DIFF ? (const bf16*)(cb + C_KDC) + r0 * 1024 + h * 128 + n * 64 : (const bf16*)(cb + C_KNC) + r0 * 1024 + h * 64;
            kB2 = (const bf16*)(cb + C_KRC) + r0 * 32;
            vA = DIFF ? (const bf16*)(cb + C_VDC) + r0 * 1024 + h * 128 : (const bf16*)(cb + C_VMC) + r0 * 1024 + h * 64;
        } else { const size_t r0 = (size_t)b * ST; nkeys = ST;
            kA = DIFF ? G.KD + r0 * 1024 + h * 128 + n * 64 : G.KN + r0 * 1024 + h * 64;
            kB2 = G.KR + r0 * 32;
            vA = DIFF ? G.VD + r0 * 1024 + h * 128 : G.VM + r0 * 1024 + h * 64;
        }
        { u32x4 t[8];
#pragma unroll
            for (int i = 0; i < 8; ++i) { const int idx = lane + 64 * i; t[i] = *(const u32x4*)(kA + (size_t)(idx >> 3) * 1024 + (idx & 7) * 8); }
#pragma unroll
            for (int i = 0; i < 8; ++i) { const int idx = lane + 64 * i; *(LAS u32x4*)(wt + (idx >> 3) * PK + (idx & 7) * 16) = t[i]; } }
        if (!DIFF) { u32x4 t[4];
#pragma unroll
            for (int i = 0; i < 4; ++i) { const int idx = lane + 64 * i; t[i] = *(const u32x4*)(kB2 + (size_t)(idx >> 2) * 32 + (idx & 3) * 8); }
#pragma unroll
            for (int i = 0; i < 4; ++i) { const int idx = lane + 64 * i; *(LAS u32x4*)(wt + (idx >> 2) * PK + 128 + (idx & 3) * 16) = t[i]; } }
        if (DIFF) {
#pragma unroll
            for (int hf = 0; hf < 2; ++hf) { u32x4 t[8];
#pragma unroll
                for (int i = 0; i < 8; ++i) { const int idx = lane + 64 * i + 512 * hf; t[i] = *(const u32x4*)(vA + (size_t)(idx >> 4) * 1024 + (idx & 15) * 8); }
#pragma unroll
                for (int i = 0; i < 8; ++i) { const int idx = lane + 64 * i + 512 * hf; *(LAS u32x4*)(wt + KB + (idx >> 4) * PV + (idx & 15) * 16) = t[i]; } }
        } else { u32x4 t[8];
#pragma unroll
            for (int i = 0; i < 8; ++i) { const int idx = lane + 64 * i; t[i] = *(const u32x4*)(vA + (size_t)(idx >> 3) * 1024 + (idx & 7) * 8); }
#pragma unroll
            for (int i = 0; i < 8; ++i) { const int idx = lane + 64 * i; *(LAS u32x4*)(wt + KB + (idx >> 3) * PV + (idx & 7) * 16) = t[i]; } }
        const int kb = 64 * j;
        const int mode = DIFF ? ((j <= 61) ? 1 : 2) : 0;
        attn_tile<DQK, DV, DIFF>(st, wt, wt + KB, mode, tab, kb - (PAST + q), nkeys, j == j0, wsf, lane);
    }
    const float lt = xsum32(st.l);
    if (hi == 0) { PM[wu * 32 + q] = st.m; PL[wu * 32 + q] = lt; }
#pragma unroll
    for (int db = 0; db < NDB; ++db)
#pragma unroll
        for (int r = 0; r < 16; ++r) PO[((size_t)wu * 32 + crow(r, hi)) * DV + db * 32 + q] = st.o[db][r];
}

__device__ __forceinline__ void phase_combine(const Grp& G, const float* POd, const float* POm, const float* PM, const float* PL, float lam, const float* subln, int gw, int ngw, int lane) {
    for (int it = gw; it < SB * 8 * ST + SB * 16 * ST; it += ngw) {
        if (it < SB * 8 * ST) {
            const int qq = it & 15, h = (it >> 4) & 7, b = it >> 7;
            float val[2] = {0.f, 0.f};
#pragma unroll
            for (int n = 0; n < 2; ++n) {
                const int wu0 = ((b * 8 + h) * 2 + n) * NSPLIT;
                float M = -1e30f;
#pragma unroll
                for (int s = 0; s < NSPLIT; ++s) M = fmaxf(M, PM[(wu0 + s) * 32 + qq]);
                float L = 0.f, a0 = 0.f, a1 = 0.f;
#pragma unroll
                for (int s = 0; s < NSPLIT; ++s) { const float w = __builtin_amdgcn_exp2f(PM[(wu0 + s) * 32 + qq] - M); L += PL[(wu0 + s) * 32 + qq] * w;
                    const float* po = POd + ((size_t)(wu0 + s) * 32 + qq) * 128; a0 += po[lane] * w; a1 += po[lane + 64] * w; }
                const float sc = (n == 0 ? 1.f : -lam) / L;
                val[0] += a0 * sc; val[1] += a1 * sc;
            }
            const float ss = wave_sum(val[0] * val[0] + val[1] * val[1]);
            const float rs = 0.8f / sqrtf(ss * (1.f / 128.f) + EPSN);
            bf16* o = G.DO + (size_t)(b * ST + qq) * 1024 + h * 128;
            o[lane] = (bf16)f2bf(val[0] * rs * subln[lane]); o[lane + 64] = (bf16)f2bf(val[1] * rs * subln[lane + 64]);
        } else {
            const int i2 = it - SB * 8 * ST; const int qq = i2 & 15, h = (i2 >> 4) & 15, b = i2 >> 8;
            const int wu0 = 512 + (b * 16 + h) * NSPLIT;
            float M = -1e30f;
#pragma unroll
            for (int s = 0; s < NSPLIT; ++s) M = fmaxf(M, PM[(wu0 + s) * 32 + qq]);
            float L = 0.f, a0 = 0.f;
#pragma unroll
            for (int s = 0; s < NSPLIT; ++s) { const float w = __builtin_amdgcn_exp2f(PM[(wu0 + s) * 32 + qq] - M); L += PL[(wu0 + s) * 32 + qq] * w;
                a0 += POm[((size_t)(wu0 - 512 + s) * 32 + qq) * 64 + lane] * w; }
            G.MO[(size_t)(b * ST + qq) * 1024 + h * 64 + lane] = (bf16)f2bf(a0 / L);
        }
    }
}

__device__ __forceinline__ void diffmix_block(const Grp& G, int b, int h, int qb, float lam, const float* subln, int tid) {
    const int lane = tid & 63, wid = tid >> 6;
    const float g0 = subln[2 * lane] * 0.8f, g1 = subln[2 * lane + 1] * 0.8f;
    const size_t row0 = (size_t)b * TS + qb * 256 + wid * 32;
#pragma unroll 1
    for (int rb = 0; rb < 32; rb += 16) {
        unsigned a[16], c[16];
#pragma unroll
        for (int r = 0; r < 16; ++r) { a[r] = *((const unsigned*)(G.DO + (row0 + rb + r) * 1024 + h * 128) + lane); c[r] = *((const unsigned*)(G.XN + (row0 + rb + r) * 1024 + h * 128) + lane); }
#pragma unroll
        for (int r = 0; r < 16; ++r) {
            const float v0 = bflo(a[r]) - lam * bflo(c[r]), v1 = bfhi(a[r]) - lam * bfhi(c[r]);
            const float ss = wave_sum(v0 * v0 + v1 * v1);
            const float rs = 1.0f / sqrtf(ss * (1.f / 128.f) + EPSN);
            *((unsigned*)(G.DO + (row0 + rb + r) * 1024 + h * 128) + lane) = pk2(v0 * rs * g0, v1 * rs * g1);
        }
    }
}

__device__ __forceinline__ void phase_attention(const Args& a, const Grp& G, LAS unsigned char* lds, const int tid_in) {
    int tid_ = tid_in; asm volatile("" : "+v"(tid_));
    const int tid = tid_, lane = tid & 63, wid = __builtin_amdgcn_readfirstlane(tid >> 6);
    const float* tabg = (const float*)(a.ws + WS_TAB);
    for (int i = tid; i < 8 * 192; i += 512) ((LAS float*)(lds + AL_TAB))[i] = tabg[i];
    const float lam = tabg[1536];
    const float* subln = a.in[13];
    __syncthreads();
    if (G.sample) {
        if (wid < 4) {
            constexpr int TBD = 64 * (64 * 2 + 16) + 64 * (128 * 2 + 64);
            LAS unsigned char* wt = lds + AL_TILE + wid * TBD;
            LAS float* wsf = (LAS float*)(lds + AL_WSF) + wid * 64;
            const LAS float* tab0 = (const LAS float*)(lds + AL_TAB);
            const unsigned char* cb = a.ws + WS_PROMPT;
            for (int wu = (int)blockIdx.x * 4 + wid; wu < 1024; wu += (int)gridDim.x * 4) {
                const int s = wu & 3; const int j0 = s == 0 ? 0 : 17 + 16 * (s - 1), j1 = 17 + 16 * s;
                if (wu < 512) {
#if ATTMASK & 1
 const int n = (wu >> 2) & 1, h = (wu >> 3) & 7, b = wu >> 6;
                    attn_unit_wave<true>(G, cb, b, h, n, j0, j1, wu, (float*)(a.ws + WS_PO_D), (float*)(a.ws + WS_PM), (float*)(a.ws + WS_PL), wt, wsf, tab0, tid);
#endif
                } else {
#if ATTMASK & 2
 const int i2 = wu - 512; const int h = (i2 >> 2) & 15, b = i2 >> 6;
                    attn_unit_wave<false>(G, cb, b, h, 0, j0, j1, wu, (float*)(a.ws + WS_PO_M) - (size_t)512 * 32 * 64, (float*)(a.ws + WS_PM), (float*)(a.ws + WS_PL), wt, wsf, tab0, tid);
#endif
                }
            }
        }
    } else {
        const int Gn = (int)gridDim.x, bx = (int)blockIdx.x;
        const int vcu = (Gn % 8 == 0) ? (bx % 8) * (Gn / 8) + bx / 8 : bx;
        for (int v = vcu; v < 256; v += Gn) {
            const int p = v & 3;
#if ATTMASK & 4
            for (int r = 0; r < GBATCH * 8 / 64; ++r) { const int bh = r * 64 + (v >> 2), b = bh >> 3, h = bh & 7;
                for (int n = 0; n < 2; ++n)
                    for (int i = 0; i < 2; ++i) attn_unit_coop<true>(G, b, h, i ? p : 7 - p, n, lds, tid_in);
                asm volatile("s_waitcnt vmcnt(0)" ::: "memory"); __syncthreads();
                int t2 = tid_in; asm volatile("" : "+v"(t2));
                diffmix_block(G, b, h, 7 - p, lam, subln, t2); diffmix_block(G, b, h, p, lam, subln, t2); }
#endif
#if ATTMASK & 8
            for (int r = 0; r < GBATCH * 16 / 64; ++r) { const int bh = r * 64 + (v >> 2), b = bh >> 4, h = bh & 15;
                for (int i = 0; i < 2; ++i) attn_unit_coop<false>(G, b, h, i ? p : 7 - p, 0, lds, tid_in); }
#endif
        }
    }
}

constexpr int LDS_BYTES = 147456;
#ifndef PHMASK
#define PHMASK 0xffff
#endif

#define XB_TMO      128
#define XB_XCNT(j)  (256  + 64 * (j))
#define XB_XSUB(j)  (1280 + 64 * (j))
#define XB_XGEN(j)  (2304 + 64 * (j))
#define XB_TOP      3328
#define XB_TOPGEN   3392
#define XCD_BAR_WORDS 3456
#define XB_SPIN_CAP (1u << 18)

__device__ __forceinline__ unsigned xb_ld(unsigned* p)              { return __hip_atomic_load(p, __ATOMIC_RELAXED, __HIP_MEMORY_SCOPE_AGENT); }
__device__ __forceinline__ unsigned xb_add(unsigned* p, unsigned v) { return __hip_atomic_fetch_add(p, v, __ATOMIC_RELAXED, __HIP_MEMORY_SCOPE_AGENT); }
__device__ __forceinline__ unsigned xb_xcc_id() { return (unsigned)__builtin_amdgcn_s_getreg((3 << 11) | 20) & 0xFu; }
#define XB_SPIN(cond, bar) do { unsigned _sp = 0; while (cond) { __builtin_amdgcn_s_sleep(1); \
    if ((++_sp & 255u) == 0u) { if (xb_ld(&(bar)[XB_TMO])) break; if (_sp > XB_SPIN_CAP) { atomicAdd(&(bar)[XB_TMO], 1u); break; } } } } while (0)

struct XcdBarrier {
    unsigned* bar; unsigned x;
    volatile LAS unsigned* st;
};

__device__ __forceinline__ XcdBarrier xcd_barrier_post(unsigned* bar, volatile LAS unsigned* st) {
    XcdBarrier b; b.bar = bar; b.x = xb_xcc_id(); b.st = st;
    if (threadIdx.x == 0) (void)xb_add(&bar[XB_XCNT(b.x)], 1u);
    return b;
}
__device__ __forceinline__ void xcd_barrier_complete(unsigned* bar, unsigned x, unsigned& nloc, unsigned& nx) {
    const unsigned G = gridDim.x * gridDim.y * gridDim.z;
    unsigned sum, cnt, mine, sp = 0u;
    for (;;) {
        sum = 0u; cnt = 0u; mine = 0u;
#pragma unroll
        for (unsigned j = 0; j < 16; ++j) { const unsigned c = xb_ld(&bar[XB_XCNT(j)]); sum += c; cnt += (c > 0u) ? 1u : 0u; mine = (j == x) ? c : mine; }
        if (sum == G) break;
        __builtin_amdgcn_s_sleep(1);
        if ((++sp & 255u) == 0u) { if (xb_ld(&bar[XB_TMO])) break; if (sp > XB_SPIN_CAP) { atomicAdd(&bar[XB_TMO], 1u); break; } }
    }
    nloc = mine > 0u ? mine : 1u; nx = cnt > 0u ? cnt : 1u;
}

__device__ __forceinline__ void xcd_barrier(const XcdBarrier& b, const bool is_t0) {
    asm volatile("s_waitcnt vmcnt(0)" ::: "memory");
    __syncthreads();
    if (is_t0) {
        unsigned* bar = b.bar;
        __builtin_amdgcn_s_waitcnt(0);
        unsigned nloc = b.st[0], nx = b.st[1];
        if (nloc == 0u) { xcd_barrier_complete(bar, b.x, nloc, nx); b.st[0] = nloc; b.st[1] = nx; }
        const unsigned old = xb_add(&bar[XB_XSUB(b.x)], 1u);
        const unsigned gen = old / nloc;
        if (old + 1u == (gen + 1u) * nloc) {
            __builtin_amdgcn_fence(__ATOMIC_RELEASE, "agent");
            asm volatile("s_waitcnt vmcnt(0)" ::: "memory");
            const unsigned og = xb_add(&bar[XB_TOP], 1u);
            const unsigned tg = og / nx;
            if (og + 1u == (tg + 1u) * nx) xb_add(&bar[XB_TOPGEN], 1u);
            else XB_SPIN(xb_ld(&bar[XB_TOPGEN]) == tg, bar);
            __builtin_amdgcn_fence(__ATOMIC_ACQUIRE, "agent");
            xb_add(&bar[XB_XGEN(b.x)], 1u);
            asm volatile("s_waitcnt vmcnt(0)" ::: "memory");
        } else {
            XB_SPIN(xb_ld(&bar[XB_XGEN(b.x)]) == gen, bar);
            __builtin_amdgcn_fence(__ATOMIC_ACQUIRE, "agent");
            asm volatile("s_waitcnt vmcnt(0)" ::: "memory");
        }
    }
    __syncthreads();
}

constexpr size_t WS_BAR = 786432;
constexpr int LDS_BARST = 131072 + 512;
constexpr int LDS_PTAB = 131072;
__device__ __forceinline__ const void* lds_ptr(LAS const unsigned long long* pt, int i) {
    const unsigned long long v = pt[i];
    const unsigned lo = __builtin_amdgcn_readfirstlane((unsigned)v), hi = __builtin_amdgcn_readfirstlane((unsigned)(v >> 32));
    return (const void*)(const __attribute__((address_space(1))) void*)(((unsigned long long)hi << 32) | lo);
}
__device__ __forceinline__ Args load_args(LAS unsigned char* lds) {
    int z = 0; asm volatile("" : "+s"(z));
    LAS const unsigned long long* pt = (LAS const unsigned long long*)(lds + LDS_PTAB + z);
    Args a;
#pragma unroll
    for (int i = 0; i < 26; ++i) a.in[i] = (const float*)lds_ptr(pt, i);
    a.out = (float*)lds_ptr(pt, 26); a.ws = (unsigned char*)lds_ptr(pt, 27); a.pad0 = 0; a.pad1 = 0;
    return a;
}
#define GBAR() do { int z_ = 0; asm volatile("" : "+s"(z_)); XcdBarrier b_; b_.bar = (unsigned*)((unsigned char*)lds_ptr((LAS const unsigned long long*)(lds + LDS_PTAB + z_), 27) + WS_BAR); \
    b_.x = xb_xcc_id(); b_.st = (volatile LAS unsigned*)(lds + LDS_BARST + z_); xcd_barrier(b_, s_wave == 0 && __builtin_amdgcn_mbcnt_hi(~0u, __builtin_amdgcn_mbcnt_lo(~0u, (unsigned)z_)) == 0u); } while (0)
#define PH_BEGIN int w_ = s_wave, g_ = g; asm volatile("" : "+s"(w_), "+s"(g_)); int zz_ = 0; asm volatile("" : "+s"(zz_)); int lane_ = (int)__builtin_amdgcn_mbcnt_hi(~0u, __builtin_amdgcn_mbcnt_lo(~0u, (unsigned)zz_)); asm volatile("" : "+v"(lane_)); const int lane = lane_, wave = w_, tid_ = w_ * 64 + lane; (void)tid_; \
    const int gw = (int)blockIdx.x * 8 + wave, ngw = (int)gridDim.x * 8; const Args a = load_args(lds); unsigned char* ws = a.ws; const float* rope = (const float*)(ws + WS_ROPE); (void)rope; const Grp G = make_grp(a, g_); const int M = G.ntiles * 256; (void)lane; (void)gw; (void)ngw; (void)M;
__global__ void __launch_bounds__(512, 2) fwd_megakernel(Args ka) {
    extern __shared__ __attribute__((aligned(16))) unsigned char lds_raw[];
    LAS unsigned char* lds = (LAS unsigned char*)lds_raw;
    cg::grid_group grid = cg::this_grid();
    if (threadIdx.x == 0) {
        LAS unsigned long long* pt = (LAS unsigned long long*)(lds + LDS_PTAB);
#pragma unroll
        for (int i = 0; i < 26; ++i) pt[i] = (unsigned long long)ka.in[i];
        pt[26] = (unsigned long long)ka.out; pt[27] = (unsigned long long)ka.ws;
    }
    if (threadIdx.x == 0) { ((LAS unsigned*)(lds + LDS_BARST))[0] = 0u; ((LAS unsigned*)(lds + LDS_BARST))[1] = 0u; }
    __syncthreads();
    const int s_wave = __builtin_amdgcn_readfirstlane((int)threadIdx.x >> 6);
    (void)xcd_barrier_post((unsigned*)(ka.ws + WS_BAR), (volatile LAS unsigned*)(lds + LDS_BARST));
#if PHMASK & 1
    { const int tid = threadIdx.x, lane = tid & 63, wave = __builtin_amdgcn_readfirstlane(tid >> 6); const Args a = load_args(lds);
      phase_prologue(a, lds, (int)blockIdx.x * 8 + wave, (int)gridDim.x * 8, lane, wave); }
#endif
    if (ka.pad0 == 0x5a17) grid.sync();
    { const int g = 0; (void)g; GBAR(); }

#pragma unroll 1
    for (int g = 0; g < NGRP; ++g) {
        { PH_BEGIN rms_rows_bf16(G.x, G.XN, a.in[7], G.nvalid, M, gw, ngw, lane, G.SSQ); }
        GBAR();
#if PHMASK & 2
        { PH_BEGIN EpiIn E{G.QD, G.KD, G.VD, G.GD, G.GM, G.ZS, G.okd, G.ovd, G.nvalid, 0.125f * LOG2E};
          run_gemm(lds, G.XN, (const bf16*)(ws + WS_WIN), M, NIN, 1024, E, tid_); }
#endif
        GBAR();
        { PH_BEGIN phase_small(G, a.in[14], a.in[16], rope, gw, ngw, lane); }
        GBAR();
#if PHMASK & 4
        { PH_BEGIN EpiQ E{G.QN, G.QR, rope, G.sample, 0.10206207261596575f * LOG2E};
          run_gemm(lds, G.CQ, (const bf16*)(ws + WS_WUQ), M, 1536, 256, E, tid_); }
#endif
#if PHMASK & 8
        { PH_BEGIN EpiKV E{G.KN, G.VM};
          run_gemm(lds, G.CKV, (const bf16*)(ws + WS_WUKV), M, 2048, 256, E, tid_); }
        if (g == 0) { PH_BEGIN EpiKV E{(bf16*)(ws + WS_PROMPT + C_KNC), (bf16*)(ws + WS_PROMPT + C_VMC)};
          run_gemm(lds, (const bf16*)(ws + WS_PROMPT + C_CKVC), (const bf16*)(ws + WS_WUKV), CACHE_ROWS, 2048, 256, E, tid_); }
#endif
        GBAR();
#if PHMASK & 16
        { PH_BEGIN phase_attention(a, G, lds, tid_); }
#endif
        GBAR();
        if (g == 0) {
            { PH_BEGIN phase_combine(G, (const float*)(ws + WS_PO_D), (const float*)(ws + WS_PO_M), (const float*)(ws + WS_PM), (const float*)(ws + WS_PL), ((const float*)(ws + WS_TAB))[1536], a.in[13], gw, ngw, lane); }
            GBAR();
        }
#if PHMASK & 32
        { PH_BEGIN EpiM1 E{G.GD, G.XN}; run_gemm(lds, G.DO, (const bf16*)(ws + WS_WOD), M, 1024, 1024, E, tid_); }
        { PH_BEGIN EpiM2 E{G.GM, G.XN}; run_gemm(lds, G.MO, (const bf16*)(ws + WS_WOM), M, 1024, 1024, E, tid_); }
#endif
        GBAR();
#if PHMASK & 64
        { PH_BEGIN EpiOut E{G.x, G.GD, G.SSQ, G.nvalid}; run_gemm(lds, G.XN, (const bf16*)(ws + WS_WOUT), M, 1024, 1024, E, tid_); }
#endif
        GBAR();
#if PHMASK & 128
        { PH_BEGIN EpiUp E{G.U, G.SSQ}; run_gemm(lds, G.GD, (const bf16*)(ws + WS_WUP), M, 4096, 1024, E, tid_);
          if (g == 0) { for (int i = tid_ + (int)blockIdx.x * 512; i < G.nvalid * 1024; i += (int)gridDim.x * 512) G.y[i] = bflo((unsigned)G.GD[i]); } }
#endif
        GBAR();
#if PHMASK & 256
        if (g == 0) {
#pragma unroll 1
            for (int sk = 0; sk < 8; ++sk) { PH_BEGIN int s_ = sk; asm volatile("" : "+s"(s_)); EpiDownAtomic E{G.y, G.nvalid};
                run_gemm(lds, G.U + s_ * 512, (const bf16*)(ws + WS_WDN) + s_ * 512, M, 1024, 512, E, tid_, 4096, 4 * s_); }
        } else
        { PH_BEGIN EpiDown E{G.GD, G.y, G.nvalid}; run_gemm(lds, G.U, (const bf16*)(ws + WS_WDN), M, 1024, 4096, E, tid_); }
#endif
        GBAR();
        { PH_BEGIN rms_rows_f32_inplace(G.y, a.in[25], G.nvalid, gw, ngw, lane); }
    }
}

extern "C" void kernel_launch(void* const* d_in, const int* in_sizes, int n_in, void* d_out, int out_size, void* d_ws, size_t ws_size, hipStream_t stream) {
    static int grid = 0;
    if (grid == 0) {
        if (n_in != 26 || ws_size < WS_NEED) { fprintf(stderr, "kernel_launch: need 26 inputs and %zu bytes of workspace; got %d, %zu\n", (size_t)WS_NEED, n_in, ws_size); grid = -1; return; }
        int dev = 0, cus = 0, per_cu = 0;
        if (hipGetDevice(&dev) != hipSuccess || hipDeviceGetAttribute(&cus, hipDeviceAttributeMultiprocessorCount, dev) != hipSuccess) { grid = -1; return; }
        if (hipFuncSetAttribute((const void*)fwd_megakernel, hipFuncAttributeMaxDynamicSharedMemorySize, LDS_BYTES) != hipSuccess) { fprintf(stderr, "kernel_launch: hipFuncSetAttribute failed\n"); grid = -1; return; }
        if (hipOccupancyMaxActiveBlocksPerMultiprocessor(&per_cu, (const void*)fwd_megakernel, 512, LDS_BYTES) != hipSuccess || per_cu < 1) { fprintf(stderr, "kernel_launch: occupancy query says %d\n", per_cu); per_cu = 1; }
        (void)hipGetLastError();
        grid = cus;
    }
    if (grid < 0) return;
    if (hipMemsetAsync((char*)d_ws + WS_BAR, 0, 16384, stream) != hipSuccess) { fprintf(stderr, "kernel_launch: memset failed\n"); return; }
    Args a{};
    for (int i = 0; i < 26; ++i) a.in[i] = (const float*)d_in[i];
    a.out = (float*)d_out; a.ws = (unsigned char*)d_ws;
    void* args[] = {&a};
    hipError_t e = hipLaunchCooperativeKernel((const void*)fwd_megakernel, dim3(grid), dim3(512), args, LDS_BYTES, stream);
    if (e != hipSuccess) fprintf(stderr, "kernel_launch: cooperative launch failed: %s (grid %d)\n", hipGetErrorString(e), grid);
}
```

```cpp
#include <hip/hip_runtime.h>
#include <hip/hip_cooperative_groups.h>
#include <cstdio>
#include <cstdint>
namespace cg = cooperative_groups;
namespace pg8 {
#define PG8_LAS __attribute__((address_space(3)))
typedef unsigned short bf16_t;
typedef short bf16x8 __attribute__((ext_vector_type(8)));
typedef float f32x4 __attribute__((ext_vector_type(4)));
typedef unsigned u32x4 __attribute__((ext_vector_type(4)));
constexpr int BM = 256, BK = 64, HALF = 128, HTB = HALF * BK * 2  , STAGE_BYTES = 8 * HTB, NXCD = 8, WGM = 8;

__host__ __device__ __forceinline__ int lds_byte(int r, int c) { const int st = (r >> 4) * 2 + (c >> 5), rr = r & 15, cc = c & 31, ob = rr * 64 + cc * 2; return st * 1024 + (ob ^ (((ob >> 9) & 1) << 5)); }
__host__ __device__ __forceinline__ void stage_rc(int b, int& R, int& C) { const int st = b / 1024, sb = b % 1024, swz = sb ^ (((sb >> 9) & 1) << 5); R = (st >> 1) * 16 + swz / 64; C = (st & 1) * 32 + (swz % 64) / 2; }
__host__ __device__ __forceinline__ int perm32(int rho) { const int n = rho >> 4, i = rho & 15; return 8 * (i >> 2) + 4 * n + (i & 3); }

struct Unit { int pm, pn; };
struct Gemm { const bf16_t* A; const bf16_t* Bt; int M, N, K, ld; };

struct StaticOrder {
    int nM, nN, nwg, G, c;
    __host__ __device__ void init(int M, int N, int G_, int c_) { nM = M / BM; nN = N / BM; nwg = nM * nN; G = G_; c = c_; }
    __host__ __device__ bool next(int i, Unit& u) const {
        const long L = (long)i * G + c; if (L >= nwg) return false;
        int wgid = (int)L; { const int q = nwg / NXCD, r = nwg % NXCD, xcd = wgid % NXCD, off = wgid / NXCD; wgid = (xcd < r ? xcd * (q + 1) : r * (q + 1) + (xcd - r) * q) + off; }
        const int nig = WGM * nN, gid = wgid / nig, fm = gid * WGM, gsz = (nM - fm) < WGM ? (nM - fm) : WGM;
        u.pm = fm + ((wgid % nig) % gsz); u.pn = (wgid % nig) / gsz; return true;
    }
    __device__ __forceinline__ void a_ready(const Unit&) const {}
    __device__ __forceinline__ void done(const Unit&) const {}
};

__device__ __forceinline__ unsigned cvt_pk_bf16(float lo, float hi) { unsigned r; asm volatile("v_cvt_pk_bf16_f32 %0, %1, %2" : "=v"(r) : "v"(lo), "v"(hi)); return r; }
typedef float f32x2 __attribute__((ext_vector_type(2)));
template <class Epi, class Sched, bool ALIGN_EPI = false, bool SP2 = false>
__device__ __forceinline__ void gemm_phase(PG8_LAS unsigned char* lds, const Gemm g, const Sched& S, const Epi& E, const int tid_in) {
    int tid_ = tid_in; asm volatile("" : "+v"(tid_));
    const int tid = tid_, wid = __builtin_amdgcn_readfirstlane(tid >> 6), lane = tid & 63, wr = wid >> 2, wc = wid & 3, fr = lane & 15, fq = lane >> 4;
    const int K = g.K, nt = K / BK, LD = g.ld;
    unsigned voffA[2], voffB[2];
#pragma unroll
    for (int i = 0; i < 2; ++i) { int R, C; stage_rc(tid * 16 + i * 8192, R, C); const int Rb = Epi::PERM ? ((R & ~31) + perm32(R & 31)) : R;
        voffA[i] = (unsigned)(R * LD + C) * 2u; voffB[i] = (unsigned)(Rb * LD + C) * 2u; }
    const size_t kstep = (size_t)(BK * 2);
    const size_t hstep = (size_t)HALF * LD * 2;
    const size_t tstep = 2 * hstep;
    const unsigned ldsw = (unsigned)wid * 1024u;
    const int aoff = lds_byte(wr * 64 + fr, fq * 8), boff = lds_byte(wc * 32 + fr, fq * 8);
#define PG8_SA(b, h) (((b) * 2 + (h)) * HTB)
#define PG8_SB(b, h) ((4 + (b) * 2 + (h)) * HTB)
#define PG8_STAGE(bufoff, gbase, voff) do { _Pragma("unroll") for (int _i = 0; _i < 2; ++_i) \
        __builtin_amdgcn_global_load_lds((const unsigned*)((const char*)(gbase) + (voff)[_i]), (PG8_LAS unsigned*)(lds + (bufoff) + ldsw + _i * 8192), 16, 0, 0); } while (0)
#define PG8_LDA(dst, b, h) do { _Pragma("unroll") for (int m = 0; m < 4; ++m) _Pragma("unroll") for (int k = 0; k < 2; ++k) dst[m][k] = *(const PG8_LAS bf16x8*)(lds + PG8_SA(b, h) + aoff + m * 2048 + k * 1024); } while (0)
#define PG8_LDB(dst, b, h) do { _Pragma("unroll") for (int n = 0; n < 2; ++n) _Pragma("unroll") for (int k = 0; k < 2; ++k) dst[n][k] = *(const PG8_LAS bf16x8*)(lds + PG8_SB(b, h) + boff + n * 2048 + k * 1024); } while (0)
#define PG8_MMA(ai, bj, At, Bt) do { __builtin_amdgcn_s_setprio(1); _Pragma("unroll") for (int m = 0; m < 4; ++m) _Pragma("unroll") for (int n = 0; n < 2; ++n) _Pragma("unroll") for (int k = 0; k < 2; ++k) \
        acc[ai][bj][m][n] = __builtin_amdgcn_mfma_f32_16x16x32_bf16(Bt[n][k], At[m][k], acc[ai][bj][m][n], 0, 0, 0); __builtin_amdgcn_s_setprio(0); } while (0)
#define PG8_WAIT_V(n) asm volatile("s_waitcnt vmcnt(" #n ")" ::: "memory")
#define PG8_WAIT_L(n) asm volatile("s_waitcnt lgkmcnt(" #n ")" ::: "memory")
#define PG8_BAR __builtin_amdgcn_s_barrier()
#define PG8_SCHED __builtin_amdgcn_sched_barrier(0)
    Unit cur, nxt; int ui = 0;
    if (!S.next(0, cur)) return;
    f32x4 acc[2][2][4][2];
#pragma unroll
    for (int a = 0; a < 2; ++a)
#pragma unroll
        for (int b = 0; b < 2; ++b)
#pragma unroll
            for (int m = 0; m < 4; ++m)
#pragma unroll
                for (int n = 0; n < 2; ++n) acc[a][b][m][n] = (f32x4){0.f, 0.f, 0.f, 0.f};
    bf16x8 At[4][2], B0[2][2], B1[2][2];
    const char* cA = (const char*)g.A + (size_t)cur.pm * tstep; const char* cB = (const char*)g.Bt + (size_t)cur.pn * tstep;
    S.a_ready(cur);
    if constexpr (SP2) {
        PG8_STAGE(PG8_SB(0, 0), cB, voffB); PG8_STAGE(PG8_SB(0, 1), cB + hstep, voffB); PG8_STAGE(PG8_SA(0, 0), cA, voffA); PG8_STAGE(PG8_SA(0, 1), cA + hstep, voffA);
        if (wr == 1) PG8_BAR;
        PG8_WAIT_V(2); PG8_BAR;
        PG8_STAGE(PG8_SB(1, 0), cB + kstep, voffB); PG8_STAGE(PG8_SA(1, 0), cA + kstep, voffA); PG8_STAGE(PG8_SB(1, 1), cB + hstep + kstep, voffB);
        PG8_WAIT_V(6); PG8_BAR;
    } else {
        PG8_STAGE(PG8_SB(0, 0), cB, voffB); PG8_STAGE(PG8_SA(0, 0), cA, voffA); PG8_STAGE(PG8_SB(0, 1), cB + hstep, voffB); PG8_STAGE(PG8_SA(0, 1), cA + hstep, voffA);
        if (wr == 1) PG8_BAR;
        PG8_WAIT_V(4); PG8_BAR;
        PG8_STAGE(PG8_SB(1, 0), cB + kstep, voffB); PG8_STAGE(PG8_SA(1, 0), cA + kstep, voffA); PG8_STAGE(PG8_SB(1, 1), cB + hstep + kstep, voffB);
        PG8_WAIT_V(6); PG8_BAR;
    }
    for (;;) {
        const bool has_next = S.next(ui + 1, nxt);
        const char* nA = has_next ? (const char*)g.A + (size_t)nxt.pm * tstep : cA; const char* nB = has_next ? (const char*)g.Bt + (size_t)nxt.pn * tstep : cB;
        for (int t = 0; t < nt; t += 2) {
            const bool last = (t == nt - 2);
            const char* a1 = cA + (size_t)(t + 1) * kstep;
            const char* a2 = last ? nA : cA + (size_t)(t + 2) * kstep; const char* b2 = last ? nB : cB + (size_t)(t + 2) * kstep;
            const char* a3 = a2 + kstep; const char* b3 = b2 + kstep;
            if (last && has_next) S.a_ready(nxt);
            if constexpr (SP2) {
            PG8_LDB(B0, 0, 0); PG8_LDB(B1, 0, 1); PG8_SCHED; PG8_LDA(At, 0, 0); PG8_STAGE(PG8_SA(1, 1), a1 + hstep, voffA);
            PG8_WAIT_V(8); PG8_WAIT_L(0); PG8_BAR; PG8_MMA(0, 0, At, B0); PG8_MMA(0, 1, At, B1); PG8_BAR; PG8_SCHED;
            PG8_LDA(At, 0, 1); PG8_STAGE(PG8_SB(0, 0), b2, voffB); PG8_STAGE(PG8_SB(0, 1), b2 + hstep, voffB); PG8_STAGE(PG8_SA(0, 0), a2, voffA);
            PG8_WAIT_V(8); PG8_WAIT_L(0); PG8_BAR; PG8_MMA(1, 0, At, B0); PG8_MMA(1, 1, At, B1); PG8_BAR; PG8_SCHED;
            PG8_LDB(B0, 1, 0); PG8_LDB(B1, 1, 1); PG8_SCHED; PG8_LDA(At, 1, 0); PG8_STAGE(PG8_SA(0, 1), a2 + hstep, voffA);
            PG8_WAIT_V(8); PG8_WAIT_L(0); PG8_BAR; PG8_MMA(0, 0, At, B0); PG8_MMA(0, 1, At, B1); PG8_BAR; PG8_SCHED;
            PG8_LDA(At, 1, 1); PG8_STAGE(PG8_SB(1, 0), b3, voffB); PG8_STAGE(PG8_SB(1, 1), b3 + hstep, voffB); PG8_STAGE(PG8_SA(1, 0), a3, voffA);
            PG8_WAIT_V(8); PG8_WAIT_L(0); PG8_BAR; PG8_MMA(1, 0, At, B0); PG8_MMA(1, 1, At, B1); PG8_BAR; PG8_SCHED;
            } else {
            PG8_LDB(B0, 0, 0); PG8_SCHED; PG8_LDA(At, 0, 0); PG8_STAGE(PG8_SA(1, 1), a1 + hstep, voffA);
            PG8_WAIT_L(8); PG8_BAR; PG8_WAIT_L(0); PG8_MMA(0, 0, At, B0); PG8_BAR; PG8_SCHED;
            PG8_LDB(B1, 0, 1); PG8_STAGE(PG8_SB(0, 0), b2, voffB);
            PG8_BAR; PG8_WAIT_L(0); PG8_MMA(0, 1, At, B1); PG8_BAR;
            PG8_LDA(At, 0, 1); PG8_STAGE(PG8_SA(0, 0), a2, voffA);
            PG8_BAR; PG8_WAIT_L(0); PG8_MMA(1, 0, At, B0); PG8_BAR; PG8_SCHED;
            PG8_STAGE(PG8_SB(0, 1), b2 + hstep, voffB);
            PG8_WAIT_V(6); PG8_BAR; PG8_MMA(1, 1, At, B1); PG8_BAR;
            PG8_LDB(B0, 1, 0); PG8_SCHED; PG8_LDA(At, 1, 0); PG8_STAGE(PG8_SA(0, 1), a2 + hstep, voffA);
            PG8_WAIT_L(8); PG8_BAR; PG8_WAIT_L(0); PG8_MMA(0, 0, At, B0); PG8_BAR; PG8_SCHED;
            PG8_LDB(B1, 1, 1); PG8_STAGE(PG8_SB(1, 0), b3, voffB);
            PG8_BAR; PG8_WAIT_L(0); PG8_MMA(0, 1, At, B1); PG8_BAR;
            PG8_LDA(At, 1, 1); PG8_STAGE(PG8_SA(1, 0), a3, voffA);
            PG8_BAR; PG8_WAIT_L(0); PG8_MMA(1, 0, At, B0); PG8_BAR; PG8_SCHED;
            PG8_STAGE(PG8_SB(1, 1), b3 + hstep, voffB);
            PG8_WAIT_V(6); PG8_BAR; PG8_MMA(1, 1, At, B1); PG8_BAR;
            }
        }
        if constexpr (ALIGN_EPI) { if (wr == 0) PG8_BAR; }
        if constexpr (!Epi::AFTER_DRAIN) { E(acc, cur, wr, wc, fr, fq); S.done(cur); }
        if (!has_next) break;
#pragma unroll
        for (int a = 0; a < 2; ++a)
#pragma unroll
            for (int b = 0; b < 2; ++b)
#pragma unroll
                for (int m = 0; m < 4; ++m)
#pragma unroll
                    for (int n = 0; n < 2; ++n) acc[a][b][m][n] = (f32x4){0.f, 0.f, 0.f, 0.f};
        cur = nxt; cA = nA; cB = nB; ++ui;
        if constexpr (ALIGN_EPI) { if (wr == 1) PG8_BAR; }
    }
    PG8_WAIT_V(0);
    if constexpr (!ALIGN_EPI) { if (wr == 0) PG8_BAR; }
    PG8_BAR;
    if constexpr (Epi::AFTER_DRAIN) { E.fused(acc, cur, wr, wc, fr, fq, lds, wid, lane); S.done(cur); }
#undef PG8_SA
#undef PG8_SB
#undef PG8_STAGE
#undef PG8_LDA
#undef PG8_LDB
#undef PG8_MMA
#undef PG8_WAIT_V
#undef PG8_WAIT_L
#undef PG8_BAR
#undef PG8_SCHED
}
}

#define LAS __attribute__((address_space(3)))
typedef unsigned short bf16;
typedef float f32x4 __attribute__((ext_vector_type(4)));
typedef float f32x2 __attribute__((ext_vector_type(2)));
typedef float f32x16 __attribute__((ext_vector_type(16)));
typedef short bf16x8 __attribute__((ext_vector_type(8)));
typedef short s16x4 __attribute__((ext_vector_type(4)));
typedef unsigned u32x4 __attribute__((ext_vector_type(4)));
typedef unsigned u32x2 __attribute__((ext_vector_type(2)));

constexpr int DM = 1024, NB = 32, TS = 2048, SB = 8, ST = 16, PAST = 4096;
constexpr int NPG = 2;
constexpr int RG = NB * TS / NPG;
constexpr int GBATCH = NB / NPG;
constexpr int NGRP = NPG + 1;
constexpr int NIN = 5888;
constexpr float LOG2E = 1.4426950408889634f;
constexpr float EPSN = 1e-6f;
constexpr int NSPLIT = 4;
constexpr int CACHE_ROWS = SB * PAST;

constexpr size_t O_YP = 0, O_YS = 67108864, O_KDP = 67239936, O_VDP = 134348800, O_CKVP = 201457664, O_KRP = 218234880,
                 O_KDS = 220332032, O_VDS = 220463104, O_CKVS = 220594176, O_KRS = 220626944;
constexpr size_t MiB = 1u << 20;
constexpr size_t WS_TAB = 0;
constexpr size_t WS_ROPE = 8192;
constexpr size_t WS_WIN = 1 * MiB;
constexpr size_t WS_WUQ = WS_WIN + (size_t)NIN * 1024 * 2;
constexpr size_t WS_WUKV = WS_WUQ + 1536 * 256 * 2;
constexpr size_t WS_WOD = WS_WUKV + 2048 * 256 * 2;
constexpr size_t WS_WOM = WS_WOD + 2 * MiB;
constexpr size_t WS_WOUT = WS_WOM + 2 * MiB;
constexpr size_t WS_WUP = WS_WOUT + 2 * MiB;
constexpr size_t WS_WDN = WS_WUP + 8 * MiB;
constexpr size_t WS_WEND = WS_WDN + 8 * MiB;
constexpr size_t WS_SAMP = 37 * MiB;
constexpr size_t WS_PART = 44 * MiB;
constexpr size_t WS_PO_D = WS_PART, WS_PO_M = WS_PART + 8 * MiB, WS_PM = WS_PART + 12 * MiB, WS_PL = WS_PM + 131072;
constexpr size_t WS_PROMPT = 58 * MiB;
constexpr size_t GRP_BYTES_PER_ROW = 21632;
constexpr size_t WS_CACHE = WS_PROMPT + (size_t)RG * GRP_BYTES_PER_ROW;
constexpr size_t WS_NEED = WS_CACHE + 274 * MiB;
static_assert(WS_WEND <= WS_SAMP && WS_SAMP + 256 * GRP_BYTES_PER_ROW <= WS_PART && WS_PL + 131072 <= WS_PROMPT, "ws map");
constexpr size_t C_KDC = 0, C_VDC = 64 * MiB, C_KNC = 128 * MiB, C_VMC = 192 * MiB, C_CKVC = 256 * MiB, C_KRC = 272 * MiB;

struct Args { const float* in[26]; float* out; unsigned char* ws; int pad0, pad1; };

struct Grp {
    const float* x; float* y; float* okd; float* ovd; float* ockv; float* okr;
    int nvalid, ntiles, sample;
    bf16 *QD, *KD, *VD, *QN, *U, *XN, *QR, *KN, *VM, *GD, *GM, *DO, *MO, *CQ, *CKV, *KR; float* ZS; float* SSQ;
};
__device__ __forceinline__ Grp make_grp(const Args& a, int g) {
    Grp G; unsigned char* base; size_t RC;
    if (g == 0) {
        G.x = a.in[1]; G.y = a.out + O_YS; G.okd = a.out + O_KDS; G.ovd = a.out + O_VDS; G.ockv = a.out + O_CKVS; G.okr = a.out + O_KRS;
        G.nvalid = SB * ST; G.ntiles = 1; G.sample = 1; base = a.ws + WS_SAMP; RC = 256;
    } else {
        const size_t r0 = (size_t)(g - 1) * RG;
        G.x = a.in[0] + r0 * 1024; G.y = a.out + O_YP + r0 * 1024; G.okd = a.out + O_KDP + r0 * 1024; G.ovd = a.out + O_VDP + r0 * 1024;
        G.ockv = a.out + O_CKVP + r0 * 256; G.okr = a.out + O_KRP + r0 * 32;
        G.nvalid = RG; G.ntiles = RG / 256; G.sample = 0; base = a.ws + WS_PROMPT; RC = RG;
    }
    G.QD = (bf16*)(base); G.KD = (bf16*)(base + RC * 2048); G.VD = (bf16*)(base + RC * 4096); G.QN = (bf16*)(base + RC * 6144); G.U = (bf16*)base; G.MO = G.QN;
    G.XN = (bf16*)(base + RC * 8192); G.KN = (bf16*)(base + RC * 10240); G.VM = (bf16*)(base + RC * 12288); G.ZS = (float*)(base + RC * 10240);
    G.GD = (bf16*)(base + RC * 14336); G.GM = (bf16*)(base + RC * 16384); G.DO = (bf16*)(base + RC * 18432); G.CQ = (bf16*)(base + RC * 18432); G.CKV = (bf16*)(base + RC * 18944);
    G.QR = (bf16*)(base + RC * 20480); G.KR = (bf16*)(base + RC * 21504); G.SSQ = (float*)(base + RC * 21568);
    return G;
}

template <int M> __device__ __forceinline__ float swz_xor(float v) { return __int_as_float(__builtin_amdgcn_ds_swizzle(__float_as_int(v), 0x1F | (M << 10))); }
__device__ __forceinline__ float half_sum32(float v) { v += swz_xor<1>(v); v += swz_xor<2>(v); v += swz_xor<4>(v); v += swz_xor<8>(v); v += swz_xor<16>(v); return v; }
__device__ __forceinline__ float wave_sum(float v) {
    v = half_sum32(v);
    auto rr = __builtin_amdgcn_permlane32_swap(__float_as_uint(v), __float_as_uint(v), false, false);
    return __uint_as_float(rr[0]) + __uint_as_float(rr[1]);
}
typedef __bf16 bf16x2_hw __attribute__((ext_vector_type(2)));
__device__ __forceinline__ unsigned pk2(float lo, float hi) { f32x2 v = {lo, hi}; bf16x2_hw b = __builtin_convertvector(v, bf16x2_hw); return __builtin_bit_cast(unsigned, b); }
__device__ __forceinline__ unsigned f2bf(float f) { return pk2(f, 0.f) & 0xffffu; }
__device__ __forceinline__ float bflo(unsigned w) { return __builtin_bit_cast(float, w << 16); }
__device__ __forceinline__ float bfhi(unsigned w) { return __builtin_bit_cast(float, w & 0xffff0000u); }
__device__ __forceinline__ void st_bf4(bf16* p, f32x4 v) { u32x2 w; w.x = pk2(v[0], v[1]); w.y = pk2(v[2], v[3]); *(u32x2*)p = w; }
__device__ __forceinline__ f32x4 ld_bf4(const bf16* p) { const u32x2 w = *(const u32x2*)p; return (f32x4){bflo(w.x), bfhi(w.x), bflo(w.y), bfhi(w.y)}; }
__device__ __forceinline__ float sigm(float x) { return 1.f / (1.f + __expf(-x)); }

#define EPI_LOOP(BODY) \
    _Pragma("unroll") for (int ai = 0; ai < 2; ++ai) _Pragma("unroll") for (int m = 0; m < 4; ++m) { const int row = u.pm * 256 + ai * 128 + wr * 64 + m * 16 + fr; const size_t rw = (size_t)row; (void)rw; \
    _Pragma("unroll") for (int bj = 0; bj < 2; ++bj) _Pragma("unroll") for (int n = 0; n < 2; ++n) { const int cl = bj * 128 + wc * 32 + n * 16 + 4 * fq; const f32x4 v = acc[ai][bj][m][n]; BODY } asm volatile("" ::: "memory"); }

#define EPI_LOOP_P(...) \
    _Pragma("unroll") for (int ai = 0; ai < 2; ++ai) _Pragma("unroll") for (int m = 0; m < 4; ++m) { const int row = u.pm * 256 + ai * 128 + wr * 64 + m * 16 + fr; const size_t rw = (size_t)row; (void)rw; \
    _Pragma("unroll") for (int bj = 0; bj < 2; ++bj) { const int cl = bj * 128 + wc * 32 + 8 * fq; const f32x4 v0 = acc[ai][bj][m][0], v1 = acc[ai][bj][m][1]; __VA_ARGS__ } asm volatile("" ::: "memory"); }
__device__ __forceinline__ void st_bf8(bf16* p, f32x4 a, f32x4 b) { u32x4 w; w.x = pk2(a[0], a[1]); w.y = pk2(a[2], a[3]); w.z = pk2(b[0], b[1]); w.w = pk2(b[2], b[3]); *(u32x4*)p = w; }
__device__ __forceinline__ void ld_bf8(const bf16* p, f32x4& a, f32x4& b) { const u32x4 w = *(const u32x4*)p; a = (f32x4){bflo(w.x), bfhi(w.x), bflo(w.y), bfhi(w.y)}; b = (f32x4){bflo(w.z), bfhi(w.z), bflo(w.w), bfhi(w.w)}; }
__device__ __forceinline__ f32x4 sigm4(f32x4 v) { return (f32x4){sigm(v[0]), sigm(v[1]), sigm(v[2]), sigm(v[3])}; }
typedef const f32x4 (&AccRef)[2][2][4][2];

struct EpiIn {
    static constexpr bool PERM = true, AFTER_DRAIN = false;
    bf16 *QD, *KD, *VD, *GD, *GM; float *ZS, *okd, *ovd; int nvalid; float qs;
    __device__ __forceinline__ void operator()(AccRef acc, const pg8::Unit& u, int wr, int wc, int fr, int fq) const {
        const int t = u.pn;
        if (t < 4) { const int c0 = t * 256; EPI_LOOP_P( st_bf8(QD + rw * 1024 + c0 + cl, v0 * qs, v1 * qs); ) }
        else if (t < 8) { const int c0 = (t - 4) * 256; EPI_LOOP_P( st_bf8(KD + rw * 1024 + c0 + cl, v0, v1); if (row < nvalid) { float* o = okd + rw * 1024 + c0 + cl; *(f32x4*)o = v0; *(f32x4*)(o + 4) = v1; } ) }
        else if (t < 12) { const int c0 = (t - 8) * 256; EPI_LOOP_P( st_bf8(VD + rw * 1024 + c0 + cl, v0, v1); if (row < nvalid) { float* o = ovd + rw * 1024 + c0 + cl; *(f32x4*)o = v0; *(f32x4*)(o + 4) = v1; } ) }
        else if (t < 15) { const int c0 = (t - 12) * 256; EPI_LOOP_P( float* o = ZS + rw * 768 + c0 + cl; *(f32x4*)o = v0; *(f32x4*)(o + 4) = v1; ) }
        else if (t < 19) { const int c0 = (t - 15) * 256; EPI_LOOP_P( st_bf8(GD + rw * 1024 + c0 + cl, sigm4(v0), sigm4(v1)); ) }
        else { const int c0 = (t - 19) * 256; EPI_LOOP_P( st_bf8(GM + rw * 1024 + c0 + cl, sigm4(v0), sigm4(v1)); ) }
    }
};
struct EpiQ {
    static constexpr bool PERM = false, AFTER_DRAIN = false;
    bf16 *QN, *QR; const float* rope; int sample; float qs;
    __device__ __forceinline__ void operator()(AccRef acc, const pg8::Unit& u, int wr, int wc, int fr, int fq) const {
        const int t = u.pn;
        if (t < 4) { const int c0 = t * 256; EPI_LOOP( st_bf4(QN + rw * 1024 + c0 + cl, v * qs); ) }
        else {
            const int c0 = (t - 4) * 256;
#pragma unroll
            for (int ai = 0; ai < 2; ++ai)
#pragma unroll
                for (int m = 0; m < 4; ++m) {
                    const int row = u.pm * 256 + ai * 128 + wr * 64 + m * 16 + fr;
                    const int pos = sample ? (PAST + (row & (ST - 1))) : (row & (TS - 1));
                    const f32x4 cs0 = *(const f32x4*)(rope + (size_t)pos * 32 + 8 * fq), cs1 = *(const f32x4*)(rope + (size_t)pos * 32 + 8 * fq + 4);
#pragma unroll
                    for (int bj = 0; bj < 2; ++bj) {
                        const f32x4 x1 = acc[ai][bj][m][0], x2 = acc[ai][bj][m][1];
                        f32x4 o1, o2;
                        o1[0] = x1[0] * cs0[0] - x2[0] * cs0[1]; o2[0] = x2[0] * cs0[0] + x1[0] * cs0[1];
                        o1[1] = x1[1] * cs0[2] - x2[1] * cs0[3]; o2[1] = x2[1] * cs0[2] + x1[1] * cs0[3];
                        o1[2] = x1[2] * cs1[0] - x2[2] * cs1[1]; o2[2] = x2[2] * cs1[0] + x1[2] * cs1[1];
                        o1[3] = x1[3] * cs1[2] - x2[3] * cs1[3]; o2[3] = x2[3] * cs1[2] + x1[3] * cs1[3];
                        bf16* p = QR + (size_t)row * 512 + c0 + bj * 128 + wc * 32 + 4 * fq;
                        st_bf4(p, o1 * qs); st_bf4(p + 16, o2 * qs);
                    }
                    asm volatile("" ::: "memory");
                }
        }
    }
};
struct EpiKV {
    static constexpr bool PERM = true, AFTER_DRAIN = false;
    bf16 *KN, *VM;
    __device__ __forceinline__ void operator()(AccRef acc, const pg8::Unit& u, int wr, int wc, int fr, int fq) const {
        const int t = u.pn; bf16* O = t < 4 ? KN : VM; const int c0 = (t & 3) * 256;
        EPI_LOOP_P( st_bf8(O + rw * 1024 + c0 + cl, v0, v1); )
    }
};
struct EpiM1 {
    static constexpr bool PERM = true, AFTER_DRAIN = false;
    const bf16* Gt; bf16* MG;
    __device__ __forceinline__ void operator()(AccRef acc, const pg8::Unit& u, int wr, int wc, int fr, int fq) const {
        const int c0 = u.pn * 256;
        EPI_LOOP_P( f32x4 g0, g1; ld_bf8(Gt + rw * 1024 + c0 + cl, g0, g1); st_bf8(MG + rw * 1024 + c0 + cl, g0 * v0, g1 * v1); )
    }
};
struct EpiM2 {
    static constexpr bool PERM = true, AFTER_DRAIN = false;
    const bf16* Gt; bf16* MG;
    __device__ __forceinline__ void operator()(AccRef acc, const pg8::Unit& u, int wr, int wc, int fr, int fq) const {
        const int c0 = u.pn * 256;
        EPI_LOOP_P( f32x4 g0, g1, o0, o1; ld_bf8(Gt + rw * 1024 + c0 + cl, g0, g1); ld_bf8(MG + rw * 1024 + c0 + cl, o0, o1); st_bf8(MG + rw * 1024 + c0 + cl, o0 + g0 * v0, o1 + g1 * v1); )
    }
};
struct EpiOut {
    static constexpr bool PERM = true, AFTER_DRAIN = false;
    const float* x; bf16* XB; float* SSQ; int nvalid;
    __device__ __forceinline__ void operator()(AccRef acc, const pg8::Unit& u, int wr, int wc, int fr, int fq) const {
        const int c0 = u.pn * 256;
#pragma unroll
        for (int ai = 0; ai < 2; ++ai)
#pragma unroll
            for (int m = 0; m < 4; ++m) {
                const int row = u.pm * 256 + ai * 128 + wr * 64 + m * 16 + fr; const size_t rw = (size_t)row; const bool ok = row < nvalid;
                float s = 0.f;
#pragma unroll
                for (int bj = 0; bj < 2; ++bj) {
                    const int cl = bj * 128 + wc * 32 + 8 * fq;
                    f32x4 v0 = {0.f, 0.f, 0.f, 0.f}, v1 = {0.f, 0.f, 0.f, 0.f};
                    if (ok) { const float* xb = x + rw * 1024 + c0 + cl; v0 = *(const f32x4*)xb + acc[ai][bj][m][0]; v1 = *(const f32x4*)(xb + 4) + acc[ai][bj][m][1]; }
                    st_bf8(XB + rw * 1024 + c0 + cl, v0, v1);
                    s += (v0[0] * v0[0] + v0[1] * v0[1]) + (v0[2] * v0[2] + v0[3] * v0[3]) + (v1[0] * v1[0] + v1[1] * v1[1]) + (v1[2] * v1[2] + v1[3] * v1[3]);
                }
                s += swz_xor<16>(s);
                { auto rr = __builtin_amdgcn_permlane32_swap(__float_as_uint(s), __float_as_uint(s), false, false); s = __uint_as_float(rr[0]) + __uint_as_float(rr[1]); }
                if (ok && fq == 0) atomicAdd(SSQ + row, s);
                asm volatile("" ::: "memory");
            }
    }
};
struct EpiUp {
    static constexpr bool PERM = true, AFTER_DRAIN = false;
    bf16* U; const float* SSQ;
    __device__ __forceinline__ void operator()(AccRef acc, const pg8::Unit& u, int wr, int wc, int fr, int fq) const {
        const int c0 = u.pn * 256;
#pragma unroll
        for (int ai = 0; ai < 2; ++ai)
#pragma unroll
            for (int m = 0; m < 4; ++m) {
                const int row = u.pm * 256 + ai * 128 + wr * 64 + m * 16 + fr; const size_t rw = (size_t)row;
                const float rs2 = 1.0f / (SSQ[row] * (1.f / 1024.f) + EPSN);
#pragma unroll
                for (int bj = 0; bj < 2; ++bj) {
                    const int cl = bj * 128 + wc * 32 + 8 * fq; const f32x4 v0 = acc[ai][bj][m][0], v1 = acc[ai][bj][m][1];
                    f32x4 r0, r1; r0[0] = fmaxf(v0[0], 0.f); r0[1] = fmaxf(v0[1], 0.f); r0[2] = fmaxf(v0[2], 0.f); r0[3] = fmaxf(v0[3], 0.f); r1[0] = fmaxf(v1[0], 0.f); r1[1] = fmaxf(v1[1], 0.f); r1[2] = fmaxf(v1[2], 0.f); r1[3] = fmaxf(v1[3], 0.f);
                    st_bf8(U + rw * 4096 + c0 + cl, r0 * r0 * rs2, r1 * r1 * rs2);
                }
                asm volatile("" ::: "memory");
            }
    }
};
struct EpiDown {
    static constexpr bool PERM = true, AFTER_DRAIN = false;
    const bf16* XB; float* y; int nvalid;
    __device__ __forceinline__ void operator()(AccRef acc, const pg8::Unit& u, int wr, int wc, int fr, int fq) const {
        const int c0 = u.pn * 256;
        EPI_LOOP_P( if (row < nvalid) { f32x4 b0, b1; ld_bf8(XB + rw * 1024 + c0 + cl, b0, b1); float* p = y + rw * 1024 + c0 + cl; *(f32x4*)p = b0 + v0; *(f32x4*)(p + 4) = b1 + v1; } )
    }
};
struct EpiDownAtomic {
    static constexpr bool PERM = true, AFTER_DRAIN = false;
    float* y; int nvalid;
    __device__ __forceinline__ void operator()(AccRef acc, const pg8::Unit& u, int wr, int wc, int fr, int fq) const {
        const int c0 = u.pn * 256;
        EPI_LOOP_P( if (row < nvalid) { float* p = y + rw * 1024 + c0 + cl;
            _Pragma("unroll") for (int e = 0; e < 4; ++e) { atomicAdd(p + e, v0[e]); atomicAdd(p + 4 + e, v1[e]); } } )
    }
};

template <class Epi>
__device__ __forceinline__ void run_gemm(LAS unsigned char* lds, const bf16* A, const bf16* Bt, int M, int N, int K, const Epi& E, const int tid_in, const int ld = 0, const int cshift = 0) {
    int Kr = K; asm volatile("" : "+s"(Kr));
    const int Gn = (int)gridDim.x; int c = (int)blockIdx.x - cshift; if (c < 0) c += Gn;
    pg8::Gemm g{A, Bt, M, N, Kr, ld ? ld : Kr}; pg8::StaticOrder S; S.init(M, N, Gn, c);
    pg8::gemm_phase<Epi, pg8::StaticOrder, true, true>(lds, g, S, E, tid_in);
}

__device__ __forceinline__ void rms_rows_bf16(const float* src, bf16* dst, const float* gain, int nvalid, int ntotal, int gw, int ngw, int lane, float* ssq_zero) {
    f32x4 g[4];
#pragma unroll
    for (int j = 0; j < 4; ++j) g[j] = ((const f32x4*)gain)[lane + 64 * j];
    for (int r0 = 2 * gw; r0 < ntotal; r0 += 2 * ngw) {
        f32x4 v[2][4];
#pragma unroll
        for (int k = 0; k < 2; ++k) { const int r = r0 + k; const f32x4* xr = (const f32x4*)(src + (size_t)(r < nvalid ? r : 0) * 1024) + lane;
#pragma unroll
            for (int j = 0; j < 4; ++j) v[k][j] = xr[64 * j]; }
#pragma unroll
        for (int k = 0; k < 2; ++k) { const int r = r0 + k; if (r >= ntotal) continue;
            if (lane == 0) ssq_zero[r] = 0.f;
            u32x2* o8 = (u32x2*)(dst + (size_t)r * 1024) + lane;
            float s = 0.f;
#pragma unroll
            for (int j = 0; j < 4; ++j) s += (v[k][j][0] * v[k][j][0] + v[k][j][1] * v[k][j][1]) + (v[k][j][2] * v[k][j][2] + v[k][j][3] * v[k][j][3]);
            const float rs = (r < nvalid) ? 1.0f / sqrtf(wave_sum(s) * (1.f / 1024.f) + EPSN) : 0.f;
#pragma unroll
            for (int j = 0; j < 4; ++j) { const f32x4 o = v[k][j] * rs * g[j]; o8[64 * j] = (u32x2){pk2(o[0], o[1]), pk2(o[2], o[3])}; } }
    }
}
__device__ __forceinline__ void rms_rows_f32_inplace(float* y, const float* gain, int nvalid, int gw, int ngw, int lane) {
    f32x4 g[4];
#pragma unroll
    for (int j = 0; j < 4; ++j) g[j] = ((const f32x4*)gain)[lane + 64 * j];
    for (int r0 = 2 * gw; r0 < nvalid; r0 += 2 * ngw) {
        f32x4 v[2][4];
#pragma unroll
        for (int k = 0; k < 2; ++k) { const int r = r0 + k; f32x4* xr = (f32x4*)(y + (size_t)(r < nvalid ? r : r0) * 1024) + lane;
#pragma unroll
            for (int j = 0; j < 4; ++j) v[k][j] = xr[64 * j]; }
#pragma unroll
        for (int k = 0; k < 2; ++k) { const int r = r0 + k; if (r >= nvalid) continue;
            f32x4* xr = (f32x4*)(y + (size_t)r * 1024) + lane;
            float s = 0.f;
#pragma unroll
            for (int j = 0; j < 4; ++j) s += (v[k][j][0] * v[k][j][0] + v[k][j][1] * v[k][j][1]) + (v[k][j][2] * v[k][j][2] + v[k][j][3] * v[k][j][3]);
            const float rs = 1.0f / sqrtf(wave_sum(s) * (1.f / 1024.f) + EPSN);
#pragma unroll
            for (int j = 0; j < 4; ++j) xr[64 * j] = v[k][j] * rs * g[j]; }
    }
}
__device__ __forceinline__ void phase_small(const Grp& G, const float* gq, const float* gkv, const float* rope, int gw, int ngw, int lane) {
    const int ntotal = G.ntiles * 256;
    for (int r = gw; r < ntotal; r += ngw) {
        const float* z = G.ZS + (size_t)r * 768;
        const f32x4 cq = ((const f32x4*)z)[lane], ck = ((const f32x4*)(z + 256))[lane];
        const float s1 = wave_sum((cq[0] * cq[0] + cq[1] * cq[1]) + (cq[2] * cq[2] + cq[3] * cq[3]));
        const float s2 = wave_sum((ck[0] * ck[0] + ck[1] * ck[1]) + (ck[2] * ck[2] + ck[3] * ck[3]));
        const float r1 = 1.0f / sqrtf(s1 * (1.f / 256.f) + EPSN), r2 = 1.0f / sqrtf(s2 * (1.f / 256.f) + EPSN);
        const f32x4 o1 = cq * r1 * ((const f32x4*)gq)[lane], o2 = ck * r2 * ((const f32x4*)gkv)[lane];
        ((u32x2*)(G.CQ + (size_t)r * 256))[lane] = (u32x2){pk2(o1[0], o1[1]), pk2(o1[2], o1[3])};
        ((u32x2*)(G.CKV + (size_t)r * 256))[lane] = (u32x2){pk2(o2[0], o2[1]), pk2(o2[2], o2[3])};
        if (r < G.nvalid) ((f32x4*)(G.ockv + (size_t)r * 256))[lane] = o2;
        if (lane < 16) {
            const int pos = G.sample ? (PAST + (r & (ST - 1))) : (r & (TS - 1));
            const float x1 = z[512 + lane], x2 = z[512 + 16 + lane];
            const f32x2 cs = *(const f32x2*)(rope + (size_t)pos * 32 + 2 * lane);
            const float a = x1 * cs[0] - x2 * cs[1], b = x2 * cs[0] + x1 * cs[1];
            G.KR[(size_t)r * 32 + lane] = (bf16)f2bf(a); G.KR[(size_t)r * 32 + 16 + lane] = (bf16)f2bf(b);
            if (r < G.nvalid) { G.okr[(size_t)r * 32 + lane] = a; G.okr[(size_t)r * 32 + 16 + lane] = b; }
        }
    }
}

__device__ __forceinline__ void tr_item(const float* W, int K, int N, bf16* WT, int k0, int n0, int drow0, LAS float* scr, int lane, const float* kgain = nullptr) {
#pragma unroll 8
    for (int i = 0; i < 32; ++i) { const int kk = 2 * i + (lane >> 5); const float gk = kgain ? kgain[k0 + kk] : 1.f; scr[kk * 33 + (lane & 31)] = W[(size_t)(k0 + kk) * N + n0 + (lane & 31)] * gk; }
    asm volatile("s_waitcnt lgkmcnt(0)" ::: "memory");
    const int c = lane & 7;
#pragma unroll
    for (int j = 0; j < 4; ++j) { const int n = (lane >> 3) + 8 * j; const LAS float* s = scr + (8 * c) * 33 + n;
        u32x4 o; o.x = pk2(s[0 * 33], s[1 * 33]); o.y = pk2(s[2 * 33], s[3 * 33]); o.z = pk2(s[4 * 33], s[5 * 33]); o.w = pk2(s[6 * 33], s[7 * 33]);
        *(u32x4*)(WT + (size_t)(drow0 + n) * K + k0 + 8 * c) = o; }
    asm volatile("s_waitcnt lgkmcnt(0)" ::: "memory");
}
__device__ __forceinline__ int map_in(int n0) {
    if (n0 < 3616) return n0;
    if (n0 < 4640) return n0 - 3616 + 3840;
    return n0 - 4640 + 4864;
}
__device__ __forceinline__ int map_uq(int n0) { const int hh = n0 / 96, d0 = n0 % 96; return d0 < 64 ? hh * 64 + d0 : 1024 + hh * 32 + (d0 - 64); }
__device__ __forceinline__ void cvt8(const float* src, bf16* dst, size_t n8, size_t gt, size_t ngt) {
    for (size_t i = gt; i < n8; i += ngt) { const f32x4 a = ((const f32x4*)src)[2 * i], b = ((const f32x4*)src)[2 * i + 1];
        ((u32x4*)dst)[i] = (u32x4){pk2(a[0], a[1]), pk2(a[2], a[3]), pk2(b[0], b[1]), pk2(b[2], b[3])}; }
}
__device__ __forceinline__ void phase_prologue(const Args& a, LAS unsigned char* lds, int gw, int ngw, int lane, int wave) {
    unsigned char* ws = a.ws;
    LAS float* scr = (LAS float*)(lds + wave * 16384);
    constexpr int I_IN = 16 * 177, I_UQ = 4 * 48, I_UK = 4 * 32, I_UV = 4 * 32, I_O = 16 * 32, I_UP = 16 * 128, I_DN = 64 * 32;
    constexpr int NITEMS = I_IN + I_UQ + I_UK + I_UV + 3 * I_O + I_UP + I_DN;
    for (int it = gw; it < NITEMS; it += ngw) {
        int r = it;
        if (r < I_IN) { const int kb = r / 177, nb = r % 177; tr_item(a.in[8], 1024, 5664, (bf16*)(ws + WS_WIN), 64 * kb, 32 * nb, map_in(32 * nb), scr, lane); continue; } r -= I_IN;
        if (r < I_UQ) { const int kb = r / 48, nb = r % 48; tr_item(a.in[15], 256, 1536, (bf16*)(ws + WS_WUQ), 64 * kb, 32 * nb, map_uq(32 * nb), scr, lane); continue; } r -= I_UQ;
        if (r < I_UK) { const int kb = r / 32, nb = r % 32; tr_item(a.in[17], 256, 1024, (bf16*)(ws + WS_WUKV), 64 * kb, 32 * nb, 32 * nb, scr, lane); continue; } r -= I_UK;
        if (r < I_UV) { const int kb = r / 32, nb = r % 32; tr_item(a.in[18], 256, 1024, (bf16*)(ws + WS_WUKV), 64 * kb, 32 * nb, 1024 + 32 * nb, scr, lane); continue; } r -= I_UV;
        if (r < I_O) { const int kb = r / 32, nb = r % 32; tr_item(a.in[19], 1024, 1024, (bf16*)(ws + WS_WOD), 64 * kb, 32 * nb, 32 * nb, scr, lane); continue; } r -= I_O;
        if (r < I_O) { const int kb = r / 32, nb = r % 32; tr_item(a.in[20], 1024, 1024, (bf16*)(ws + WS_WOM), 64 * kb, 32 * nb, 32 * nb, scr, lane); continue; } r -= I_O;
        if (r < I_O) { const int kb = r / 32, nb = r % 32; tr_item(a.in[21], 1024, 1024, (bf16*)(ws + WS_WOUT), 64 * kb, 32 * nb, 32 * nb, scr, lane); continue; } r -= I_O;
        if (r < I_UP) { const int kb = r / 128, nb = r % 128; tr_item(a.in[23], 1024, 4096, (bf16*)(ws + WS_WUP), 64 * kb, 32 * nb, 32 * nb, scr, lane, a.in[22]); continue; } r -= I_UP;
        { const int kb = r / 32, nb = r % 32; tr_item(a.in[24], 4096, 1024, (bf16*)(ws + WS_WDN), 64 * kb, 32 * nb, 32 * nb, scr, lane); }
    }
    const size_t gt = (size_t)gw * 64 + lane, ngt = (size_t)ngw * 64;
    { u32x4* z = (u32x4*)(ws + WS_WIN + (size_t)3616 * 2048); for (size_t i = gt; i < (size_t)224 * 128; i += ngt) z[i] = (u32x4){0u, 0u, 0u, 0u}; }
    unsigned char* cb = ws + WS_CACHE;
    cvt8(a.in[2], (bf16*)(cb + C_KDC), (size_t)CACHE_ROWS * 128, gt, ngt);
    cvt8(a.in[3], (bf16*)(cb + C_VDC), (size_t)CACHE_ROWS * 128, gt, ngt);
    cvt8(a.in[4], (bf16*)(cb + C_CKVC), (size_t)CACHE_ROWS * 32, gt, ngt);
    cvt8(a.in[5], (bf16*)(cb + C_KRC), (size_t)CACHE_ROWS * 4, gt, ngt);
    float* tab = (float*)(ws + WS_TAB);
    for (size_t i = gt; i < 8 * 192; i += ngt) {
        const int h = (int)i / 192, idx = (int)i % 192, rel = idx - 128, n = rel < 0 ? -rel : rel;
        int bucket = n;
        if (n >= 8) { int j = (31 - __clz(n * n)) - 6; bucket = 8 + j; if (bucket > 15) bucket = 15; }
        if (rel > 0) bucket += 16;
        tab[i] = (a.in[6][bucket * 8 + h] - a.in[6][15 * 8 + h]) * LOG2E;
    }
    if (gt == 0) {
        float d1 = 0.f, d2 = 0.f;
        for (int i = 0; i < 64; ++i) { d1 += a.in[9][i] * a.in[10][i]; d2 += a.in[11][i] * a.in[12][i]; }
        tab[1536] = expf(d1) - expf(d2) + 0.2f;
    }
    float* rope = (float*)(ws + WS_ROPE);
    for (size_t i = gt; i < (size_t)(PAST + ST) * 16; i += ngt) {
        const int pos = (int)(i >> 4), k = (int)(i & 15);
        const float inv = __builtin_amdgcn_exp2f(-(float)k * 0.8304820237218406f);
        const float ang = (float)pos * inv;
        const double rev = (double)ang * 0.15915494309189535;
        const float fr = (float)(rev - __builtin_rint(rev));
        rope[2 * i] = __builtin_amdgcn_cosf(fr); rope[2 * i + 1] = __builtin_amdgcn_sinf(fr);
    }
}

#ifndef ATTMASK
#define ATTMASK 15
#endif
constexpr int AL_TAB = 0, AL_WSF = 6144, AL_TILE = 8192;

__device__ __forceinline__ int crow(int r, int hi) { return (r & 3) + 8 * (r >> 2) + 4 * hi; }
__device__ __forceinline__ float xmax32(float v) { auto rr = __builtin_amdgcn_permlane32_swap(__float_as_uint(v), __float_as_uint(v), false, false); return fmaxf(__uint_as_float(rr[0]), __uint_as_float(rr[1])); }
__device__ __forceinline__ float xsum32(float v) { auto rr = __builtin_amdgcn_permlane32_swap(__float_as_uint(v), __float_as_uint(v), false, false); return __uint_as_float(rr[0]) + __uint_as_float(rr[1]); }
typedef __bf16 bf16x2_t __attribute__((ext_vector_type(2)));
__device__ __forceinline__ unsigned cvtpk(float lo, float hi) { f32x2 v = {lo, hi}; bf16x2_t b = __builtin_convertvector(v, bf16x2_t); return __builtin_bit_cast(unsigned, b); }
__device__ __forceinline__ bf16x8 pack8(float a0, float a1, float a2, float a3, float a4, float a5, float a6, float a7) {
    u32x4 w = {cvtpk(a0, a1), cvtpk(a2, a3), cvtpk(a4, a5), cvtpk(a6, a7)}; return __builtin_bit_cast(bf16x8, w);
}
typedef short v4i16_t __attribute__((ext_vector_type(4)));
__device__ __forceinline__ s16x4 vtr(const LAS unsigned char* p) { return __builtin_bit_cast(s16x4, __builtin_amdgcn_ds_read_tr16_b64_v4i16((LAS v4i16_t*)p)); }

template <int DQK, int DV> struct AttnState { bf16x8 qf[DQK / 16]; f32x16 o[DV / 32]; f32x16 negm; float m, l; };
constexpr float ATT_THR = 8.0f;

template <int DQK, int DV, bool HAS_BIAS>
__device__ __forceinline__ void attn_tile(AttnState<DQK, DV>& st, const LAS unsigned char* Kt, const LAS unsigned char* Vt, int bias_mode, const LAS float* tab, int rel0, int nkeys, bool first, LAS float* wsf, int lane) {
    constexpr int PK = DQK * 2 + 16, PV = DV * 2 + 64, KS = DQK / 16, NDB = DV / 32;
    const int q = lane & 31, hi = lane >> 5;
    f32x16 p0, p1;
    const LAS unsigned char* kp = Kt + q * PK + hi * 16;
    bf16x8 ka[KS], kb[KS];
#pragma unroll
    for (int ks = 0; ks < KS; ++ks) { ka[ks] = *(const LAS bf16x8*)(kp + ks * 32); kb[ks] = *(const LAS bf16x8*)(kp + 32 * PK + ks * 32); }
    if (HAS_BIAS && bias_mode == 2) {
        asm volatile("" ::: "memory");
#pragma unroll
        for (int r = 0; r < 16; ++r) {
            const int k = crow(r, hi);
            const int i0 = min(max(rel0 + k + 128, 0), 191), i1 = min(max(rel0 + k + 160, 0), 191);
            p0[r] = tab[i0] + st.negm[r]; p1[r] = tab[i1] + st.negm[r];
        }
        p0 = __builtin_amdgcn_mfma_f32_32x32x16_bf16(ka[0], st.qf[0], p0, 0, 0, 0);
        p1 = __builtin_amdgcn_mfma_f32_32x32x16_bf16(kb[0], st.qf[0], p1, 0, 0, 0);
    } else {
        p0 = __builtin_amdgcn_mfma_f32_32x32x16_bf16(ka[0], st.qf[0], st.negm, 0, 0, 0);
        p1 = __builtin_amdgcn_mfma_f32_32x32x16_bf16(kb[0], st.qf[0], st.negm, 0, 0, 0);
    }
#pragma unroll
    for (int ks = 1; ks < KS; ++ks) {
        p0 = __builtin_amdgcn_mfma_f32_32x32x16_bf16(ka[ks], st.qf[ks], p0, 0, 0, 0);
        p1 = __builtin_amdgcn_mfma_f32_32x32x16_bf16(kb[ks], st.qf[ks], p1, 0, 0, 0);
    }
    const int q4 = (lane & 15) >> 2, blk = (lane >> 4) & 1, pp = lane & 3;
    const LAS unsigned char* vp = Vt + (4 * hi + q4) * PV + (16 * blk + 4 * pp) * 2;
    s16x4 vlo[2][4], vhi[2][4];
#pragma unroll
    for (int s4 = 0; s4 < 4; ++s4) { vlo[0][s4] = vtr(vp + (16 * s4) * PV); vhi[0][s4] = vtr(vp + (16 * s4 + 8) * PV); }
    __builtin_amdgcn_sched_barrier(0);
    if (nkeys < 64) {
#pragma unroll
        for (int r = 0; r < 16; ++r) { const int k = crow(r, hi); if (k >= nkeys) p0[r] = -1e30f; if (k + 32 >= nkeys) p1[r] = -1e30f; }
    }
    float mxa = __builtin_fmaxf(__builtin_fmaxf(p0[0], p0[1]), p1[0]), mxb = __builtin_fmaxf(__builtin_fmaxf(p0[2], p0[3]), p1[1]);
    mxa = __builtin_fmaxf(__builtin_fmaxf(mxa, p1[2]), p1[3]);
#pragma unroll
    for (int r = 4; r < 16; r += 4) {
        mxa = __builtin_fmaxf(__builtin_fmaxf(mxa, p0[r]), p0[r + 1]); mxb = __builtin_fmaxf(__builtin_fmaxf(mxb, p0[r + 2]), p0[r + 3]);
        mxa = __builtin_fmaxf(__builtin_fmaxf(mxa, p1[r]), p1[r + 1]); mxb = __builtin_fmaxf(__builtin_fmaxf(mxb, p1[r + 2]), p1[r + 3]);
    }
    const float mx = xmax32(__builtin_fmaxf(mxa, mxb));
    if (first || __any(mx > ATT_THR)) {
        const float dl = first ? mx : __builtin_fmaxf(mx, 0.f);
        st.m += dl;
#pragma unroll
        for (int r = 0; r < 16; ++r) { st.negm[r] = -st.m; p0[r] -= dl; p1[r] -= dl; }
        const float f = __builtin_amdgcn_exp2f(-dl);
        st.l *= f;
        if (hi == 0) wsf[q] = f;
#pragma unroll
        for (int r = 0; r < 16; ++r) { const float fr = wsf[crow(r, hi)];
#pragma unroll
            for (int db = 0; db < NDB; ++db) st.o[db][r] *= fr; }
    }
    float sum0 = 0.f, sum1 = 0.f;
#pragma unroll
    for (int r = 0; r < 16; ++r) { p0[r] = __builtin_amdgcn_exp2f(p0[r]); p1[r] = __builtin_amdgcn_exp2f(p1[r]); sum0 += p0[r]; sum1 += p1[r]; }
    st.l += sum0 + sum1;
    bf16x8 pf[4];
    pf[0] = pack8(p0[0], p0[1], p0[2], p0[3], p0[4], p0[5], p0[6], p0[7]);
    pf[1] = pack8(p0[8], p0[9], p0[10], p0[11], p0[12], p0[13], p0[14], p0[15]);
    pf[2] = pack8(p1[0], p1[1], p1[2], p1[3], p1[4], p1[5], p1[6], p1[7]);
    pf[3] = pack8(p1[8], p1[9], p1[10], p1[11], p1[12], p1[13], p1[14], p1[15]);
    __builtin_amdgcn_sched_barrier(0);
#pragma unroll
    for (int db = 0; db < NDB; ++db) {
        if (db + 1 < NDB) {
#pragma unroll
            for (int s4 = 0; s4 < 4; ++s4) { vlo[(db + 1) & 1][s4] = vtr(vp + (16 * s4) * PV + (db + 1) * 64); vhi[(db + 1) & 1][s4] = vtr(vp + (16 * s4 + 8) * PV + (db + 1) * 64); }
        }
#pragma unroll
        for (int s4 = 0; s4 < 4; ++s4) {
            const s16x4 lo = vlo[db & 1][s4], h4 = vhi[db & 1][s4];
            const bf16x8 vb = {lo[0], lo[1], lo[2], lo[3], h4[0], h4[1], h4[2], h4[3]};
            st.o[db] = __builtin_amdgcn_mfma_f32_32x32x16_bf16(pf[s4], vb, st.o[db], 0, 0, 0);
        }
        __builtin_amdgcn_sched_barrier(0);
    }
}

template <int DQK, int DV>
__device__ __forceinline__ void attn_init(AttnState<DQK, DV>& st) {
    st.m = 0.f; st.l = 0.f;
#pragma unroll
    for (int r = 0; r < 16; ++r) st.negm[r] = 0.f;
#pragma unroll
    for (int db = 0; db < DV / 32; ++db)
#pragma unroll
        for (int r = 0; r < 16; ++r) st.o[db][r] = 0.f;
}

template <bool DIFF>
__device__ __forceinline__ void attn_unit_coop(const Grp& G, int b, int h, int qb, int n, LAS unsigned char* lds, const int tid_in) {
    constexpr int DQK = DIFF ? 64 : 96, DV = DIFF ? 128 : 64, PK = DQK * 2 + 16, PV = DV * 2 + 64, KB = 64 * PK, VB = 64 * PV, TB = KB + VB, NDB = DV / 32;
    int tid_ = tid_in; asm volatile("" : "+v"(tid_));
    const int tid = tid_, lane = tid & 63, wid = __builtin_amdgcn_readfirstlane(tid >> 6), q = lane & 31, hi = lane >> 5;
    const size_t seq0 = (size_t)b * TS;
    const int qrow0 = qb * 256 + wid * 32;
    const int NT = 4 * qb + 4, my_nt = 4 * qb + (wid >> 1) + 1;
    const LAS float* tab = (const LAS float*)(lds + AL_TAB) + h * 192;
    LAS float* wsf = (LAS float*)(lds + AL_WSF) + wid * 64;
    LAS unsigned char* tiles = lds + AL_TILE;
    {
        AttnState<DQK, DV> st; attn_init(st);
        if (DIFF) { const bf16* qp = G.QD + (seq0 + qrow0 + q) * 1024 + h * 128 + n * 64 + hi * 8;
#pragma unroll
            for (int ks = 0; ks < 4; ++ks) st.qf[ks] = *(const bf16x8*)(qp + ks * 16);
        } else { const bf16* qn = G.QN + (seq0 + qrow0 + q) * 1024 + h * 64 + hi * 8; const bf16* qr = G.QR + (seq0 + qrow0 + q) * 512 + h * 32 + hi * 8;
#pragma unroll
            for (int ks = 0; ks < 4; ++ks) st.qf[ks] = *(const bf16x8*)(qn + ks * 16);
#pragma unroll
            for (int ks = 0; ks < 2; ++ks) st.qf[4 + ks] = *(const bf16x8*)(qr + ks * 16);
        }
        const bf16* ksrc = (DIFF ? G.KD + h * 128 + n * 64 : G.KN + h * 64) + (seq0 + (tid >> 3)) * 1024 + (tid & 7) * 8;
        const int kdst = (tid >> 3) * PK + (tid & 7) * 16;
        const bf16* k2src = G.KR + (seq0 + ((tid & 255) >> 2)) * 32 + (tid & 3) * 8;
        const int k2dst = ((tid & 255) >> 2) * PK + 128 + (tid & 3) * 16;
        const bf16* vsrc = DIFF ? G.VD + (seq0 + (tid >> 4)) * 1024 + h * 128 + (tid & 15) * 8 : G.VM + (seq0 + (tid >> 3)) * 1024 + h * 64 + (tid & 7) * 8;
        const int vdst = DIFF ? KB + (tid >> 4) * PV + (tid & 15) * 16 : KB + (tid >> 3) * PV + (tid & 7) * 16;
        u32x4 rkA, rk2A = {0u, 0u, 0u, 0u}, rv0A, rv1A = {0u, 0u, 0u, 0u}, rkB = {0u, 0u, 0u, 0u}, rk2B = {0u, 0u, 0u, 0u}, rv0B = {0u, 0u, 0u, 0u}, rv1B = {0u, 0u, 0u, 0u};
#define ATT_LOAD(S, j) do { rk##S = *(const u32x4*)(ksrc + (size_t)(j) * 64 * 1024); if (!DIFF && tid < 256) rk2##S = *(const u32x4*)(k2src + (size_t)(j) * 64 * 32); \
        rv0##S = *(const u32x4*)(vsrc + (size_t)(j) * 64 * 1024); if (DIFF) rv1##S = *(const u32x4*)(vsrc + (size_t)(j) * 64 * 1024 + 32 * 1024); } while (0)
#define ATT_STORE(S, bufp) do { *(LAS u32x4*)((bufp) + kdst) = rk##S; if (!DIFF && tid < 256) *(LAS u32x4*)((bufp) + k2dst) = rk2##S; \
        *(LAS u32x4*)((bufp) + vdst) = rv0##S; if (DIFF) *(LAS u32x4*)((bufp) + vdst + 32 * PV) = rv1##S; } while (0)
#define ATT_COMPUTE(j, bufp) do { if ((j) < my_nt) { const int kb_ = 64 * (j); const int mode_ = DIFF ? ((kb_ + 63 - qrow0 <= -128) ? 1 : 2) : 0; \
        attn_tile<DQK, DV, DIFF>(st, (bufp), (bufp) + KB, mode_, tab, kb_ - (qrow0 + q), 64, (j) == 0, wsf, lane); } } while (0)
        ATT_LOAD(A, 0); ATT_STORE(A, tiles);
        __syncthreads();
        ATT_LOAD(A, 1);
        for (int j = 0; j < NT; j += 2) {
            LAS unsigned char* b0 = tiles + (j & 1) * TB; LAS unsigned char* b1 = tiles + ((j + 1) & 1) * TB;
            if (j + 2 < NT) ATT_LOAD(B, j + 2);
            ATT_COMPUTE(j, b0);
            ATT_STORE(A, b1);
            __syncthreads();
            if (j + 3 < NT) ATT_LOAD(A, j + 3);
            ATT_COMPUTE(j + 1, b1);
            if (j + 2 < NT) ATT_STORE(B, b0);
            __syncthreads();
        }
#undef ATT_LOAD
#undef ATT_STORE
#undef ATT_COMPUTE
        const float lt = xsum32(st.l);
        if (hi == 0) wsf[32 + q] = lt;
        float inv[16];
#pragma unroll
        for (int r = 0; r < 16; ++r) inv[r] = 1.0f / wsf[32 + crow(r, hi)];
        bf16* obase = (DIFF ? (n == 0 ? G.DO : G.XN) + h * 128 : G.MO + h * 64) + (seq0 + qrow0) * 1024 + q;
#pragma unroll
        for (int db = 0; db < NDB; ++db)
#pragma unroll
            for (int r = 0; r < 16; ++r) obase[(size_t)crow(r, hi) * 1024 + db * 32] = (bf16)f2bf(st.o[db][r] * inv[r]);
    }
}

__device__ __forceinline__ void phase_diffmix(const Grp& G, float lam, const float* subln, int gw, int ngw, int lane) {
    const int c = (lane & 7) * 16;
    float g[16];
#pragma unroll
    for (int i = 0; i < 16; ++i) g[i] = subln[c + i] * 0.8f;
    for (int r = gw; r < G.nvalid; r += ngw) {
        bf16* p1 = G.DO + (size_t)r * 1024 + lane * 16; const bf16* p2 = G.XN + (size_t)r * 1024 + lane * 16;
        const u32x4 a0 = ((const u32x4*)p1)[0], a1 = ((const u32x4*)p1)[1], b0 = ((const u32x4*)p2)[0], b1 = ((const u32x4*)p2)[1];
        float v[16];
#pragma unroll
        for (int i = 0; i < 4; ++i) { v[2 * i] = bflo(a0[i]) - lam * bflo(b0[i]); v[2 * i + 1] = bfhi(a0[i]) - lam * bfhi(b0[i]);
                                      v[8 + 2 * i] = bflo(a1[i]) - lam * bflo(b1[i]); v[8 + 2 * i + 1] = bfhi(a1[i]) - lam * bfhi(b1[i]); }
        float s = 0.f;
#pragma unroll
        for (int i = 0; i < 16; ++i) s += v[i] * v[i];
        s += swz_xor<1>(s); s += swz_xor<2>(s); s += swz_xor<4>(s);
        const float rs = 1.0f / sqrtf(s * (1.f / 128.f) + EPSN);
        u32x4 o0, o1;
#pragma unroll
        for (int i = 0; i < 4; ++i) { o0[i] = pk2(v[2 * i] * rs * g[2 * i], v[2 * i + 1] * rs * g[2 * i + 1]); o1[i] = pk2(v[8 + 2 * i] * rs * g[8 + 2 * i], v[8 + 2 * i + 1] * rs * g[8 + 2 * i + 1]); }
        ((u32x4*)p1)[0] = o0; ((u32x4*)p1)[1] = o1;
    }
}

template <bool DIFF>
__device__ __forceinline__ void attn_unit_wave(const Grp& G, const unsigned char* cb, int b, int h, int n, int j0, int j1, int wu, float* PO, float* PM, float* PL,
                                               LAS unsigned char* wt, LAS float* wsf, const LAS float* tab0, int lane_in) {
    int lane = lane_in; asm volatile("" : "+v"(lane)); lane &= 63;
    constexpr int DQK = DIFF ? 64 : 96, DV = DIFF ? 128 : 64, PK = DQK * 2 + 16, PV = DV * 2 + 64, KB = 64 * PK, NDB = DV / 32;
    const int q = lane & 31, hi = lane >> 5;
    const LAS float* tab = tab0 + h * 192;
    AttnState<DQK, DV> st; attn_init(st);
    const size_t qrow = (size_t)b * ST + q;
    if (DIFF) { const bf16* qp = G.QD + qrow * 1024 + h * 128 + n * 64 + hi * 8;
#pragma unroll
        for (int ks = 0; ks < 4; ++ks) st.qf[ks] = *(const bf16x8*)(qp + ks * 16);
    } else { const bf16* qn = G.QN + qrow * 1024 + h * 64 + hi * 8; const bf16* qr = G.QR + qrow * 512 + h * 32 + hi * 8;
#pragma unroll
        for (int ks = 0; ks < 4; ++ks) st.qf[ks] = *(const bf16x8*)(qn + ks * 16);
#pragma unroll
        for (int ks = 0; ks < 2; ++ks) st.qf[4 + ks] = *(const bf16x8*)(qr + ks * 16);
    }
    for (int j = j0; j < j1; ++j) {
        const bf16 *kA, *kB2, *vA; int nkeys;
        if (j < 64) { const size_t r0 = (size_t)b * PAST + 64 * j; nkeys = 64;
            kA = DIFF ? (const bf16*)(cb + C_KDC) + r0 * 1024 + h * 128 + n * 64 : (const bf16*)(cb + C_KNC) + r0 * 1024 + h * 64;
            kB2 = (const bf16*)(cb + C_KRC) + r0 * 32;
            vA = DIFF ? (const bf16*)(cb + C_VDC) + r0 * 1024 + h * 128 : (const bf16*)(cb + C_VMC) + r0 * 1024 + h * 64;
        } else { const size_t r0 = (size_t)b * ST; nkeys = ST;
            kA = DIFF ? G.KD + r0 * 1024 + h * 128 + n * 64 : G.KN + r0 * 1024 + h * 64;
            kB2 = G.KR + r0 * 32;
            vA = DIFF ? G.VD + r0 * 1024 + h * 128 : G.VM + r0 * 1024 + h * 64;
        }
        { u32x4 t[8];
#pragma unroll
            for (int i = 0; i < 8; ++i) { const int idx = lane + 64 * i; t[i] = *(const u32x4*)(kA + (size_t)(idx >> 3) * 1024 + (idx & 7) * 8); }
#pragma unroll
            for (int i = 0; i < 8; ++i) { const int idx = lane + 64 * i; *(LAS u32x4*)(wt + (idx >> 3) * PK + (idx & 7) * 16) = t[i]; } }
        if (!DIFF) { u32x4 t[4];
#pragma unroll
            for (int i = 0; i < 4; ++i) { const int idx = lane + 64 * i; t[i] = *(const u32x4*)(kB2 + (size_t)(idx >> 2) * 32 + (idx & 3) * 8); }
#pragma unroll
            for (int i = 0; i < 4; ++i) { const int idx = lane + 64 * i; *(LAS u32x4*)(wt + (idx >> 2) * PK + 128 + (idx & 3) * 16) = t[i]; } }
        if (DIFF) {
#pragma unroll
            for (int hf = 0; hf < 2; ++hf) { u32x4 t[8];
#pragma unroll
                for (int i = 0; i < 8; ++i) { const int idx = lane + 64 * i + 512 * hf; t[i] = *(const u32x4*)(vA + (size_t)(idx >> 4) * 1024 + (idx & 15) * 8); }
#pragma unroll
                for (int i = 0; i < 8; ++i) { const int idx = lane + 64 * i + 512 * hf; *(LAS u32x4*)(wt + KB + (idx >> 4) * PV + (idx & 15) * 16) = t[i]; } }
        } else { u32x4 t[8];
#pragma unroll
            for (int i = 0; i < 8; ++i) { const int idx = lane + 64 * i; t[i] = *(const u32x4*)(vA + (size_t)(idx >> 3) * 1024 + (idx & 7) * 8); }
#pragma unroll
            for (int i = 0; i < 8; ++i) { const int idx = lane + 64 * i; *(LAS u32x4*)(wt + KB + (idx >> 3) * PV + (idx & 7) * 16) = t[i]; } }
        const int kb = 64 * j;
        const int mode = DIFF ? ((j <= 61) ? 1 : 2) : 0;
        attn_tile<DQK, DV, DIFF>(st, wt, wt + KB, mode, tab, kb - (PAST + q), nkeys, j == j0, wsf, lane);
    }
    const float lt = xsum32(st.l);
    if (hi == 0) { PM[wu * 32 + q] = st.m; PL[wu * 32 + q] = lt; }
#pragma unroll
    for (int db = 0; db < NDB; ++db)
#pragma unroll
        for (int r = 0; r < 16; ++r) PO[((size_t)wu * 32 + crow(r, hi)) * DV + db * 32 + q] = st.o[db][r];
}

__device__ __forceinline__ void phase_combine(const Grp& G, const float* POd, const float* POm, const float* PM, const float* PL, float lam, const float* subln, int gw, int ngw, int lane) {
    for (int it = gw; it < SB * 8 * ST + SB * 16 * ST; it += ngw) {
        if (it < SB * 8 * ST) {
            const int qq = it & 15, h = (it >> 4) & 7, b = it >> 7;
            float val[2] = {0.f, 0.f};
#pragma unroll
            for (int n = 0; n < 2; ++n) {
                const int wu0 = ((b * 8 + h) * 2 + n) * NSPLIT;
                float M = -1e30f;
#pragma unroll
                for (int s = 0; s < NSPLIT; ++s) M = fmaxf(M, PM[(wu0 + s) * 32 + qq]);
                float L = 0.f, a0 = 0.f, a1 = 0.f;
#pragma unroll
                for (int s = 0; s < NSPLIT; ++s) { const float w = __builtin_amdgcn_exp2f(PM[(wu0 + s) * 32 + qq] - M); L += PL[(wu0 + s) * 32 + qq] * w;
                    const float* po = POd + ((size_t)(wu0 + s) * 32 + qq) * 128; a0 += po[lane] * w; a1 += po[lane + 64] * w; }
                const float sc = (n == 0 ? 1.f : -lam) / L;
                val[0] += a0 * sc; val[1] += a1 * sc;
            }
            const float ss = wave_sum(val[0] * val[0] + val[1] * val[1]);
            const float rs = 0.8f / sqrtf(ss * (1.f / 128.f) + EPSN);
            bf16* o = G.DO + (size_t)(b * ST + qq) * 1024 + h * 128;
            o[lane] = (bf16)f2bf(val[0] * rs * subln[lane]); o[lane + 64] = (bf16)f2bf(val[1] * rs * subln[lane + 64]);
        } else {
            const int i2 = it - SB * 8 * ST; const int qq = i2 & 15, h = (i2 >> 4) & 15, b = i2 >> 8;
            const int wu0 = 512 + (b * 16 + h) * NSPLIT;
            float M = -1e30f;
#pragma unroll
            for (int s = 0; s < NSPLIT; ++s) M = fmaxf(M, PM[(wu0 + s) * 32 + qq]);
            float L = 0.f, a0 = 0.f;
#pragma unroll
            for (int s = 0; s < NSPLIT; ++s) { const float w = __builtin_amdgcn_exp2f(PM[(wu0 + s) * 32 + qq] - M); L += PL[(wu0 + s) * 32 + qq] * w;
                a0 += POm[((size_t)(wu0 - 512 + s) * 32 + qq) * 64 + lane] * w; }
            G.MO[(size_t)(b * ST + qq) * 1024 + h * 64 + lane] = (bf16)f2bf(a0 / L);
        }
    }
}

__device__ __forceinline__ void diffmix_block(const Grp& G, int b, int h, int qb, float lam, const float* subln, int tid) {
    const int lane = tid & 63, wid = tid >> 6;
    const float g0 = subln[2 * lane] * 0.8f, g1 = subln[2 * lane + 1] * 0.8f;
    const size_t row0 = (size_t)b * TS + qb * 256 + wid * 32;
#pragma unroll 1
    for (int rb = 0; rb < 32; rb += 16) {
        unsigned a[16], c[16];
#pragma unroll
        for (int r = 0; r < 16; ++r) { a[r] = *((const unsigned*)(G.DO + (row0 + rb + r) * 1024 + h * 128) + lane); c[r] = *((const unsigned*)(G.XN + (row0 + rb + r) * 1024 + h * 128) + lane); }
#pragma unroll
        for (int r = 0; r < 16; ++r) {
            const float v0 = bflo(a[r]) - lam * bflo(c[r]), v1 = bfhi(a[r]) - lam * bfhi(c[r]);
            const float ss = wave_sum(v0 * v0 + v1 * v1);
            const float rs = 1.0f / sqrtf(ss * (1.f / 128.f) + EPSN);
            *((unsigned*)(G.DO + (row0 + rb + r) * 1024 + h * 128) + lane) = pk2(v0 * rs * g0, v1 * rs * g1);
        }
    }
}

__device__ __forceinline__ void phase_attention(const Args& a, const Grp& G, LAS unsigned char* lds, const int tid_in) {
    int tid_ = tid_in; asm volatile("" : "+v"(tid_));
    const int tid = tid_, lane = tid & 63, wid = __builtin_amdgcn_readfirstlane(tid >> 6);
    const float* tabg = (const float*)(a.ws + WS_TAB);
    for (int i = tid; i < 8 * 192; i += 512) ((LAS float*)(lds + AL_TAB))[i] = tabg[i];
    const float lam = tabg[1536];
    const float* subln = a.in[13];
    __syncthreads();
    if (G.sample) {
        if (wid < 4) {
            constexpr int TBD = 64 * (64 * 2 + 16) + 64 * (128 * 2 + 64);
            LAS unsigned char* wt = lds + AL_TILE + wid * TBD;
            LAS float* wsf = (LAS float*)(lds + AL_WSF) + wid * 64;
            const LAS float* tab0 = (const LAS float*)(lds + AL_TAB);
            const unsigned char* cb = a.ws + WS_CACHE;
            for (int wu = (int)blockIdx.x * 4 + wid; wu < 1024; wu += (int)gridDim.x * 4) {
                const int s = wu & 3; const int j0 = s == 0 ? 0 : 17 + 16 * (s - 1), j1 = 17 + 16 * s;
                if (wu < 512) {
#if ATTMASK & 1
 const int n = (wu >> 2) & 1, h = (wu >> 3) & 7, b = wu >> 6;
                    attn_unit_wave<true>(G, cb, b, h, n, j0, j1, wu, (float*)(a.ws + WS_PO_D), (float*)(a.ws + WS_PM), (float*)(a.ws + WS_PL), wt, wsf, tab0, tid);
#endif
                } else {
#if ATTMASK & 2
 const int i2 = wu - 512; const int h = (i2 >> 2) & 15, b = i2 >> 6;
                    attn_unit_wave<false>(G, cb, b, h, 0, j0, j1, wu, (float*)(a.ws + WS_PO_M) - (size_t)512 * 32 * 64, (float*)(a.ws + WS_PM), (float*)(a.ws + WS_PL), wt, wsf, tab0, tid);
#endif
                }
            }
        }
    } else {
        const int Gn = (int)gridDim.x, bx = (int)blockIdx.x;
        const int vcu = (Gn % 8 == 0) ? (bx % 8) * (Gn / 8) + bx / 8 : bx;
        for (int v = vcu; v < 256; v += Gn) {
            const int p = v & 3;
#if ATTMASK & 4
            for (int r = 0; r < GBATCH * 8 / 64; ++r) { const int bh = r * 64 + (v >> 2), b = bh >> 3, h = bh & 7;
                for (int n = 0; n < 2; ++n)
                    for (int i = 0; i < 2; ++i) attn_unit_coop<true>(G, b, h, i ? p : 7 - p, n, lds, tid_in);
                asm volatile("s_waitcnt vmcnt(0)" ::: "memory"); __syncthreads();
                int t2 = tid_in; asm volatile("" : "+v"(t2));
                diffmix_block(G, b, h, 7 - p, lam, subln, t2); diffmix_block(G, b, h, p, lam, subln, t2); }
#endif
#if ATTMASK & 8
            for (int r = 0; r < GBATCH * 16 / 64; ++r) { const int bh = r * 64 + (v >> 2), b = bh >> 4, h = bh & 15;
                for (int i = 0; i < 2; ++i) attn_unit_coop<false>(G, b, h, i ? p : 7 - p, 0, lds, tid_in); }
#endif
        }
    }
}

constexpr int LDS_BYTES = 147456;
#ifndef PHMASK
#define PHMASK 0xffff
#endif

#define XB_TMO      128
#define XB_XCNT(j)  (256  + 64 * (j))
#define XB_XSUB(j)  (1280 + 64 * (j))
#define XB_XGEN(j)  (2304 + 64 * (j))
#define XB_TOP      3328
#define XB_TOPGEN   3392
#define XCD_BAR_WORDS 3456
#define XB_SPIN_CAP (1u << 18)

__device__ __forceinline__ unsigned xb_ld(unsigned* p)              { return __hip_atomic_load(p, __ATOMIC_RELAXED, __HIP_MEMORY_SCOPE_AGENT); }
__device__ __forceinline__ unsigned xb_add(unsigned* p, unsigned v) { return __hip_atomic_fetch_add(p, v, __ATOMIC_RELAXED, __HIP_MEMORY_SCOPE_AGENT); }
__device__ __forceinline__ unsigned xb_xcc_id() { return (unsigned)__builtin_amdgcn_s_getreg((3 << 11) | 20) & 0xFu; }
#define XB_SPIN(cond, bar) do { unsigned _sp = 0; while (cond) { __builtin_amdgcn_s_sleep(1); \
    if ((++_sp & 255u) == 0u) { if (xb_ld(&(bar)[XB_TMO])) break; if (_sp > XB_SPIN_CAP) { atomicAdd(&(bar)[XB_TMO], 1u); break; } } } } while (0)

struct XcdBarrier {
    unsigned* bar; unsigned x;
    volatile LAS unsigned* st;
};

__device__ __forceinline__ XcdBarrier xcd_barrier_post(unsigned* bar, volatile LAS unsigned* st) {
    XcdBarrier b; b.bar = bar; b.x = xb_xcc_id(); b.st = st;
    if (threadIdx.x == 0) (void)xb_add(&bar[XB_XCNT(b.x)], 1u);
    return b;
}
__device__ __forceinline__ void xcd_barrier_complete(unsigned* bar, unsigned x, unsigned& nloc, unsigned& nx) {
    const unsigned G = gridDim.x * gridDim.y * gridDim.z;
    unsigned sum, cnt, mine, sp = 0u;
    for (;;) {
        sum = 0u; cnt = 0u; mine = 0u;
#pragma unroll
        for (unsigned j = 0; j < 16; ++j) { const unsigned c = xb_ld(&bar[XB_XCNT(j)]); sum += c; cnt += (c > 0u) ? 1u : 0u; mine = (j == x) ? c : mine; }
        if (sum == G) break;
        __builtin_amdgcn_s_sleep(1);
        if ((++sp & 255u) == 0u) { if (xb_ld(&bar[XB_TMO])) break; if (sp > XB_SPIN_CAP) { atomicAdd(&bar[XB_TMO], 1u); break; } }
    }
    nloc = mine > 0u ? mine : 1u; nx = cnt > 0u ? cnt : 1u;
}

__device__ __forceinline__ void xcd_barrier(const XcdBarrier& b, const bool is_t0) {
    asm volatile("s_waitcnt vmcnt(0)" ::: "memory");
    __syncthreads();
    if (is_t0) {
        unsigned* bar = b.bar;
        __builtin_amdgcn_s_waitcnt(0);
        unsigned nloc = b.st[0], nx = b.st[1];
        if (nloc == 0u) { xcd_barrier_complete(bar, b.x, nloc, nx); b.st[0] = nloc; b.st[1] = nx; }
        const unsigned old = xb_add(&bar[XB_XSUB(b.x)], 1u);
        const unsigned gen = old / nloc;
        if (old + 1u == (gen + 1u) * nloc) {
            __builtin_amdgcn_fence(__ATOMIC_RELEASE, "agent");
            asm volatile("s_waitcnt vmcnt(0)" ::: "memory");
            const unsigned og = xb_add(&bar[XB_TOP], 1u);
            const unsigned tg = og / nx;
            if (og + 1u == (tg + 1u) * nx) xb_add(&bar[XB_TOPGEN], 1u);
            else XB_SPIN(xb_ld(&bar[XB_TOPGEN]) == tg, bar);
            __builtin_amdgcn_fence(__ATOMIC_ACQUIRE, "agent");
            xb_add(&bar[XB_XGEN(b.x)], 1u);
            asm volatile("s_waitcnt vmcnt(0)" ::: "memory");
        } else {
            XB_SPIN(xb_ld(&bar[XB_XGEN(b.x)]) == gen, bar);
            __builtin_amdgcn_fence(__ATOMIC_ACQUIRE, "agent");
            asm volatile("s_waitcnt vmcnt(0)" ::: "memory");
        }
    }
    __syncthreads();
}

constexpr size_t WS_BAR = 786432;
constexpr int LDS_BARST = 131072 + 512;
constexpr int LDS_PTAB = 131072;
__device__ __forceinline__ const void* lds_ptr(LAS const unsigned long long* pt, int i) {
    const unsigned long long v = pt[i];
    const unsigned lo = __builtin_amdgcn_readfirstlane((unsigned)v), hi = __builtin_amdgcn_readfirstlane((unsigned)(v >> 32));
    return (const void*)(const __attribute__((address_space(1))) void*)(((unsigned long long)hi << 32) | lo);
}
__device__ __forceinline__ Args load_args(LAS unsigned char* lds) {
    int z = 0; asm volatile("" : "+s"(z));
    LAS const unsigned long long* pt = (LAS const unsigned long long*)(lds + LDS_PTAB + z);
    Args a;
#pragma unroll
    for (int i = 0; i < 26; ++i) a.in[i] = (const float*)lds_ptr(pt, i);
    a.out = (float*)lds_ptr(pt, 26); a.ws = (unsigned char*)lds_ptr(pt, 27); a.pad0 = 0; a.pad1 = 0;
    return a;
}
#define GBAR() do { int z_ = 0; asm volatile("" : "+s"(z_)); XcdBarrier b_; b_.bar = (unsigned*)((unsigned char*)lds_ptr((LAS const unsigned long long*)(lds + LDS_PTAB + z_), 27) + WS_BAR); \
    b_.x = xb_xcc_id(); b_.st = (volatile LAS unsigned*)(lds + LDS_BARST + z_); xcd_barrier(b_, s_wave == 0 && __builtin_amdgcn_mbcnt_hi(~0u, __builtin_amdgcn_mbcnt_lo(~0u, (unsigned)z_)) == 0u); } while (0)
#define PH_BEGIN int w_ = s_wave, g_ = g; asm volatile("" : "+s"(w_), "+s"(g_)); int zz_ = 0; asm volatile("" : "+s"(zz_)); int lane_ = (int)__builtin_amdgcn_mbcnt_hi(~0u, __builtin_amdgcn_mbcnt_lo(~0u, (unsigned)zz_)); asm volatile("" : "+v"(lane_)); const int lane = lane_, wave = w_, tid_ = w_ * 64 + lane; (void)tid_; \
    const int gw = (int)blockIdx.x * 8 + wave, ngw = (int)gridDim.x * 8; const Args a = load_args(lds); unsigned char* ws = a.ws; const float* rope = (const float*)(ws + WS_ROPE); (void)rope; const Grp G = make_grp(a, g_); const int M = G.ntiles * 256; (void)lane; (void)gw; (void)ngw; (void)M;
__global__ void __launch_bounds__(512, 2) fwd_megakernel(Args ka) {
    extern __shared__ __attribute__((aligned(16))) unsigned char lds_raw[];
    LAS unsigned char* lds = (LAS unsigned char*)lds_raw;
    cg::grid_group grid = cg::this_grid();
    if (threadIdx.x == 0) {
        LAS unsigned long long* pt = (LAS unsigned long long*)(lds + LDS_PTAB);
#pragma unroll
        for (int i = 0; i < 26; ++i) pt[i] = (unsigned long long)ka.in[i];
        pt[26] = (unsigned long long)ka.out; pt[27] = (unsigned long long)ka.ws;
    }
    if (threadIdx.x == 0) { ((LAS unsigned*)(lds + LDS_BARST))[0] = 0u; ((LAS unsigned*)(lds + LDS_BARST))[1] = 0u; }
    __syncthreads();
    const int s_wave = __builtin_amdgcn_readfirstlane((int)threadIdx.x >> 6);
    (void)xcd_barrier_post((unsigned*)(ka.ws + WS_BAR), (volatile LAS unsigned*)(lds + LDS_BARST));
#if PHMASK & 1
    { const int tid = threadIdx.x, lane = tid & 63, wave = __builtin_amdgcn_readfirstlane(tid >> 6); const Args a = load_args(lds);
      phase_prologue(a, lds, (int)blockIdx.x * 8 + wave, (int)gridDim.x * 8, lane, wave); }
#endif
    if (ka.pad0 == 0x5a17) grid.sync();
    { const int g = 0; (void)g; GBAR(); }

#pragma unroll 1
    for (int step = 0; step < 19; ++step) {
#pragma unroll 1
        for (int w = 0; w < 3; ++w) {
            int ph = -1, g = 0;
            if (w == 0) { if (step <= 9) { ph = step; g = 1; } else if (step <= 17) { ph = step - 9; g = 2; } else { ph = 9; g = 2; } }
            else if (w == 1) { if (step == 9) { ph = 0; g = 2; } }
            else { if (step <= 4) ph = step; else if (step == 5) ph = 10; else if (step <= 10) ph = step - 1; g = 0; }
            ph = __builtin_amdgcn_readfirstlane(ph); g = __builtin_amdgcn_readfirstlane(g);
            if (ph < 0) continue;
            switch (ph) {
            case 0: { PH_BEGIN rms_rows_bf16(G.x, G.XN, a.in[7], G.nvalid, M, gw, ngw, lane, G.SSQ); } break;
            case 1: { PH_BEGIN EpiIn E{G.QD, G.KD, G.VD, G.GD, G.GM, G.ZS, G.okd, G.ovd, G.nvalid, 0.125f * LOG2E};
                      run_gemm(lds, G.XN, (const bf16*)(ws + WS_WIN), M, NIN, 1024, E, tid_, 0, g == 0 ? 128 : 0); } break;
            case 2: { PH_BEGIN phase_small(G, a.in[14], a.in[16], rope, gw, ngw, lane); } break;
            case 3: { { PH_BEGIN EpiQ E{G.QN, G.QR, rope, G.sample, 0.10206207261596575f * LOG2E};
                        run_gemm(lds, G.CQ, (const bf16*)(ws + WS_WUQ), M, 1536, 256, E, tid_); }
                      { PH_BEGIN EpiKV E{G.KN, G.VM};
                        run_gemm(lds, G.CKV, (const bf16*)(ws + WS_WUKV), M, 2048, 256, E, tid_); }
                      if (g == 0) { PH_BEGIN EpiKV E{(bf16*)(ws + WS_CACHE + C_KNC), (bf16*)(ws + WS_CACHE + C_VMC)};
                        run_gemm(lds, (const bf16*)(ws + WS_CACHE + C_CKVC), (const bf16*)(ws + WS_WUKV), CACHE_ROWS, 2048, 256, E, tid_); } } break;
            case 4: { PH_BEGIN phase_attention(a, G, lds, tid_); } break;
            case 5: { { PH_BEGIN EpiM1 E{G.GD, G.XN}; run_gemm(lds, G.DO, (const bf16*)(ws + WS_WOD), M, 1024, 1024, E, tid_); }
                      { PH_BEGIN EpiM2 E{G.GM, G.XN}; run_gemm(lds, G.MO, (const bf16*)(ws + WS_WOM), M, 1024, 1024, E, tid_); } } break;
            case 6: { PH_BEGIN EpiOut E{G.x, G.GD, G.SSQ, G.nvalid}; run_gemm(lds, G.XN, (const bf16*)(ws + WS_WOUT), M, 1024, 1024, E, tid_); } break;
            case 7: { PH_BEGIN EpiUp E{G.U, G.SSQ}; run_gemm(lds, G.GD, (const bf16*)(ws + WS_WUP), M, 4096, 1024, E, tid_);
                      if (g == 0) { for (int i = tid_ + (int)blockIdx.x * 512; i < G.nvalid * 1024; i += (int)gridDim.x * 512) G.y[i] = bflo((unsigned)G.GD[i]); } } break;
            case 8: if (g == 0) {
#pragma unroll 1
                        for (int sk = 0; sk < 8; ++sk) { PH_BEGIN int s_ = sk; asm volatile("" : "+s"(s_)); EpiDownAtomic E{G.y, G.nvalid};
                            run_gemm(lds, G.U + s_ * 512, (const bf16*)(ws + WS_WDN) + s_ * 512, M, 1024, 512, E, tid_, 4096, 4 * s_); }
                    } else { PH_BEGIN EpiDown E{G.GD, G.y, G.nvalid}; run_gemm(lds, G.U, (const bf16*)(ws + WS_WDN), M, 1024, 4096, E, tid_); } break;
            case 9: { PH_BEGIN rms_rows_f32_inplace(G.y, a.in[25], G.nvalid, gw, ngw, lane); } break;
            default: { PH_BEGIN phase_combine(G, (const float*)(ws + WS_PO_D), (const float*)(ws + WS_PO_M), (const float*)(ws + WS_PM), (const float*)(ws + WS_PL), ((const float*)(ws + WS_TAB))[1536], a.in[13], gw, ngw, lane); } break;
            }
        }
        if (step < 18) { const int g = 0; (void)g; GBAR(); }
    }
}

extern "C" void kernel_launch(void* const* d_in, const int* in_sizes, int n_in, void* d_out, int out_size, void* d_ws, size_t ws_size, hipStream_t stream) {
    static int grid = 0;
    if (grid == 0) {
        if (n_in != 26 || ws_size < WS_NEED) { fprintf(stderr, "kernel_launch: need 26 inputs and %zu bytes of workspace; got %d, %zu\n", (size_t)WS_NEED, n_in, ws_size); grid = -1; return; }
        int dev = 0, cus = 0, per_cu = 0;
        if (hipGetDevice(&dev) != hipSuccess || hipDeviceGetAttribute(&cus, hipDeviceAttributeMultiprocessorCount, dev) != hipSuccess) { grid = -1; return; }
        if (hipFuncSetAttribute((const void*)fwd_megakernel, hipFuncAttributeMaxDynamicSharedMemorySize, LDS_BYTES) != hipSuccess) { fprintf(stderr, "kernel_launch: hipFuncSetAttribute failed\n"); grid = -1; return; }
        if (hipOccupancyMaxActiveBlocksPerMultiprocessor(&per_cu, (const void*)fwd_megakernel, 512, LDS_BYTES) != hipSuccess || per_cu < 1) { fprintf(stderr, "kernel_launch: occupancy query says %d\n", per_cu); per_cu = 1; }
        (void)hipGetLastError();
        grid = cus;
    }
    if (grid < 0) return;
    if (hipMemsetAsync((char*)d_ws + WS_BAR, 0, 16384, stream) != hipSuccess) { fprintf(stderr, "kernel_launch: memset failed\n"); return; }
    Args a{};
    for (int i = 0; i < 26; ++i) a.in[i] = (const float*)d_in[i];
    a.out = (float*)d_out; a.ws = (unsigned char*)d_ws;
    void* args[] = {&a};
    hipError_t e = hipLaunchCooperativeKernel((const void*)fwd_megakernel, dim3(grid), dim3(512), args, LDS_BYTES, stream);
    if (e != hipSuccess) fprintf(stderr, "kernel_launch: cooperative launch failed: %s (grid %d)\n", hipGetErrorString(e), grid);
}
```
